# Optimizing an MI355X kernel written in HIP

```python
import jax, jax.numpy as jnp
from jax import lax
import numpy as np

D_MODEL = 1024
BATCH = 16
SEQ = 2048
DEPTH = 2

RWKV_HEADS = 6
RWKV_HEAD_DIM = 64
RWKV_WIDTH = RWKV_HEADS * RWKV_HEAD_DIM
W_LORA = 64
A_LORA = 64
G_LORA = 128
RET_HEADS = 6
RET_HEAD_DIM = 64
RET_WIDTH = RET_HEADS * RET_HEAD_DIM
RET_CHUNK = 128
POOL_GROUPS = 4
POOL_GROUP_DIM = 64
POOL_WIDTH = POOL_GROUPS * POOL_GROUP_DIM
POOL_WINDOWS = (2, 4, 8, 16)
MIX_WIDTH = RWKV_WIDTH + RET_WIDTH + POOL_WIDTH
RWKV_COLS = 3 * RWKV_WIDTH + W_LORA + A_LORA + G_LORA
RET_COLS = 4 * RET_WIDTH
IN_COLS = RWKV_COLS + RET_COLS + POOL_WIDTH
N_EXPERTS = 64
TOP_K = 8
N_GROUPS = 8
TOPK_GROUPS = 4
EXPERT_HIDDEN = 256
SHARED_HIDDEN = 256
ROUTED_SCALE = 2.5
MOE_BLOCK = 256
NORM_EPS = 1e-6
RWKV_LNX_EPS = 64e-5
RET_NORM_EPS = 1e-6
ROPE_BASE = 10000.0

kernel_name = 'hybrid_rwkv7_retention_pool_moe_adaln'


def rms_norm(x, g):
    xf = x.astype(jnp.float32)
    y = xf * lax.rsqrt(jnp.mean(xf * xf, -1, keepdims=True) + NORM_EPS)
    return (y * g.astype(jnp.float32)).astype(x.dtype)


def token_shift(p, mu):
    prev = jnp.pad(p, ((0, 0), (1, 0), (0, 0)))[:, :-1]
    return p + (prev - p) * mu


def group_norm(y, w, b, eps):
    B, T, H, d = y.shape
    mu = jnp.mean(y, -1, keepdims=True)
    var = jnp.mean(jnp.square(y - mu), -1, keepdims=True)
    yn = (y - mu) * lax.rsqrt(var + eps)
    return yn.reshape(B, T, H * d) * w + b


def rwkv7_scan(r, decay, k, v, kk, a):
    def step(S, inp):
        r_t, w_t, k_t, v_t, kk_t, a_t = inp
        sa = jnp.einsum('bhij,bhj->bhi', S, -kk_t)
        S = (S * w_t[:, :, None, :] + sa[..., None] * (kk_t * a_t)[:, :, None, :]
             + v_t[..., None] * k_t[:, :, None, :])
        return S, jnp.einsum('bhij,bhj->bhi', S, r_t)
    B, T, H, d = r.shape
    xs = tuple(jnp.moveaxis(t, 1, 0) for t in (r, decay, k, v, kk, a))
    _, ys = lax.scan(step, jnp.zeros((B, H, d, d), jnp.float32), xs)
    return jnp.moveaxis(ys, 0, 1)


def rwkv7_mixer(p, mu, w_up, w0, a_up, a0, g_up, k_k, k_a, r_k, lnx_w, lnx_b):
    B, T, _ = p.shape
    H, Dh, R = RWKV_HEADS, RWKV_HEAD_DIM, RWKV_WIDTH
    p = token_shift(p.astype(jnp.float32), mu)
    r = p[..., 0:R]
    k = p[..., R:2 * R]
    v = p[..., 2 * R:3 * R]
    o = 3 * R
    xw = p[..., o:o + W_LORA]
    xa = p[..., o + W_LORA:o + W_LORA + A_LORA]
    xg = p[..., o + W_LORA + A_LORA:]
    z = w0 + jnp.tanh(xw) @ w_up
    log_decay = -jnp.exp(-jax.nn.softplus(-z) - 0.5)
    a = jax.nn.sigmoid(a0 + xa @ a_up)
    g = jax.nn.sigmoid(xg) @ g_up

    def heads(t):
        return t.reshape(B, T, H, Dh)

    kk = heads(k * k_k)
    kk = kk / jnp.maximum(jnp.linalg.norm(kk, axis=-1, keepdims=True), 1e-12)
    k = k * (1.0 + (a - 1.0) * k_a)
    r_h, k_h, v_h, a_h = heads(r), heads(k), heads(v), heads(a)
    y = rwkv7_scan(r_h, jnp.exp(heads(log_decay)), k_h, v_h, kk, a_h)
    y = group_norm(y, lnx_w, lnx_b, RWKV_LNX_EPS)
    bonus = jnp.sum(r_h * k_h * r_k, -1, keepdims=True) * v_h
    return (y + bonus.reshape(B, T, R)) * g


def rotary(t, cos, sin):
    half = t.shape[-1] // 2
    t1, t2 = t[..., :half], t[..., half:]
    return jnp.concatenate([t1 * cos - t2 * sin, t1 * sin + t2 * cos], -1)


def retention_mixer(p):
    B, T, _ = p.shape
    H, d, C = RET_HEADS, RET_HEAD_DIM, RET_CHUNK
    NC = T // C
    p = p.astype(jnp.float32)
    W = RET_WIDTH
    q = p[..., 0:W].reshape(B, T, H, d)
    k = p[..., W:2 * W].reshape(B, T, H, d)
    v = p[..., 2 * W:3 * W].reshape(B, T, H, d)
    gate = p[..., 3 * W:]
    pos = jnp.arange(T, dtype=jnp.float32)
    inv_freq = ROPE_BASE ** (-jnp.arange(0, d, 2, dtype=jnp.float32) / d)
    ang = pos[:, None] * inv_freq[None, :]
    cos, sin = jnp.cos(ang)[:, None, :], jnp.sin(ang)[:, None, :]
    q = rotary(q, cos, sin)
    k = rotary(k, cos, sin) * (d ** -0.5)
    log_gamma = jnp.log1p(-(2.0 ** (-5.0 - jnp.arange(H, dtype=jnp.float32))))
    idx = jnp.arange(C, dtype=jnp.float32)
    diff = idx[:, None] - idx[None, :]
    inner_decay = jnp.where(diff >= 0,
                            jnp.exp(log_gamma[:, None, None] * jnp.maximum(diff, 0.0)), 0.0)
    xi = jnp.exp(log_gamma[:, None] * (idx + 1.0))
    zeta = jnp.exp(log_gamma[:, None] * (C - 1.0 - idx))
    chunk_decay = jnp.exp(log_gamma * C)
    qc = q.reshape(B, NC, C, H, d)
    kc = k.reshape(B, NC, C, H, d)
    vc = v.reshape(B, NC, C, H, d)
    scores = jnp.einsum('bnqhd,bnkhd->bnhqk', qc, kc) * inner_decay
    y_inner = jnp.einsum('bnhqk,bnkhe->bnqhe', scores, vc)
    kv = jnp.einsum('bnkhd,hk,bnkhe->nbhde', kc, zeta, vc)

    def step(R, kv_n):
        return chunk_decay[None, :, None, None] * R + kv_n, R

    _, R_prev = lax.scan(step, jnp.zeros((B, H, d, d), jnp.float32), kv)
    y_cross = jnp.einsum('bnqhd,hq,nbhde->bnqhe', qc, xi, R_prev)
    y = (y_inner + y_cross).reshape(B, T, H, d)
    y = y * lax.rsqrt(jnp.mean(y * y, -1, keepdims=True) + RET_NORM_EPS)
    return jax.nn.silu(gate) * y.reshape(B, T, W)


def pool_mixer(u, pool_w, pool_scale):
    B, T, _ = u.shape
    uf = u.astype(jnp.float32).reshape(B, T, POOL_GROUPS, POOL_GROUP_DIM)
    cs = jnp.cumsum(uf, axis=1)
    t = jnp.arange(T)
    pooled = []
    for gi, win in enumerate(POOL_WINDOWS):
        csg = cs[:, :, gi]
        lagged = jnp.pad(csg, ((0, 0), (win, 0), (0, 0)))[:, :T]
        count = jnp.minimum(t + 1, win).astype(jnp.float32)[None, :, None]
        pooled.append((csg - lagged) / count - uf[:, :, gi])
    pooled = jnp.stack(pooled, axis=2)
    out = jnp.einsum('btgc,gcd->btgd', pooled, pool_w)
    return out.reshape(B, T, POOL_WIDTH) * pool_scale


def swiglu(h, wg, wu, wd):
    return (jax.nn.silu(h @ wg) * (h @ wu)) @ wd


def moe_ffn(h, w_router, router_bias, we_gate, we_up, we_down, ws_gate, ws_up, ws_down):
    B, T, D = h.shape
    N = B * T
    hf = h.reshape(N, D)
    scores = jax.nn.sigmoid((hf @ w_router).astype(jnp.float32))
    choice = scores + router_bias.astype(jnp.float32)
    per_group = N_EXPERTS // N_GROUPS
    group_score = lax.top_k(choice.reshape(N, N_GROUPS, per_group), 2)[0].sum(-1)
    _, gsel = lax.top_k(group_score, TOPK_GROUPS)
    gmask = jax.nn.one_hot(gsel, N_GROUPS, dtype=jnp.float32).sum(-2) > 0
    emask = jnp.repeat(gmask, per_group, axis=-1)
    _, top_idx = lax.top_k(jnp.where(emask, choice, -jnp.inf), TOP_K)
    top_w = jnp.take_along_axis(scores, top_idx, -1)
    top_w = top_w / jnp.sum(top_w, -1, keepdims=True) * ROUTED_SCALE
    NK = N * TOP_K
    flat_e = top_idx.reshape(NK)
    flat_tok = jnp.repeat(jnp.arange(N, dtype=jnp.int32), TOP_K)
    flat_w = top_w.reshape(NK)
    order = jnp.argsort(flat_e)
    se = flat_e[order]
    counts = jnp.bincount(flat_e, length=N_EXPERTS)
    padded = (counts + MOE_BLOCK - 1) // MOE_BLOCK * MOE_BLOCK
    pad_end = jnp.cumsum(padded)
    pad_start = pad_end - padded
    start = jnp.cumsum(counts) - counts
    dest = pad_start[se] + jnp.arange(NK, dtype=jnp.int32) - start[se]
    n_blocks = -(-NK // MOE_BLOCK) + N_EXPERTS
    P = n_blocks * MOE_BLOCK
    row_tok = jnp.full((P,), N, jnp.int32).at[dest].set(flat_tok[order])
    row_w = jnp.zeros((P,), jnp.float32).at[dest].set(flat_w[order])
    block_expert = jnp.minimum(
        jnp.searchsorted(pad_end, jnp.arange(n_blocks, dtype=jnp.int32) * MOE_BLOCK, side='right'),
        N_EXPERTS - 1)
    h_pad = jnp.concatenate([hf, jnp.zeros((1, D), hf.dtype)], 0)

    def run_block(args):
        rows, wts, e = args
        yb = swiglu(h_pad[rows], we_gate[e], we_up[e], we_down[e])
        return yb * wts[:, None].astype(yb.dtype)

    yb = lax.map(run_block, (row_tok.reshape(n_blocks, MOE_BLOCK),
                             row_w.reshape(n_blocks, MOE_BLOCK), block_expert))
    routed = jax.ops.segment_sum(yb.reshape(P, D), row_tok, num_segments=N + 1)[:N]
    shared = swiglu(hf, ws_gate, ws_up, ws_down)
    return (routed + shared).reshape(B, T, D)


def setup_inputs(seed: int = 0) -> dict:
    key = jax.random.key(seed)
    ks = jax.random.split(key, 32)
    L, D = DEPTH, D_MODEL
    f32 = jnp.float32

    def nrm(k, shape, scale):
        return jax.random.normal(k, shape, f32) * scale

    return {
        'x': nrm(ks[0], (BATCH, SEQ, D), 1.0),
        'c': nrm(ks[1], (BATCH, D), 1.0),
        'norm1_g': 1.0 + nrm(ks[2], (L, D), 0.02),
        'norm2_g': 1.0 + nrm(ks[3], (L, D), 0.02),
        'w_ada': nrm(ks[4], (L, D, 6 * D), 0.5 * D ** -0.5),
        'b_ada': nrm(ks[5], (L, 6 * D), 0.02),
        'w_in': nrm(ks[6], (L, D, IN_COLS), D ** -0.5),
        'w_out': nrm(ks[7], (L, MIX_WIDTH, D), MIX_WIDTH ** -0.5),
        'rwkv_mu': jax.random.uniform(ks[8], (L, RWKV_COLS), f32),
        'rwkv_w_up': nrm(ks[9], (L, W_LORA, RWKV_WIDTH), W_LORA ** -0.5),
        'rwkv_w0': jax.random.uniform(ks[10], (L, RWKV_WIDTH), f32, -5.0, -1.0),
        'rwkv_a_up': nrm(ks[11], (L, A_LORA, RWKV_WIDTH), A_LORA ** -0.5),
        'rwkv_a0': nrm(ks[12], (L, RWKV_WIDTH), 0.5),
        'rwkv_g_up': nrm(ks[13], (L, G_LORA, RWKV_WIDTH), G_LORA ** -0.5),
        'rwkv_k_k': 0.85 + nrm(ks[14], (L, RWKV_WIDTH), 0.05),
        'rwkv_k_a': 1.0 + nrm(ks[15], (L, RWKV_WIDTH), 0.05),
        'rwkv_r_k': nrm(ks[16], (L, RWKV_HEADS, RWKV_HEAD_DIM), 0.1),
        'rwkv_lnx_w': 1.0 + nrm(ks[17], (L, RWKV_WIDTH), 0.1),
        'rwkv_lnx_b': nrm(ks[18], (L, RWKV_WIDTH), 0.01),
        'pool_w': nrm(ks[19], (L, POOL_GROUPS, POOL_GROUP_DIM, POOL_GROUP_DIM), POOL_GROUP_DIM ** -0.5),
        'pool_scale': 1.0 + nrm(ks[20], (L, POOL_WIDTH), 0.1),
        'w_router': nrm(ks[21], (L, D, N_EXPERTS), D ** -0.5),
        'router_bias': nrm(ks[22], (L, N_EXPERTS), 0.01),
        'we_gate': nrm(ks[23], (L, N_EXPERTS, D, EXPERT_HIDDEN), D ** -0.5),
        'we_up': nrm(ks[24], (L, N_EXPERTS, D, EXPERT_HIDDEN), D ** -0.5),
        'we_down': nrm(ks[25], (L, N_EXPERTS, EXPERT_HIDDEN, D), EXPERT_HIDDEN ** -0.5),
        'ws_gate': nrm(ks[26], (L, D, SHARED_HIDDEN), D ** -0.5),
        'ws_up': nrm(ks[27], (L, D, SHARED_HIDDEN), D ** -0.5),
        'ws_down': nrm(ks[28], (L, SHARED_HIDDEN, D), SHARED_HIDDEN ** -0.5),
        'final_g': 1.0 + nrm(ks[29], (D,), 0.02),
    }


def reference(x, c, norm1_g, norm2_g, w_ada, b_ada, w_in, w_out, rwkv_mu, rwkv_w_up, rwkv_w0,
              rwkv_a_up, rwkv_a0, rwkv_g_up, rwkv_k_k, rwkv_k_a, rwkv_r_k, rwkv_lnx_w, rwkv_lnx_b,
              pool_w, pool_scale, w_router, router_bias, we_gate, we_up, we_down,
              ws_gate, ws_up, ws_down, final_g):
    mod = jnp.einsum('bd,ldm->lbm', jax.nn.silu(c), w_ada) + b_ada[:, None, :]
    for l in range(DEPTH):
        shift1, scale1, gate1, shift2, scale2, gate2 = jnp.split(mod[l][:, None, :], 6, axis=-1)
        h = rms_norm(x, norm1_g[l]) * (1.0 + scale1) + shift1
        p = h @ w_in[l]
        y_rwkv = rwkv7_mixer(p[..., :RWKV_COLS], rwkv_mu[l], rwkv_w_up[l], rwkv_w0[l],
                             rwkv_a_up[l], rwkv_a0[l], rwkv_g_up[l], rwkv_k_k[l], rwkv_k_a[l],
                             rwkv_r_k[l], rwkv_lnx_w[l], rwkv_lnx_b[l])
        y_ret = retention_mixer(p[..., RWKV_COLS:RWKV_COLS + RET_COLS])
        y_pool = pool_mixer(p[..., RWKV_COLS + RET_COLS:], pool_w[l], pool_scale[l])
        mixed = jnp.concatenate([y_rwkv, y_ret, y_pool], -1).astype(x.dtype) @ w_out[l]
        x = x + gate1 * mixed
        h = rms_norm(x, norm2_g[l]) * (1.0 + scale2) + shift2
        y = moe_ffn(h, w_router[l], router_bias[l], we_gate[l], we_up[l], we_down[l],
                    ws_gate[l], ws_up[l], ws_down[l])
        x = x + gate2 * y
    return rms_norm(x, final_g)
```

```cpp
#include <hip/hip_runtime.h>
#include <cstdio>
#include <cstdint>

#ifndef N_LAUNCH_MODE
#define N_LAUNCH_MODE 0
#endif
#ifndef LAST_PHASE
#define LAST_PHASE 26
#endif
#ifndef STEP_MASK
#define STEP_MASK 0xFFFF
#endif
#define STEP_ON(s) ((STEP_MASK >> (s)) & 1)
#ifndef REPEAT_STEP
#define REPEAT_STEP -1
#endif

#define LAS __attribute__((address_space(3)))
typedef unsigned short bf16_t;
typedef short bf16x8 __attribute__((ext_vector_type(8)));
typedef float f32x4 __attribute__((ext_vector_type(4)));
typedef float f32x2 __attribute__((ext_vector_type(2)));
typedef unsigned u32x4 __attribute__((ext_vector_type(4)));
typedef unsigned u32x2 __attribute__((ext_vector_type(2)));
typedef __attribute__((address_space(1))) unsigned char* GPTR;

constexpr int D = 1024, NB = 16, SEQ = 2048, NTOK = NB * SEQ, NL = 2;
constexpr int RH = 6, RW = 384, RCOLS = 1408, INC = 3200, INP = 3328;
constexpr int RET_OFF = 1408, POOL_OFF = 2944;
constexpr int NE = 64, HT = 16384, PMAXH = 576 * 256, ACT_ROWS = PMAXH + 2 * HT;
constexpr int NTHREADS = 512;
constexpr int LDS_BYTES = 163840;
constexpr int MISC_OFF = LDS_BYTES - 1024;
constexpr int TILEE_OFF = LDS_BYTES - 4096;

constexpr size_t al256(size_t x) { return (x + 255) & ~(size_t)255; }
constexpr size_t WS_CTL = 0, CTL_BYTES = 65536;
constexpr size_t CTL_TOTALS = 16384;
constexpr size_t WS_MOD = WS_CTL + CTL_BYTES;
constexpr size_t WS_ROPE = WS_MOD + al256((size_t)NL * 16 * 6144 * 4);
constexpr size_t WS_WINT = WS_ROPE + (size_t)2 * 2048 * 32 * 4;
constexpr size_t WS_WOUTT = WS_WINT + (size_t)NL * INP * 1024 * 2;
constexpr size_t WS_WUPT = WS_WOUTT + (size_t)NL * 1024 * 1024 * 2;
constexpr size_t WS_AUPT = WS_WUPT + (size_t)NL * 384 * 64 * 2;
constexpr size_t WS_GUPT = WS_AUPT + (size_t)NL * 384 * 64 * 2;
constexpr size_t WS_POOLWT = WS_GUPT + (size_t)NL * 384 * 128 * 2;
constexpr size_t WS_WRT = WS_POOLWT + (size_t)NL * 4 * 64 * 64 * 2;
constexpr size_t WS_TOPI = WS_WRT + (size_t)NL * 2 * 64 * 1024 * 2;
constexpr size_t WS_TOPW = WS_TOPI + (size_t)NTOK * 8 * 4;
constexpr size_t WS_TILECNT = WS_TOPW + (size_t)NTOK * 8 * 4;
constexpr size_t WS_ROWTOK = WS_TILECNT + (size_t)1024 * 64 * 4;
constexpr size_t WS_ROWW = WS_ROWTOK + (size_t)2 * PMAXH * 4;
constexpr size_t WS_ROWDST = WS_ROWW + (size_t)2 * PMAXH * 4;
constexpr size_t WS_PADEND = WS_ROWDST + (size_t)2 * PMAXH * 4;
constexpr size_t WS_TILEE = WS_PADEND + 1024;
constexpr size_t WS_H = WS_TILEE + 2 * 576 * 4 + 512;
constexpr size_t WS_XB = WS_H + al256((size_t)(NTOK + 1) * 1024 * 2);
constexpr size_t WS_BIG = WS_XB + (size_t)NTOK * 1024 * 2;
constexpr size_t WS_P = WS_BIG;
constexpr size_t WS_SW = WS_P + (size_t)NTOK * INP;
constexpr size_t SARR = (size_t)NTOK * RW * 2;
constexpr size_t WS_SX = WS_SW + (size_t)NTOK * RW * 4;
constexpr size_t WS_YS = WS_SX + 5 * SARR;
constexpr size_t WS_G = WS_YS + (size_t)NTOK * RW * 4;
constexpr size_t WS_END_MIX = WS_G + SARR;
constexpr size_t WS_ACT = WS_BIG;
constexpr size_t WS_YB = WS_ACT + (size_t)ACT_ROWS * 256 * 2;
constexpr size_t WS_END_MOE = WS_YB + (size_t)HT * 9 * 1024;
constexpr size_t WS_WGU = al256(WS_END_MIX > WS_END_MOE ? WS_END_MIX : WS_END_MOE);
constexpr size_t WS_WD = WS_WGU + (size_t)65 * 512 * 1024 * 2;
constexpr size_t WS_END = WS_WD + (size_t)65 * 1024 * 256 * 2;
constexpr size_t CTL_QUEUE = 32768;

struct Params {
    const float* x; const float* c; const float* norm1_g; const float* norm2_g; const float* w_ada; const float* b_ada; const float* w_in; const float* w_out;
    const float* rwkv_mu; const float* rwkv_w_up; const float* rwkv_w0; const float* rwkv_a_up; const float* rwkv_a0; const float* rwkv_g_up; const float* rwkv_k_k; const float* rwkv_k_a;
    const float* rwkv_r_k; const float* rwkv_lnx_w; const float* rwkv_lnx_b; const float* pool_w; const float* pool_scale; const float* w_router; const float* router_bias;
    const float* we_gate; const float* we_up; const float* we_down; const float* ws_gate; const float* ws_up; const float* ws_down; const float* final_g;
    float* out; unsigned char* ws;
    int ph_lo, ph_hi;
};

__device__ __forceinline__ float bf2f(unsigned b) { return __uint_as_float(b << 16); }
__device__ __forceinline__ unsigned f2bf(float f) { unsigned u = __float_as_uint(f); u += 0x7FFFu + ((u >> 16) & 1u); return u >> 16; }
typedef __bf16 bf16x2_t __attribute__((ext_vector_type(2)));
__device__ __forceinline__ unsigned cvt_pk_bf16(float lo, float hi) { const bf16x2_t v = {(__bf16)lo, (__bf16)hi}; return __builtin_bit_cast(unsigned, v); }
__device__ __forceinline__ unsigned pack2(float lo, float hi) { return cvt_pk_bf16(lo, hi); }
__device__ __forceinline__ float sigmoidf_(float x) { return __builtin_amdgcn_rcpf(1.0f + __expf(-x)); }
__device__ __forceinline__ float tanhf_(float x) { const float e = __expf(2.0f * x); return 1.0f - 2.0f * __builtin_amdgcn_rcpf(e + 1.0f); }
template <int N> __device__ __forceinline__ float dpp_ror(float x) { return __builtin_bit_cast(float, __builtin_amdgcn_update_dpp(0, __builtin_bit_cast(int, x), 0x120 + N, 0xf, 0xf, false)); }
__device__ __forceinline__ float row16_sum(float x) { x += dpp_ror<8>(x); x += dpp_ror<4>(x); x += dpp_ror<2>(x); x += dpp_ror<1>(x); return x; }
template <int CTRL> __device__ __forceinline__ float dpp_mov(float x) { return __builtin_bit_cast(float, __builtin_amdgcn_update_dpp(0, __builtin_bit_cast(int, x), CTRL, 0xf, 0xf, false)); }
__device__ __forceinline__ float gmax8(float x) { x = fmaxf(x, dpp_mov<0xB1>(x)); x = fmaxf(x, dpp_mov<0x4E>(x)); x = fmaxf(x, dpp_mov<0x141>(x)); return x; }
__device__ __forceinline__ float shx(float v, int m, int lane) { return __builtin_bit_cast(float, __builtin_amdgcn_ds_bpermute((lane ^ m) << 2, __builtin_bit_cast(int, v))); }
__device__ __forceinline__ float wave_sum(float v, int lane) { v = row16_sum(v); v += shx(v, 16, lane); v += shx(v, 32, lane); return v; }
__device__ __forceinline__ unsigned ld_u32_agent(const unsigned* p) { return __hip_atomic_load(p, __ATOMIC_RELAXED, __HIP_MEMORY_SCOPE_AGENT); }
__device__ __forceinline__ void unpack8(const u32x4 v, float (&f)[8]) {
    f[0] = bf2f(v.x & 0xffffu); f[1] = __uint_as_float(v.x & 0xffff0000u); f[2] = bf2f(v.y & 0xffffu); f[3] = __uint_as_float(v.y & 0xffff0000u);
    f[4] = bf2f(v.z & 0xffffu); f[5] = __uint_as_float(v.z & 0xffff0000u); f[6] = bf2f(v.w & 0xffffu); f[7] = __uint_as_float(v.w & 0xffff0000u);
}
__device__ __forceinline__ u32x4 pack8(const float (&f)[8]) { u32x4 w; w.x = pack2(f[0], f[1]); w.y = pack2(f[2], f[3]); w.z = pack2(f[4], f[5]); w.w = pack2(f[6], f[7]); return w; }

__device__ __forceinline__ int opaque_tid() { int t = threadIdx.x; asm volatile("" : "+v"(t)); return t; }
typedef float f32x2v_ __attribute__((ext_vector_type(2)));
__device__ __forceinline__ void unpack4f8(unsigned v, float* f, float sc) { const f32x2v_ lo = __builtin_amdgcn_cvt_pk_f32_fp8((int)v, false), hi = __builtin_amdgcn_cvt_pk_f32_fp8((int)v, true); f[0] = lo.x * sc; f[1] = lo.y * sc; f[2] = hi.x * sc; f[3] = hi.y * sc; }
__device__ __forceinline__ void unpack8f8(const u32x2 v, float (&f)[8], float sc) { unpack4f8(v.x, f, sc); unpack4f8(v.y, f + 4, sc); }
__device__ __forceinline__ void unpack16f8(const u32x4 v, float (&f)[16], float sc) { unpack4f8(v.x, f, sc); unpack4f8(v.y, f + 4, sc); unpack4f8(v.z, f + 8, sc); unpack4f8(v.w, f + 12, sc); }
__device__ __forceinline__ unsigned pack4f8(float a, float b, float c, float d) { int w = 0; w = __builtin_amdgcn_cvt_pk_fp8_f32(a, b, w, false); w = __builtin_amdgcn_cvt_pk_fp8_f32(c, d, w, true); return (unsigned)w; }
constexpr float PSCALE = 16.0f, PINV = 1.0f / 16.0f;
#define XB_TMO      128
#define XB_XCNT(j)  (256  + 64 * (j))
#define XB_XSUB(j)  (1280 + 64 * (j))
#define XB_XGEN(j)  (2304 + 64 * (j))
#define XB_TOP      3328
#define XB_TOPGEN   3392
#define XCD_BAR_WORDS 3456
#define XB_SPIN_CAP (1u << 24)
__device__ __forceinline__ unsigned xb_ld(unsigned* p)              { return __hip_atomic_load(p, __ATOMIC_RELAXED, __HIP_MEMORY_SCOPE_AGENT); }
__device__ __forceinline__ unsigned xb_add(unsigned* p, unsigned v) { return __hip_atomic_fetch_add(p, v, __ATOMIC_RELAXED, __HIP_MEMORY_SCOPE_AGENT); }
__device__ __forceinline__ unsigned xb_xcc_id() { return (unsigned)__builtin_amdgcn_s_getreg((3 << 11) | 20) & 0xFu; }
#define XB_SPIN(cond, bar) do { unsigned _sp = 0; while (cond) { __builtin_amdgcn_s_sleep(1); \
    if ((++_sp & 255u) == 0u) { if (xb_ld(&(bar)[XB_TMO])) break; if (_sp > XB_SPIN_CAP) { atomicAdd(&(bar)[XB_TMO], 1u); break; } } } } while (0)
struct XcdBarrier { unsigned* bar; unsigned x; volatile LAS unsigned* st; };
__device__ __forceinline__ XcdBarrier xcd_barrier_post(unsigned* bar, volatile LAS unsigned* st) {
    XcdBarrier b; b.bar = bar; b.x = xb_xcc_id(); b.st = st;
    if (threadIdx.x == 0) (void)xb_add(&bar[XB_XCNT(b.x)], 1u);
    return b;
}
__device__ __forceinline__ void xcd_barrier_complete(unsigned* bar, unsigned x, unsigned& nloc, unsigned& nx) {
    const unsigned G = gridDim.x * gridDim.y * gridDim.z;
    unsigned sum, cnt, mine, sp = 0u;
    for (;;) {
        sum = 0u; cnt = 0u; mine = 0u;
#pragma unroll
        for (unsigned j = 0; j < 16; ++j) { const unsigned c = xb_ld(&bar[XB_XCNT(j)]); sum += c; cnt += (c > 0u) ? 1u : 0u; mine = (j == x) ? c : mine; }
        if (sum == G) break;
        __builtin_amdgcn_s_sleep(1);
        if ((++sp & 255u) == 0u) { if (xb_ld(&bar[XB_TMO])) break; if (sp > XB_SPIN_CAP) { atomicAdd(&bar[XB_TMO], 1u); break; } }
    }
    nloc = mine > 0u ? mine : 1u; nx = cnt > 0u ? cnt : 1u;
}
__device__ __forceinline__ void xcd_barrier(const XcdBarrier& b) {
    asm volatile("s_waitcnt vmcnt(0)" ::: "memory");
    __syncthreads();
    if (threadIdx.x == 0) {
        unsigned* bar = b.bar;
        __builtin_amdgcn_s_waitcnt(0);
        unsigned nloc = b.st[0], nx = b.st[1];
        if (nloc == 0u) { xcd_barrier_complete(bar, b.x, nloc, nx); b.st[0] = nloc; b.st[1] = nx; }
        const unsigned old = xb_add(&bar[XB_XSUB(b.x)], 1u);
        const unsigned gen = old / nloc;
        if (old + 1u == (gen + 1u) * nloc) {
            __builtin_amdgcn_fence(__ATOMIC_RELEASE, "agent");
            asm volatile("s_waitcnt vmcnt(0)" ::: "memory");
            const unsigned og = xb_add(&bar[XB_TOP], 1u);
            const unsigned tg = og / nx;
            if (og + 1u == (tg + 1u) * nx) xb_add(&bar[XB_TOPGEN], 1u);
            else XB_SPIN(xb_ld(&bar[XB_TOPGEN]) == tg, bar);
            __builtin_amdgcn_fence(__ATOMIC_ACQUIRE, "agent");
            xb_add(&bar[XB_XGEN(b.x)], 1u);
            asm volatile("s_waitcnt vmcnt(0)" ::: "memory");
        } else {
            XB_SPIN(xb_ld(&bar[XB_XGEN(b.x)]) == gen, bar);
            __builtin_amdgcn_fence(__ATOMIC_ACQUIRE, "agent");
            asm volatile("s_waitcnt vmcnt(0)" ::: "memory");
        }
    }
    __syncthreads();
}

typedef const __attribute__((address_space(4))) Params* PP;
struct Frame {
    PP p;
    LAS unsigned char* lds;
    unsigned char* ws;
    int tid, lane, wave, G, bid;
};

namespace pg8 {
constexpr int BM = 256, BK = 64, HALF = 128, HTB = HALF * BK * 2, STAGE_BYTES = 8 * HTB, NXCD = 8, WGM = 8;
__device__ __forceinline__ int lds_byte(int r, int c) { const int st = (r >> 4) * 2 + (c >> 5), rr = r & 15, cc = c & 31, ob = rr * 64 + cc * 2; return st * 1024 + (ob ^ (((ob >> 9) & 1) << 5)); }
__device__ __forceinline__ void stage_rc(int b, int& R, int& C) { const int st = b / 1024, sb = b % 1024, swz = sb ^ (((sb >> 9) & 1) << 5); R = (st >> 1) * 16 + swz / 64; C = (st & 1) * 32 + (swz % 64) / 2; }
__device__ __forceinline__ int perm32(int rho) { const int n = rho >> 4, i = rho & 15; return 8 * (i >> 2) + 4 * n + (i & 3); }

__device__ __forceinline__ bool static_order(int nM, int nN, int G, int c, int i, int& pm, int& pn) {
    const int nwg = nM * nN; const long L = (long)i * G + c; if (L >= nwg) return false;
    int wgid = (int)L; { const int q = nwg / NXCD, r = nwg % NXCD, xcd = wgid % NXCD, off = wgid / NXCD; wgid = (xcd < r ? xcd * (q + 1) : r * (q + 1) + (xcd - r) * q) + off; }
    const int nig = WGM * nN, gid = wgid / nig, fm = gid * WGM, gsz = (nM - fm) < WGM ? (nM - fm) : WGM;
    pm = fm + ((wgid % nig) % gsz); pn = (wgid % nig) / gsz; return true;
}

struct Unit { int rt, ct, e, slot; };

template <class Task>
__device__ __forceinline__ void gemm_run(LAS unsigned char* lds, const Task& S) {
    constexpr int K = Task::K, nt = K / BK;
    const int tid = opaque_tid(), wid = __builtin_amdgcn_readfirstlane(tid >> 6), lane = tid & 63, wr = wid >> 2, wc = wid & 3, fr = lane & 15, fq = lane >> 4;
    unsigned voffB[2][2];
#pragma unroll
    for (int h = 0; h < 2; ++h)
#pragma unroll
        for (int i = 0; i < 2; ++i) { int R, C; stage_rc(tid * 16 + i * 8192, R, C); voffB[h][i] = (unsigned)(Task::brow(h, R) * K + C) * 2u; }
    const size_t kstep = (size_t)(BK * 2);
        const unsigned ldsw = (unsigned)wid * 1024u;
    const int aoff = lds_byte(wr * 64 + fr, fq * 8), boff = lds_byte(wc * 32 + fr, fq * 8);
#define PG8_SA(b, h) (((b) * 2 + (h)) * HTB)
#define PG8_SB(b, h) ((4 + (b) * 2 + (h)) * HTB)
#define PG8_STAGE(bufoff, gbase, voff) do { _Pragma("unroll") for (int _i = 0; _i < 2; ++_i) \
        __builtin_amdgcn_global_load_lds((const unsigned*)((const char*)(gbase) + (voff)[_i]), (LAS unsigned*)(lds + (bufoff) + ldsw + _i * 8192), 16, 0, 0); } while (0)
#define PG8_LDA(dst, b, h) do { _Pragma("unroll") for (int m = 0; m < 4; ++m) _Pragma("unroll") for (int k = 0; k < 2; ++k) dst[m][k] = *(const LAS bf16x8*)(lds + PG8_SA(b, h) + aoff + m * 2048 + k * 1024); } while (0)
#define PG8_LDB(dst, b, h) do { _Pragma("unroll") for (int n = 0; n < 2; ++n) _Pragma("unroll") for (int k = 0; k < 2; ++k) dst[n][k] = *(const LAS bf16x8*)(lds + PG8_SB(b, h) + boff + n * 2048 + k * 1024); } while (0)
#define PG8_MMA(ai, bj, At, Bt) do { __builtin_amdgcn_s_setprio(1); _Pragma("unroll") for (int m = 0; m < 4; ++m) _Pragma("unroll") for (int n = 0; n < 2; ++n) _Pragma("unroll") for (int k = 0; k < 2; ++k) \
        acc[ai][bj][m][n] = __builtin_amdgcn_mfma_f32_16x16x32_bf16(Bt[n][k], At[m][k], acc[ai][bj][m][n], 0, 0, 0); __builtin_amdgcn_s_setprio(0); } while (0)
#define PG8_WAIT_V(n) asm volatile("s_waitcnt vmcnt(" #n ")" ::: "memory")
#define PG8_WAIT_L(n) asm volatile("s_waitcnt lgkmcnt(" #n ")" ::: "memory")
#define PG8_BAR __builtin_amdgcn_s_barrier()
#define LDS_BAR() do { asm volatile("s_waitcnt lgkmcnt(0)" ::: "memory"); __builtin_amdgcn_s_barrier(); asm volatile("" ::: "memory"); } while (0)
#define PG8_SCHED __builtin_amdgcn_sched_barrier(0)
    Unit cur, nxt; int ui = 0;
    if (!S.unit(0, cur)) return;
    f32x4 acc[2][2][4][2];
#pragma unroll
    for (int a = 0; a < 2; ++a)
#pragma unroll
        for (int b = 0; b < 2; ++b)
#pragma unroll
            for (int m = 0; m < 4; ++m)
#pragma unroll
                for (int n = 0; n < 2; ++n) acc[a][b][m][n] = (f32x4){0.f, 0.f, 0.f, 0.f};
    bf16x8 At[4][2], B0[2][2], B1[2][2];
    const char* const Ab = S.abase();
    unsigned co[2][2];
    S.aoffs(cur, co);
    const char* cB = S.bptr(cur);
    PG8_STAGE(PG8_SB(0, 0), cB, voffB[0]); PG8_STAGE(PG8_SB(0, 1), cB, voffB[1]); PG8_STAGE(PG8_SA(0, 0), Ab, co[0]); PG8_STAGE(PG8_SA(0, 1), Ab, co[1]);
    if (wr == 1) PG8_BAR;
    PG8_WAIT_V(2); PG8_BAR;
    PG8_STAGE(PG8_SB(1, 0), cB + kstep, voffB[0]); PG8_STAGE(PG8_SA(1, 0), Ab + kstep, co[0]); PG8_STAGE(PG8_SB(1, 1), cB + kstep, voffB[1]);
    PG8_WAIT_V(6); PG8_BAR;
#pragma unroll 1
    for (;;) {
        const bool has_next = S.unit(ui + 1, nxt);
        const char* nB = cB;
        if (has_next) nB = S.bptr(nxt);
#pragma unroll 1
        for (int t = 0; t < nt; t += 2) {
            const bool last = (t == nt - 2);
            const char* a1 = Ab + (size_t)(t + 1) * kstep;
            const char* a2 = last ? Ab : Ab + (size_t)(t + 2) * kstep; const char* b2 = last ? nB : cB + (size_t)(t + 2) * kstep;
            const char* a3 = a2 + kstep; const char* b3 = b2 + kstep;
            PG8_LDB(B0, 0, 0); PG8_LDB(B1, 0, 1); PG8_SCHED; PG8_LDA(At, 0, 0); PG8_STAGE(PG8_SA(1, 1), a1, co[1]);
            PG8_WAIT_V(8); PG8_WAIT_L(0); PG8_BAR; PG8_MMA(0, 0, At, B0); PG8_MMA(0, 1, At, B1); PG8_BAR; PG8_SCHED;
            if (last && has_next) S.aoffs(nxt, co);
            PG8_LDA(At, 0, 1); PG8_STAGE(PG8_SB(0, 0), b2, voffB[0]); PG8_STAGE(PG8_SB(0, 1), b2, voffB[1]); PG8_STAGE(PG8_SA(0, 0), a2, co[0]);
            PG8_WAIT_V(8); PG8_WAIT_L(0); PG8_BAR; PG8_MMA(1, 0, At, B0); PG8_MMA(1, 1, At, B1); PG8_BAR; PG8_SCHED;
            PG8_LDB(B0, 1, 0); PG8_LDB(B1, 1, 1); PG8_SCHED; PG8_LDA(At, 1, 0); PG8_STAGE(PG8_SA(0, 1), a2, co[1]);
            PG8_WAIT_V(8); PG8_WAIT_L(0); PG8_BAR; PG8_MMA(0, 0, At, B0); PG8_MMA(0, 1, At, B1); PG8_BAR; PG8_SCHED;
            PG8_LDA(At, 1, 1); PG8_STAGE(PG8_SB(1, 0), b3, voffB[0]); PG8_STAGE(PG8_SB(1, 1), b3, voffB[1]); PG8_STAGE(PG8_SA(1, 0), a3, co[0]);
            PG8_WAIT_V(8); PG8_WAIT_L(0); PG8_BAR; PG8_MMA(1, 0, At, B0); PG8_MMA(1, 1, At, B1); PG8_BAR; PG8_SCHED;
        }
        if (wr == 0) PG8_BAR;
        S.epi(acc, cur, wr, wc, fr, fq);
        if (!has_next) break;
#pragma unroll
        for (int a = 0; a < 2; ++a)
#pragma unroll
            for (int b = 0; b < 2; ++b)
#pragma unroll
                for (int m = 0; m < 4; ++m)
#pragma unroll
                    for (int n = 0; n < 2; ++n) acc[a][b][m][n] = (f32x4){0.f, 0.f, 0.f, 0.f};
        cur = nxt; cB = nB; ++ui;
        if (wr == 1) PG8_BAR;
    }
    PG8_WAIT_V(0);
    PG8_BAR;
#undef PG8_SA
#undef PG8_SB
#undef PG8_STAGE
#undef PG8_LDA
#undef PG8_LDB
#undef PG8_MMA
#undef PG8_WAIT_V
#undef PG8_WAIT_L
#undef PG8_BAR
#undef PG8_SCHED
}
}
using pg8::Unit;


__device__ __forceinline__ u32x4 ror8_u32x4(u32x4 v) { u32x4 r;
    r.x = (unsigned)__builtin_amdgcn_update_dpp(0, (int)v.x, 0x128, 0xf, 0xf, false); r.y = (unsigned)__builtin_amdgcn_update_dpp(0, (int)v.y, 0x128, 0xf, 0xf, false);
    r.z = (unsigned)__builtin_amdgcn_update_dpp(0, (int)v.z, 0x128, 0xf, 0xf, false); r.w = (unsigned)__builtin_amdgcn_update_dpp(0, (int)v.w, 0x128, 0xf, 0xf, false); return r; }
__device__ __forceinline__ void store_rows_full(bf16_t* pa, bf16_t* pb, u32x4 w0, u32x4 w1, int fr, int fq) {
    const bool lo = fr < 8;
    const u32x4 send = lo ? w1 : w0, recv = ror8_u32x4(send);
    const u32x4 s1 = lo ? w0 : recv;
    const u32x4 s2 = lo ? recv : w1;
    const int co = (lo ? 0 : 32) + 8 * fq;
    if (pa) *(u32x4*)(pa + co) = s1;
    if (pb) *(u32x4*)(pb + co) = s2;
}

struct TaskIn {
    static constexpr int K = 1024; static constexpr bool PERM = true;
    static __device__ __forceinline__ int brow(int h, int R) { return (R >> 5) * 64 + 16 * ((R & 15) >> 2) + 8 * h + 4 * ((R >> 4) & 1) + (R & 3); }
    const char* A; const char* Bt; unsigned char* O; int G, c;
    __device__ __forceinline__ bool unit(int i, Unit& u) const { u.e = 0; u.slot = i; return pg8::static_order(NTOK / 256, INP / 256, G, c, i, u.rt, u.ct); }
    __device__ __forceinline__ const char* abase() const { return A; }
    __device__ __forceinline__ void aoffs(const Unit& u, unsigned (&o)[2][2]) const {
        int R[2], C[2];
        { const int t_ = opaque_tid();
#pragma unroll
        for (int i = 0; i < 2; ++i) pg8::stage_rc(t_ * 16 + i * 8192, R[i], C[i]); }
#pragma unroll
        for (int h = 0; h < 2; ++h)
#pragma unroll
            for (int i = 0; i < 2; ++i) o[h][i] = (unsigned)((u.rt * 256 + h * 128 + R[i]) * K + C[i]) * 2u;
    }
    __device__ __forceinline__ const char* bptr(const Unit& u) const { return Bt + (size_t)u.ct * 256 * K * 2; }
    __device__ __forceinline__ void epi(const f32x4 (&acc)[2][2][4][2], const Unit& u, int wr, int wc, int fr, int fq) const {
        const int row0 = u.rt * 256 + wr * 64 + fr, col0 = u.ct * 256 + wc * 64 + 16 * fq;
#pragma unroll
        for (int ai = 0; ai < 2; ++ai)
#pragma unroll
            for (int m = 0; m < 4; ++m) {
                const f32x4 a0 = acc[ai][0][m][0] * PSCALE, a1 = acc[ai][0][m][1] * PSCALE, b0 = acc[ai][1][m][0] * PSCALE, b1 = acc[ai][1][m][1] * PSCALE;
                u32x4 w; w.x = pack4f8(a0[0], a0[1], a0[2], a0[3]); w.y = pack4f8(a1[0], a1[1], a1[2], a1[3]); w.z = pack4f8(b0[0], b0[1], b0[2], b0[3]); w.w = pack4f8(b1[0], b1[1], b1[2], b1[3]);
                *(u32x4*)(O + (size_t)(row0 + ai * 128 + m * 16) * INP + col0) = w;
            }
    }
};

struct TaskOut {
    static constexpr int K = 1024; static constexpr bool PERM = true;
    static __device__ __forceinline__ int brow(int h, int R) { return (R >> 5) * 64 + h * 32 + pg8::perm32(R & 31); }
    const char* A; const char* Bt; const float* xf; bf16_t* xb; const float* gate;
    int G, c;
    __device__ __forceinline__ bool unit(int i, Unit& u) const { u.e = 0; u.slot = i; return pg8::static_order(NTOK / 256, D / 256, G, c, i, u.rt, u.ct); }
    __device__ __forceinline__ const char* abase() const { return A; }
    __device__ __forceinline__ void aoffs(const Unit& u, unsigned (&o)[2][2]) const {
        int R[2], C[2];
        { const int t_ = opaque_tid();
#pragma unroll
        for (int i = 0; i < 2; ++i) pg8::stage_rc(t_ * 16 + i * 8192, R[i], C[i]); }
#pragma unroll
        for (int h = 0; h < 2; ++h)
#pragma unroll
            for (int i = 0; i < 2; ++i) o[h][i] = (unsigned)((u.rt * 256 + h * 128 + R[i]) * K + C[i]) * 2u;
    }
    __device__ __forceinline__ const char* bptr(const Unit& u) const { return Bt + (size_t)u.ct * 256 * K * 2; }
    __device__ __forceinline__ void epi(const f32x4 (&acc)[2][2][4][2], const Unit& u, int wr, int wc, int fr, int fq) const {
        const int rowg = u.rt * 256 + wr * 64, colw = u.ct * 256 + wc * 64, b = (u.rt * 256) / SEQ;
        f32x4 gv[2][2];
#pragma unroll
        for (int bj = 0; bj < 2; ++bj)
#pragma unroll
            for (int n = 0; n < 2; ++n) gv[bj][n] = *(const f32x4*)(gate + (size_t)b * 6144 + colw + bj * 32 + 8 * fq + 4 * n);
#pragma unroll
        for (int ai = 0; ai < 2; ++ai)
#pragma unroll
            for (int m = 0; m < 4; ++m) {
                const size_t ro = (size_t)(rowg + ai * 128 + m * 16 + fr) * D + colw + 8 * fq;
                u32x4 w[2];
#pragma unroll
                for (int bj = 0; bj < 2; ++bj) {
                    float xv[8];
                    if (xf) { const f32x4 x0 = *(const f32x4*)(xf + ro + bj * 32), x1 = *(const f32x4*)(xf + ro + bj * 32 + 4);
#pragma unroll
                        for (int j = 0; j < 4; ++j) { xv[j] = x0[j]; xv[4 + j] = x1[j]; } }
                    else unpack8(*(const u32x4*)(xb + ro + bj * 32), xv);
                    float o[8];
#pragma unroll
                    for (int n = 0; n < 2; ++n)
#pragma unroll
                        for (int j = 0; j < 4; ++j) o[n * 4 + j] = xv[n * 4 + j] + gv[bj][n][j] * acc[ai][bj][m][n][j];
                    w[bj] = pack8(o);
                }
                bf16_t* pa = xb + (size_t)(rowg + ai * 128 + m * 16 + (fr & 7)) * D + colw;
                store_rows_full(pa, pa + (size_t)8 * D, w[0], w[1], fr, fq);
                asm volatile("" ::: "memory");
            }
    }
};

struct TaskGU {
    static constexpr int K = 1024; static constexpr bool PERM = true;
    static __device__ __forceinline__ int brow(int h, int R) { return h * 128 + (R & ~31) + pg8::perm32(R & 31); }
    const char* A;
    const char* W;
    const LAS int* ltok; const LAS float* lw; bf16_t* act; const LAS int* tilee;
    int hf, ntr, G, c;
    __device__ __forceinline__ bool unit(int i, Unit& u) const {
        const int uu = c + i * G; if (uu >= (ntr + 64) * 2) return false;
        u.rt = uu >> 1; u.ct = uu & 1; u.slot = i;
        if (u.rt < ntr) u.e = __builtin_amdgcn_readfirstlane(tilee[u.rt]); else u.e = 64;
        return true;
    }
    __device__ __forceinline__ const char* abase() const { return A; }
    __device__ __forceinline__ void aoffs(const Unit& u, unsigned (&o)[2][2]) const {
        int R[2], C[2];
        { const int t_ = opaque_tid();
#pragma unroll
        for (int i = 0; i < 2; ++i) pg8::stage_rc(t_ * 16 + i * 8192, R[i], C[i]); }
#pragma unroll
        for (int h = 0; h < 2; ++h)
#pragma unroll
            for (int i = 0; i < 2; ++i) {
                int tok;
                if (u.e < 64) tok = ltok[u.slot * 256 + h * 128 + R[i]]; else tok = hf * HT + (u.rt - ntr) * 256 + h * 128 + R[i];
                o[h][i] = (unsigned)(tok * K + C[i]) * 2u;
            }
    }
    __device__ __forceinline__ const char* bptr(const Unit& u) const { return W + ((size_t)u.e * 512 + (size_t)u.ct * 256) * K * 2; }
    __device__ __forceinline__ void epi(const f32x4 (&acc)[2][2][4][2], const Unit& u, int wr, int wc, int fr, int fq) const {
        const bool routed = u.e < 64;
        const int rin = u.rt * 256 + wr * 64 + fr;
        const int rout = routed ? rin : PMAXH + hf * HT + (u.rt - ntr) * 256 + wr * 64 + fr;
        const int col0 = u.ct * 128 + wc * 32 + 8 * fq;
#pragma unroll
        for (int ai = 0; ai < 2; ++ai)
#pragma unroll
            for (int m = 0; m < 4; ++m) {
                const float rw = routed ? lw[u.slot * 256 + wr * 64 + fr + ai * 128 + m * 16] : 1.0f;
                float o[8];
#pragma unroll
                for (int n = 0; n < 2; ++n)
#pragma unroll
                    for (int j = 0; j < 4; ++j) { const float g = acc[ai][0][m][n][j], up = acc[ai][1][m][n][j]; o[n * 4 + j] = g * sigmoidf_(g) * up * rw; }
                u32x4 w; w.x = cvt_pk_bf16(o[0], o[1]); w.y = cvt_pk_bf16(o[2], o[3]); w.z = cvt_pk_bf16(o[4], o[5]); w.w = cvt_pk_bf16(o[6], o[7]);
                *(u32x4*)(act + (size_t)(rout + ai * 128 + m * 16) * 256 + col0) = w;
            }
    }
};

struct TaskDown {
    static constexpr int K = 256; static constexpr bool PERM = true;
    static __device__ __forceinline__ int brow(int h, int R) { return (R >> 5) * 64 + 16 * ((R & 15) >> 2) + 8 * h + 4 * ((R >> 4) & 1) + (R & 3); }
    const char* A;
    const char* W;
    const LAS int* ldst; unsigned char* yb; const LAS int* tilee;
    int hf, ntr, G, c;
    __device__ __forceinline__ bool unit(int i, Unit& u) const {
        const int uu = c + i * G; if (uu >= (ntr + 64) * 4) return false;
        u.rt = uu >> 2; u.ct = uu & 3; u.slot = i;
        if (u.rt < ntr) u.e = __builtin_amdgcn_readfirstlane(tilee[u.rt]); else u.e = 64;
        return true;
    }
    __device__ __forceinline__ const char* abase() const { return A; }
    __device__ __forceinline__ void aoffs(const Unit& u, unsigned (&o)[2][2]) const {
        int R[2], C[2];
        { const int t_ = opaque_tid();
#pragma unroll
        for (int i = 0; i < 2; ++i) pg8::stage_rc(t_ * 16 + i * 8192, R[i], C[i]); }
        const int row0 = (u.e < 64) ? u.rt * 256 : PMAXH + hf * HT + (u.rt - ntr) * 256;
#pragma unroll
        for (int h = 0; h < 2; ++h)
#pragma unroll
            for (int i = 0; i < 2; ++i) o[h][i] = (unsigned)((row0 + h * 128 + R[i]) * K + C[i]) * 2u;
    }
    __device__ __forceinline__ const char* bptr(const Unit& u) const { return W + ((size_t)u.e * 1024 + (size_t)u.ct * 256) * K * 2; }
    __device__ __forceinline__ void epi(const f32x4 (&acc)[2][2][4][2], const Unit& u, int wr, int wc, int fr, int fq) const {
        const bool routed = u.e < 64;
        const int rin = u.rt * 256 + wr * 64 + fr, col0 = u.ct * 256 + wc * 64 + 16 * fq;
        const int sl = (u.rt - ntr) * 256 + wr * 64 + fr;
#pragma unroll
        for (int ai = 0; ai < 2; ++ai)
#pragma unroll
            for (int m = 0; m < 4; ++m) {
                const int dst = routed ? ldst[u.slot * 256 + wr * 64 + fr + ai * 128 + m * 16] : (sl + ai * 128 + m * 16) * 9 + 8;
                u32x4 w;
                { int d0 = 0, d1 = 0, d2 = 0, d3 = 0; const f32x4 a0 = acc[ai][0][m][0] * 64.0f, a1 = acc[ai][0][m][1] * 64.0f, b0 = acc[ai][1][m][0] * 64.0f, b1 = acc[ai][1][m][1] * 64.0f;
                  d0 = __builtin_amdgcn_cvt_pk_fp8_f32(a0[0], a0[1], d0, false); d0 = __builtin_amdgcn_cvt_pk_fp8_f32(a0[2], a0[3], d0, true);
                  d1 = __builtin_amdgcn_cvt_pk_fp8_f32(a1[0], a1[1], d1, false); d1 = __builtin_amdgcn_cvt_pk_fp8_f32(a1[2], a1[3], d1, true);
                  d2 = __builtin_amdgcn_cvt_pk_fp8_f32(b0[0], b0[1], d2, false); d2 = __builtin_amdgcn_cvt_pk_fp8_f32(b0[2], b0[3], d2, true);
                  d3 = __builtin_amdgcn_cvt_pk_fp8_f32(b1[0], b1[1], d3, false); d3 = __builtin_amdgcn_cvt_pk_fp8_f32(b1[2], b1[3], d3, true);
                  w.x = (unsigned)d0; w.y = (unsigned)d1; w.z = (unsigned)d2; w.w = (unsigned)d3; }
                if (dst >= 0) *(u32x4*)(yb + (size_t)dst * 1024 + col0) = w;
                asm volatile("" ::: "memory");
            }
    }
};

__device__ __forceinline__ void tr_tile(int tid, LAS float* T, const float* src, int ld_src, bf16_t* dst, int ld_dst, bf16_t* dst_lo) {
    { const int row = tid >> 4, c4 = tid & 15;
#pragma unroll
      for (int rr = 0; rr < 64; rr += 32) { const f32x4 v = *(const f32x4*)(src + (size_t)(row + rr) * ld_src + c4 * 4);
          LAS float* t = T + (row + rr) * 65 + c4 * 4; t[0] = v[0]; t[1] = v[1]; t[2] = v[2]; t[3] = v[3]; } }
    __syncthreads();
    { const int n = tid >> 3, kq = tid & 7; float v[8];
#pragma unroll
      for (int j = 0; j < 8; ++j) v[j] = T[(kq * 8 + j) * 65 + n];
      *(u32x4*)(dst + (size_t)n * ld_dst + kq * 8) = pack8(v);
      if (dst_lo) { float lo[8];
#pragma unroll
          for (int j = 0; j < 8; ++j) lo[j] = v[j] - bf2f(f2bf(v[j]));
          *(u32x4*)(dst_lo + (size_t)n * ld_dst + kq * 8) = pack8(lo); } }
    __syncthreads();
}

__device__ __forceinline__ void tr_tile_wave(int lane, LAS float* T, const float* src, int ld_src, bf16_t* dst, int ld_dst) {
    f32x4 v[16];
#pragma unroll
    for (int i = 0; i < 16; ++i) v[i] = *(const f32x4*)(src + (size_t)(i * 4 + (lane >> 4)) * ld_src + (lane & 15) * 4);
#pragma unroll
    for (int i = 0; i < 16; ++i) { LAS float* t = T + (i * 4 + (lane >> 4)) * 65 + (lane & 15) * 4; t[0] = v[i][0]; t[1] = v[i][1]; t[2] = v[i][2]; t[3] = v[i][3]; }
    __builtin_amdgcn_fence(__ATOMIC_RELEASE, "wavefront"); asm volatile("s_waitcnt lgkmcnt(0)" ::: "memory");
    const int kq = lane & 7;
#pragma unroll
    for (int q = 0; q < 8; ++q) { const int n = q * 8 + (lane >> 3); float o[8];
#pragma unroll
        for (int j = 0; j < 8; ++j) o[j] = T[(kq * 8 + j) * 65 + n];
        *(u32x4*)(dst + (size_t)n * ld_dst + kq * 8) = pack8(o); }
    asm volatile("s_waitcnt lgkmcnt(0)" ::: "memory");
}

__device__ __forceinline__ void phase_init(Frame& F) {
    const PP p = F.p; const int tid = F.tid;
    LAS float* T = (LAS float*)F.lds;
    LAS float* sc = (LAS float*)(F.lds + 32768);
    LAS float* red = (LAS float*)(F.lds + 98304);
    constexpr int PER_L = 800 + 256 + 6 + 6 + 12 + 4 + 16, NTR = NL * PER_L, I_ZERO = NTR, I_MOD = I_ZERO + NL, I_ROPE = I_MOD + 192, I_ZROW = I_ROPE + 128, N_ITEMS = I_ZROW + 1;
    bool sc_ready = false;
    for (int it = F.bid; it < N_ITEMS; it += F.G) {
        if (it < NTR) {
            const int l = it / PER_L; int j = it % PER_L;
            if (j < 800) { const int kt = j / 50, ntile = j % 50; tr_tile(F.tid, T, p->w_in + (size_t)l * 1024 * INC + (size_t)kt * 64 * INC + ntile * 64, INC, (bf16_t*)(F.ws + WS_WINT) + (size_t)l * INP * 1024 + (size_t)ntile * 64 * 1024 + kt * 64, 1024, nullptr); continue; }
            j -= 800;
            if (j < 256) { const int kt = j / 16, ntile = j % 16; tr_tile(F.tid, T, p->w_out + (size_t)l * 1024 * 1024 + (size_t)kt * 64 * 1024 + ntile * 64, 1024, (bf16_t*)(F.ws + WS_WOUTT) + (size_t)l * 1024 * 1024 + (size_t)ntile * 64 * 1024 + kt * 64, 1024, nullptr); continue; }
            j -= 256;
            if (j < 6) { tr_tile(F.tid, T, p->rwkv_w_up + (size_t)l * 64 * 384 + j * 64, 384, (bf16_t*)(F.ws + WS_WUPT) + (size_t)l * 384 * 64 + (size_t)j * 64 * 64, 64, nullptr); continue; }
            j -= 6;
            if (j < 6) { tr_tile(F.tid, T, p->rwkv_a_up + (size_t)l * 64 * 384 + j * 64, 384, (bf16_t*)(F.ws + WS_AUPT) + (size_t)l * 384 * 64 + (size_t)j * 64 * 64, 64, nullptr); continue; }
            j -= 6;
            if (j < 12) { const int kt = j / 6, ntile = j % 6; tr_tile(F.tid, T, p->rwkv_g_up + (size_t)l * 128 * 384 + (size_t)kt * 64 * 384 + ntile * 64, 384, (bf16_t*)(F.ws + WS_GUPT) + (size_t)l * 384 * 128 + (size_t)ntile * 64 * 128 + kt * 64, 128, nullptr); continue; }
            j -= 12;
            if (j < 4) { tr_tile(F.tid, T, p->pool_w + ((size_t)l * 4 + j) * 64 * 64, 64, (bf16_t*)(F.ws + WS_POOLWT) + ((size_t)l * 4 + j) * 64 * 64, 64, nullptr); continue; }
            j -= 4;
            { bf16_t* hi = (bf16_t*)(F.ws + WS_WRT) + (size_t)l * 2 * 64 * 1024; tr_tile(F.tid, T, p->w_router + (size_t)l * 1024 * 64 + (size_t)j * 64 * 64, 64, hi + j * 64, 1024, hi + 64 * 1024 + j * 64); continue; }
        } else if (it < I_MOD) {
            const int l = it - I_ZERO; u32x4* z = (u32x4*)((bf16_t*)(F.ws + WS_WINT) + (size_t)l * INP * 1024 + (size_t)INC * 1024);
            for (int i = tid; i < 128 * 1024 * 2 / 16; i += NTHREADS) z[i] = (u32x4){0u, 0u, 0u, 0u};
        } else if (it < I_ROPE) {
            if (!sc_ready) { for (int i = tid; i < 16 * 1024; i += NTHREADS) { const float v = p->c[i]; sc[i] = v / (1.0f + __expf(-v)); } sc_ready = true; __syncthreads(); }
            const int j = it - I_MOD, l = j / 96, cb = j % 96, ks = tid >> 6, cl = tid & 63, col = cb * 64 + cl;
            float acc[16];
#pragma unroll
            for (int b = 0; b < 16; ++b) acc[b] = 0.f;
            const float* wp = p->w_ada + (size_t)l * 1024 * 6144 + col;
            for (int k = ks * 128; k < ks * 128 + 128; k += 4) {
                const float w0 = wp[(size_t)k * 6144], w1 = wp[(size_t)(k + 1) * 6144], w2 = wp[(size_t)(k + 2) * 6144], w3 = wp[(size_t)(k + 3) * 6144];
#pragma unroll
                for (int b = 0; b < 16; ++b) { const f32x4 s = *(const LAS f32x4*)(sc + b * 1024 + k); acc[b] += s[0] * w0 + s[1] * w1 + s[2] * w2 + s[3] * w3; }
            }
#pragma unroll
            for (int b = 0; b < 16; ++b) red[(ks * 16 + b) * 64 + cl] = acc[b];
            __syncthreads();
            for (int o = tid; o < 1024; o += NTHREADS) { const int b = o >> 6, c2 = o & 63; float s = p->b_ada[(size_t)l * 6144 + cb * 64 + c2];
#pragma unroll
                for (int q = 0; q < 8; ++q) s += red[(q * 16 + b) * 64 + c2];
                ((float*)(F.ws + WS_MOD))[((size_t)l * 16 + b) * 6144 + cb * 64 + c2] = s; }
            __syncthreads();
        } else if (it < I_ZROW) {
            const int idx = (it - I_ROPE) * NTHREADS + tid, pos = idx >> 5, cc = idx & 31;
            const float invf = __expf(-((float)(2 * cc) * (1.0f / 64.0f)) * 9.210340371976184f);
            const double ang = (double)pos * (double)invf, nn = __builtin_rint(ang * 0.15915494309189535), r = ang - nn * 6.283185307179586, r2 = r * r;
            double sn = 0.0, cs = 0.0;
#pragma unroll
            for (int k = 14; k >= 1; --k) { sn = sn * r2 * (-1.0 / (double)((2 * k) * (2 * k + 1))) + 1.0; cs = cs * r2 * (-1.0 / (double)((2 * k - 1) * (2 * k))) + 1.0; }
            sn *= r;
            ((float*)(F.ws + WS_ROPE))[idx] = (float)cs; ((float*)(F.ws + WS_ROPE))[2048 * 32 + idx] = (float)sn;
        } else {
            u32x4* z = (u32x4*)((bf16_t*)(F.ws + WS_H) + (size_t)NTOK * 1024);
            if (tid < 128) z[tid] = (u32x4){0u, 0u, 0u, 0u};
        }
    }
}

__device__ __forceinline__ void phase_norm(Frame& F, const float* xin, const float* g, const float* mod_l, int shift_off, int scale_off) {
    bf16_t* H = (bf16_t*)(F.ws + WS_H);
    for (int row = F.bid * 8 + F.wave; row < NTOK; row += F.G * 8) {
        const int b = row / SEQ; const float* xr = xin + (size_t)row * D; f32x4 v[4]; float ss = 0.f;
#pragma unroll
        for (int i = 0; i < 4; ++i) { v[i] = *(const f32x4*)(xr + i * 256 + F.lane * 4); ss += v[i][0] * v[i][0] + v[i][1] * v[i][1] + v[i][2] * v[i][2] + v[i][3] * v[i][3]; }
        ss = wave_sum(ss, F.lane); const float rstd = rsqrtf(ss * (1.0f / D) + 1e-6f);
#pragma unroll
        for (int i = 0; i < 4; ++i) { const int c0 = i * 256 + F.lane * 4; const f32x4 gg = *(const f32x4*)(g + c0), sc = *(const f32x4*)(mod_l + (size_t)b * 6144 + scale_off + c0), sh = *(const f32x4*)(mod_l + (size_t)b * 6144 + shift_off + c0);
            float o[4];
#pragma unroll
            for (int j = 0; j < 4; ++j) o[j] = v[i][j] * rstd * gg[j] * (1.0f + sc[j]) + sh[j];
            u32x2 w; w.x = pack2(o[0], o[1]); w.y = pack2(o[2], o[3]); *(u32x2*)(H + (size_t)row * D + c0) = w; }
    }
}

__device__ __forceinline__ void phase_final(Frame& F) {
    float* X = F.p->out;
    for (int row = F.bid * 8 + F.wave; row < NTOK; row += F.G * 8) {
        float* xr = X + (size_t)row * D; f32x4 v[4]; float ss = 0.f;
#pragma unroll
        for (int i = 0; i < 4; ++i) { v[i] = *(const f32x4*)(xr + i * 256 + F.lane * 4); ss += v[i][0] * v[i][0] + v[i][1] * v[i][1] + v[i][2] * v[i][2] + v[i][3] * v[i][3]; }
        ss = wave_sum(ss, F.lane); const float rstd = rsqrtf(ss * (1.0f / D) + 1e-6f);
#pragma unroll
        for (int i = 0; i < 4; ++i) { const int c0 = i * 256 + F.lane * 4; const f32x4 gg = *(const f32x4*)(F.p->final_g + c0); *(f32x4*)(xr + c0) = v[i] * rstd * gg; }
    }
}

__device__ __forceinline__ void rwkv_prep_tile(Frame& F, int l, int item) {
    const PP p = F.p; const int tid = F.tid, lane = F.lane, fr = lane & 15, fq = lane >> 4;
    const bf16_t* P = (const bf16_t*)(F.ws + WS_P);
    const int row0 = item * 32, b = row0 / SEQ, t0 = row0 % SEQ;
    constexpr int PSS = 1416, XWS = 72, XGS = 136;
    LAS bf16_t* PS = (LAS bf16_t*)F.lds;
    LAS bf16_t* XW = (LAS bf16_t*)(F.lds + 90624);
    LAS bf16_t* XA = (LAS bf16_t*)(F.lds + 90624 + 4608);
    LAS bf16_t* XG = (LAS bf16_t*)(F.lds + 90624 + 9216);
#pragma unroll 1
    for (int ito_ = 0; ito_ < 3; ++ito_)
#pragma unroll
    for (int iti_ = 0; iti_ < 4; ++iti_) {
        const int idx = tid + (ito_ * 4 + iti_) * NTHREADS; if (idx >= 32 * 176) continue;
        const int i = idx / 176, q = idx % 176, c0 = q * 8;
        const u32x4 cu = *(const u32x4*)(P + (size_t)(row0 + i) * INP + c0);
        u32x4 pv = (u32x4){0u, 0u, 0u, 0u}; if (t0 + i > 0) pv = *(const u32x4*)(P + (size_t)(row0 + i - 1) * INP + c0);
        float cf[8], pf[8], s[8]; unpack8(cu, cf); unpack8(pv, pf);
        const f32x4 m0 = *(const f32x4*)(p->rwkv_mu + (size_t)l * RCOLS + c0), m1 = *(const f32x4*)(p->rwkv_mu + (size_t)l * RCOLS + c0 + 4);
#pragma unroll
        for (int j = 0; j < 4; ++j) { s[j] = cf[j] + (pf[j] - cf[j]) * m0[j]; s[4 + j] = cf[4 + j] + (pf[4 + j] - cf[4 + j]) * m1[j]; }
        if (c0 < 1152) *(LAS u32x4*)(PS + i * PSS + c0) = pack8(s);
        else if (c0 < 1216) {
#pragma unroll
            for (int j = 0; j < 8; ++j) s[j] = tanhf_(s[j]);
            *(LAS u32x4*)(XW + i * XWS + (c0 - 1152)) = pack8(s);
        } else if (c0 < 1280) *(LAS u32x4*)(XA + i * XWS + (c0 - 1216)) = pack8(s);
        else {
#pragma unroll
            for (int j = 0; j < 8; ++j) s[j] = sigmoidf_(s[j]);
            *(LAS u32x4*)(XG + i * XGS + (c0 - 1280)) = pack8(s);
        }
    }
    __syncthreads();
    if (F.wave < 6) {
        const int hd = F.wave;
        const bf16_t* WU = (const bf16_t*)(F.ws + WS_WUPT) + (size_t)l * 384 * 64, *AU = (const bf16_t*)(F.ws + WS_AUPT) + (size_t)l * 384 * 64, *GU = (const bf16_t*)(F.ws + WS_GUPT) + (size_t)l * 384 * 128;
        float* SWp = (float*)(F.ws + WS_SW); bf16_t* SAp = (bf16_t*)(F.ws + WS_SX); bf16_t* SBp = SAp + SARR / 2; bf16_t* SKp = SBp + SARR / 2; bf16_t* SRp = SKp + SARR / 2; bf16_t* SVp = SRp + SARR / 2;
        bf16_t* Gp = (bf16_t*)(F.ws + WS_G);
#pragma unroll 1
        for (int mt = 0; mt < 2; ++mt) {
            const int i = mt * 16 + fr;
            const size_t ob = (((size_t)b * RH + hd) * SEQ + t0 + i) * 64;
            {
                f32x4 ag[4];
#pragma unroll
                for (int nt = 0; nt < 4; ++nt) ag[nt] = (f32x4){0.f, 0.f, 0.f, 0.f};
#pragma unroll
                for (int ks = 0; ks < 4; ++ks) {
                    const bf16x8 xg = *(const LAS bf16x8*)(XG + i * XGS + ks * 32 + fq * 8);
#pragma unroll
                    for (int nt = 0; nt < 4; ++nt) { const bf16x8 gf = *(const bf16x8*)(GU + (size_t)(hd * 64 + nt * 16 + fr) * 128 + ks * 32 + fq * 8); ag[nt] = __builtin_amdgcn_mfma_f32_16x16x32_bf16(gf, xg, ag[nt], 0, 0, 0); }
                }
#pragma unroll
                for (int nt = 0; nt < 4; ++nt) { u32x2 gw; gw.x = pack2(ag[nt][0], ag[nt][1]); gw.y = pack2(ag[nt][2], ag[nt][3]); *(u32x2*)(Gp + (size_t)(row0 + i) * RW + hd * 64 + nt * 16 + fq * 4) = gw; }
            }
            f32x4 aw[4], aa[4];
#pragma unroll
            for (int nt = 0; nt < 4; ++nt) { aw[nt] = (f32x4){0.f, 0.f, 0.f, 0.f}; aa[nt] = (f32x4){0.f, 0.f, 0.f, 0.f}; }
#pragma unroll
            for (int ks = 0; ks < 2; ++ks) {
                const bf16x8 xw = *(const LAS bf16x8*)(XW + i * XWS + ks * 32 + fq * 8), xa = *(const LAS bf16x8*)(XA + i * XWS + ks * 32 + fq * 8);
#pragma unroll
                for (int nt = 0; nt < 4; ++nt) {
                    const bf16x8 wf = *(const bf16x8*)(WU + (size_t)(hd * 64 + nt * 16 + fr) * 64 + ks * 32 + fq * 8), af = *(const bf16x8*)(AU + (size_t)(hd * 64 + nt * 16 + fr) * 64 + ks * 32 + fq * 8);
                    aw[nt] = __builtin_amdgcn_mfma_f32_16x16x32_bf16(wf, xw, aw[nt], 0, 0, 0); aa[nt] = __builtin_amdgcn_mfma_f32_16x16x32_bf16(af, xa, aa[nt], 0, 0, 0);
                }
            }
            float ss = 0.f;
#pragma unroll
            for (int nt = 0; nt < 4; ++nt) {
                const int ch0 = hd * 64 + nt * 16 + fq * 4;
                const u32x2 r2 = *(const LAS u32x2*)(PS + i * PSS + ch0), k2 = *(const LAS u32x2*)(PS + i * PSS + 384 + ch0), v2 = *(const LAS u32x2*)(PS + i * PSS + 768 + ch0);
                const float kf[4] = {bf2f(k2.x & 0xffffu), __uint_as_float(k2.x & 0xffff0000u), bf2f(k2.y & 0xffffu), __uint_as_float(k2.y & 0xffff0000u)};
                const f32x4 w0 = *(const f32x4*)(p->rwkv_w0 + (size_t)l * RW + ch0), a0 = *(const f32x4*)(p->rwkv_a0 + (size_t)l * RW + ch0), kkp = *(const f32x4*)(p->rwkv_k_k + (size_t)l * RW + ch0), kap = *(const f32x4*)(p->rwkv_k_a + (size_t)l * RW + ch0);
                f32x4 wv; float kn[4];
#pragma unroll
                for (int j = 0; j < 4; ++j) {
                    const float z = w0[j] + aw[nt][j]; wv[j] = __expf(-0.6065306597126334f * sigmoidf_(z));
                    const float a = sigmoidf_(a0[j] + aa[nt][j]); aa[nt][j] = a;
                    const float kv = kf[j] * kkp[j]; aw[nt][j] = kv; ss += kv * kv;
                    kn[j] = kf[j] * (1.0f + (a - 1.0f) * kap[j]);
                }
                *(f32x4*)(SWp + ob + nt * 16 + fq * 4) = wv;
                u32x2 kw; kw.x = pack2(kn[0], kn[1]); kw.y = pack2(kn[2], kn[3]); *(u32x2*)(SKp + ob + nt * 16 + fq * 4) = kw;
                *(u32x2*)(SRp + ob + nt * 16 + fq * 4) = r2; *(u32x2*)(SVp + ob + nt * 16 + fq * 4) = v2;
            }
            ss += shx(ss, 16, lane); ss += shx(ss, 32, lane);
            const float inv = 1.0f / fmaxf(sqrtf(ss), 1e-12f);
#pragma unroll
            for (int nt = 0; nt < 4; ++nt) {
                float av[4], bv[4];
#pragma unroll
                for (int j = 0; j < 4; ++j) { const float kn = aw[nt][j] * inv; av[j] = -kn; bv[j] = kn * aa[nt][j]; }
                u32x2 aw2, bw2; aw2.x = pack2(av[0], av[1]); aw2.y = pack2(av[2], av[3]); bw2.x = pack2(bv[0], bv[1]); bw2.y = pack2(bv[2], bv[3]);
                *(u32x2*)(SAp + ob + nt * 16 + fq * 4) = aw2; *(u32x2*)(SBp + ob + nt * 16 + fq * 4) = bw2;
            }
        }
    }
    __syncthreads();
}

__device__ __forceinline__ void phase_prep_rwkv(Frame& F, int l) {
    const PP p = F.p; const int tid = F.tid, lane = F.lane, w = F.wave, fr = lane & 15, fq = lane >> 4;
    const unsigned char* P = (const unsigned char*)(F.ws + WS_P);
    constexpr int RAWB = 24576, PS_OFF = 2 * RAWB, PSS = 1416, XWS = 72, XGS = 136, XW_OFF = PS_OFF + 16 * PSS * 2, XA_OFF = XW_OFF + 16 * XWS * 2, XG_OFF = XA_OFF + 16 * XWS * 2;
    LAS unsigned char* RAW = F.lds;
    LAS bf16_t* PS = (LAS bf16_t*)(F.lds + PS_OFF); LAS bf16_t* XW = (LAS bf16_t*)(F.lds + XW_OFF); LAS bf16_t* XA = (LAS bf16_t*)(F.lds + XA_OFF); LAS bf16_t* XG = (LAS bf16_t*)(F.lds + XG_OFF);
#define PREP_DMA(tile, buf) do { for (int m_ = w; m_ < 24; m_ += 8) { const int f_ = m_ * 64 + lane; int r_ = f_ / 88, ch_ = f_ % 88; int row_ = (tile) * 16 - 1 + r_; \
        if (f_ >= 1496 || row_ < 0) { row_ = 0; ch_ = 0; } \
        __builtin_amdgcn_global_load_lds((const unsigned*)(P + (size_t)row_ * INP + ch_ * 16), (LAS unsigned*)(RAW + (buf) * RAWB + m_ * 1024), 16, 0, 0); } } while (0)
    const int hd = w;
    const int wrow = hd * 64 + fr;
    const bf16_t* WU = (const bf16_t*)(F.ws + WS_WUPT) + (size_t)l * 384 * 64, *AU = (const bf16_t*)(F.ws + WS_AUPT) + (size_t)l * 384 * 64, *GU = (const bf16_t*)(F.ws + WS_GUPT) + (size_t)l * 384 * 128;
    u32x4 res[32];
#define WREG(nt, ks) __builtin_bit_cast(bf16x8, res[(nt) * 2 + (ks)])
#define AREG(nt, ks) __builtin_bit_cast(bf16x8, res[8 + (nt) * 2 + (ks)])
#define PW0(nt) __builtin_bit_cast(f32x4, res[16 + (nt)])
#define PA0(nt) __builtin_bit_cast(f32x4, res[20 + (nt)])
#define PKK(nt) __builtin_bit_cast(f32x4, res[24 + (nt)])
#define PKA(nt) __builtin_bit_cast(f32x4, res[28 + (nt)])
#define GFR(hl, ks, nt) __builtin_bit_cast(bf16x8, res[(hl) * 16 + (ks) * 4 + (nt)])
    if (w < 6) {
#pragma unroll
        for (int nt = 0; nt < 4; ++nt) {
#pragma unroll
            for (int ks = 0; ks < 2; ++ks) { res[nt * 2 + ks] = *(const u32x4*)(WU + (size_t)(wrow + nt * 16) * 64 + ks * 32 + fq * 8); res[8 + nt * 2 + ks] = *(const u32x4*)(AU + (size_t)(wrow + nt * 16) * 64 + ks * 32 + fq * 8); }
            const int ch0 = hd * 64 + nt * 16 + fq * 4;
            res[16 + nt] = *(const u32x4*)(p->rwkv_w0 + (size_t)l * RW + ch0); res[20 + nt] = *(const u32x4*)(p->rwkv_a0 + (size_t)l * RW + ch0); res[24 + nt] = *(const u32x4*)(p->rwkv_k_k + (size_t)l * RW + ch0); res[28 + nt] = *(const u32x4*)(p->rwkv_k_a + (size_t)l * RW + ch0);
        }
    }
    else {
#pragma unroll
        for (int hl = 0; hl < 2; ++hl)
#pragma unroll
            for (int ks = 0; ks < 4; ++ks)
#pragma unroll
                for (int nt = 0; nt < 4; ++nt) res[hl * 16 + ks * 4 + nt] = *(const u32x4*)(GU + (size_t)(((w - 6) * 3 + hl) * 64 + fr + nt * 16) * 128 + ks * 32 + fq * 8);
    }
    float* SWp = (float*)(F.ws + WS_SW); bf16_t* SAp = (bf16_t*)(F.ws + WS_SX); bf16_t* SBp = SAp + SARR / 2; bf16_t* SKp = SBp + SARR / 2; bf16_t* SRp = SKp + SARR / 2; bf16_t* SVp = SRp + SARR / 2;
    bf16_t* Gp = (bf16_t*)(F.ws + WS_G);
    LAS float* MU = (LAS float*)(F.lds + 114688);
    for (int i_ = tid; i_ < RCOLS; i_ += NTHREADS) MU[i_] = p->rwkv_mu[(size_t)l * RCOLS + i_];
    int tile = F.bid;
    if (tile < 2048) PREP_DMA(tile, 0);
    if (tile + F.G < 2048) PREP_DMA(tile + F.G, 1);
    int buf = 0;
    __syncthreads();
#pragma unroll 1
    for (; tile < 2048; tile += F.G, buf ^= 1) {
        const int row0 = tile * 16, b = row0 / SEQ, t0 = row0 % SEQ;
        LDS_BAR();
        const LAS unsigned char* raw = RAW + buf * RAWB;
#pragma unroll 1
        for (int idx = tid; idx < 16 * 88; idx += NTHREADS) {
            const int i = idx / 88, q = idx % 88, c0 = q * 16;
            const u32x4 cu = *(const LAS u32x4*)(raw + (i + 1) * 1408 + q * 16);
            u32x4 pv = *(const LAS u32x4*)(raw + i * 1408 + q * 16); if (t0 + i == 0) pv = (u32x4){0u, 0u, 0u, 0u};
            float cf[16], pf[16], sv[16]; unpack16f8(cu, cf, PINV); unpack16f8(pv, pf, PINV);
#pragma unroll
            for (int g4 = 0; g4 < 4; ++g4) { const f32x4 m4 = *(const LAS f32x4*)(MU + c0 + g4 * 4);
#pragma unroll
                for (int j = 0; j < 4; ++j) sv[g4 * 4 + j] = cf[g4 * 4 + j] + (pf[g4 * 4 + j] - cf[g4 * 4 + j]) * m4[j]; }
            LAS bf16_t* dst;
            if (c0 < 1152) dst = PS + i * PSS + c0;
            else if (c0 < 1216) { dst = XW + i * XWS + (c0 - 1152);
#pragma unroll
                for (int j = 0; j < 16; ++j) sv[j] = tanhf_(sv[j]); }
            else if (c0 < 1280) dst = XA + i * XWS + (c0 - 1216);
            else { dst = XG + i * XGS + (c0 - 1280);
#pragma unroll
                for (int j = 0; j < 16; ++j) sv[j] = sigmoidf_(sv[j]); }
            u32x4 o0, o1; o0.x = pack2(sv[0], sv[1]); o0.y = pack2(sv[2], sv[3]); o0.z = pack2(sv[4], sv[5]); o0.w = pack2(sv[6], sv[7]); o1.x = pack2(sv[8], sv[9]); o1.y = pack2(sv[10], sv[11]); o1.z = pack2(sv[12], sv[13]); o1.w = pack2(sv[14], sv[15]);
            *(LAS u32x4*)dst = o0; *(LAS u32x4*)(dst + 8) = o1;
        }
        __syncthreads();
        if (tile + 2 * F.G < 2048) PREP_DMA(tile + 2 * F.G, buf);
        if (w < 6) {
            const int i = fr;
            const size_t ob0 = (((size_t)b * RH + hd) * SEQ + t0) * 64;
            LAS unsigned char* sb = F.lds + 120320 + w * 4352; u32x2 kwv[4];
            f32x4 aw[4], aa[4];
#pragma unroll
            for (int nt = 0; nt < 4; ++nt) { aw[nt] = (f32x4){0.f, 0.f, 0.f, 0.f}; aa[nt] = (f32x4){0.f, 0.f, 0.f, 0.f}; }
#pragma unroll
            for (int ks = 0; ks < 2; ++ks) {
                const bf16x8 xw = *(const LAS bf16x8*)(XW + i * XWS + ks * 32 + fq * 8), xa = *(const LAS bf16x8*)(XA + i * XWS + ks * 32 + fq * 8);
#pragma unroll
                for (int nt = 0; nt < 4; ++nt) { aw[nt] = __builtin_amdgcn_mfma_f32_16x16x32_bf16(WREG(nt, ks), xw, aw[nt], 0, 0, 0); aa[nt] = __builtin_amdgcn_mfma_f32_16x16x32_bf16(AREG(nt, ks), xa, aa[nt], 0, 0, 0); }
            }
            float ss = 0.f;
#pragma unroll
            for (int nt = 0; nt < 4; ++nt) {
                const int ch0 = hd * 64 + nt * 16 + fq * 4;
                const u32x2 r2 = *(const LAS u32x2*)(PS + i * PSS + ch0), k2 = *(const LAS u32x2*)(PS + i * PSS + 384 + ch0), v2 = *(const LAS u32x2*)(PS + i * PSS + 768 + ch0);
                const float kf[4] = {bf2f(k2.x & 0xffffu), __uint_as_float(k2.x & 0xffff0000u), bf2f(k2.y & 0xffffu), __uint_as_float(k2.y & 0xffff0000u)};
                f32x4 wv; float kn[4];
#pragma unroll
                for (int j = 0; j < 4; ++j) {
                    const float z = PW0(nt)[j] + aw[nt][j]; wv[j] = __expf(-0.6065306597126334f * sigmoidf_(z));
                    const float a = sigmoidf_(PA0(nt)[j] + aa[nt][j]); aa[nt][j] = a;
                    const float kv = kf[j] * PKK(nt)[j]; aw[nt][j] = kv; ss += kv * kv;
                    kn[j] = kf[j] * (1.0f + (a - 1.0f) * PKA(nt)[j]);
                }
                *(LAS f32x4*)(sb + i * 272 + (nt * 16 + fq * 4) * 4) = wv;
                kwv[nt].x = pack2(kn[0], kn[1]); kwv[nt].y = pack2(kn[2], kn[3]);
            }
            asm volatile("" ::: "memory");
#pragma unroll
            for (int m = 0; m < 4; ++m) { const f32x4 v_ = *(const LAS f32x4*)(sb + (m * 4 + (lane >> 4)) * 272 + (lane & 15) * 16); *(f32x4*)(SWp + ob0 + (m * 64 + lane) * 4) = v_; }
            asm volatile("" ::: "memory");
#pragma unroll
            for (int nt = 0; nt < 4; ++nt) *(LAS u32x2*)(sb + i * 136 + (nt * 16 + fq * 4) * 2) = kwv[nt];
            asm volatile("" ::: "memory");
#pragma unroll
            for (int m = 0; m < 2; ++m) { const int rw_ = m * 8 + (lane >> 3), cb_ = (lane & 7) * 8;
                const u32x4 kq_ = *(const LAS u32x4*)(sb + rw_ * 136 + cb_ * 2), rq_ = *(const LAS u32x4*)(PS + rw_ * PSS + hd * 64 + cb_), vq_ = *(const LAS u32x4*)(PS + rw_ * PSS + 768 + hd * 64 + cb_);
                *(u32x4*)(SKp + ob0 + (m * 64 + lane) * 8) = kq_; *(u32x4*)(SRp + ob0 + (m * 64 + lane) * 8) = rq_; *(u32x4*)(SVp + ob0 + (m * 64 + lane) * 8) = vq_; }
            asm volatile("" ::: "memory");
            ss += shx(ss, 16, lane); ss += shx(ss, 32, lane);
            const float inv = 1.0f / fmaxf(sqrtf(ss), 1e-12f);
#pragma unroll
            for (int nt = 0; nt < 4; ++nt) {
                float av[4], bv[4];
#pragma unroll
                for (int j = 0; j < 4; ++j) { const float kq = aw[nt][j] * inv; av[j] = -kq; bv[j] = kq * aa[nt][j]; }
                u32x2 aw2; aw2.x = pack2(av[0], av[1]); aw2.y = pack2(av[2], av[3]); kwv[nt].x = pack2(bv[0], bv[1]); kwv[nt].y = pack2(bv[2], bv[3]);
                *(LAS u32x2*)(sb + i * 136 + (nt * 16 + fq * 4) * 2) = aw2;
            }
            asm volatile("" ::: "memory");
#pragma unroll
            for (int m = 0; m < 2; ++m) { const u32x4 q_ = *(const LAS u32x4*)(sb + (m * 8 + (lane >> 3)) * 136 + (lane & 7) * 16); *(u32x4*)(SAp + ob0 + (m * 64 + lane) * 8) = q_; }
            asm volatile("" ::: "memory");
#pragma unroll
            for (int nt = 0; nt < 4; ++nt) *(LAS u32x2*)(sb + i * 136 + (nt * 16 + fq * 4) * 2) = kwv[nt];
            asm volatile("" ::: "memory");
#pragma unroll
            for (int m = 0; m < 2; ++m) { const u32x4 q_ = *(const LAS u32x4*)(sb + (m * 8 + (lane >> 3)) * 136 + (lane & 7) * 16); *(u32x4*)(SBp + ob0 + (m * 64 + lane) * 8) = q_; }
            asm volatile("" ::: "memory");
        } else {
            const int i = fr; LAS unsigned char* sbg = F.lds + 120320 + w * 4352;
            bf16x8 xg[4];
#pragma unroll
            for (int ks = 0; ks < 4; ++ks) xg[ks] = *(const LAS bf16x8*)(XG + i * XGS + ks * 32 + fq * 8);
#pragma unroll
            for (int hl = 0; hl < 3; ++hl) {
                f32x4 ag[4];
#pragma unroll
                for (int nt = 0; nt < 4; ++nt) ag[nt] = (f32x4){0.f, 0.f, 0.f, 0.f};
#pragma unroll
                for (int ks = 0; ks < 4; ++ks)
#pragma unroll
                    for (int nt = 0; nt < 4; ++nt) { const bf16x8 gf = (hl < 2) ? GFR(hl & 1, ks, nt) : *(const bf16x8*)(GU + (size_t)(((w - 6) * 3 + 2) * 64 + fr + nt * 16) * 128 + ks * 32 + fq * 8);
                        ag[nt] = __builtin_amdgcn_mfma_f32_16x16x32_bf16(gf, xg[ks], ag[nt], 0, 0, 0); }
#pragma unroll
                for (int nt = 0; nt < 4; ++nt) { u32x2 gw; gw.x = pack2(ag[nt][0], ag[nt][1]); gw.y = pack2(ag[nt][2], ag[nt][3]); *(LAS u32x2*)(sbg + i * 136 + (nt * 16 + fq * 4) * 2) = gw; }
                asm volatile("" ::: "memory");
#pragma unroll
                for (int m = 0; m < 2; ++m) { const int rw_ = m * 8 + (lane >> 3); const u32x4 q_ = *(const LAS u32x4*)(sbg + rw_ * 136 + (lane & 7) * 16);
                    *(u32x4*)(Gp + (size_t)(row0 + rw_) * RW + ((w - 6) * 3 + hl) * 64 + (lane & 7) * 8) = q_; }
                asm volatile("" ::: "memory");
            }
        }
    }
#undef WREG
#undef AREG
#undef PW0
#undef PA0
#undef PKK
#undef PKA
#undef GFR
#undef PREP_DMA
    __syncthreads();
}

__device__ __forceinline__ void pool_tile(Frame& F, int l, int item) {
    const PP p = F.p; const int tid = F.tid, lane = F.lane, fr = lane & 15, fq = lane >> 4;
    const unsigned char* P = (const unsigned char*)(F.ws + WS_P);
    const int row0 = item * 64, t0 = row0 % SEQ;
    constexpr int PLS = 264;
    LAS float* U = (LAS float*)F.lds;
    LAS bf16_t* PL = (LAS bf16_t*)(F.lds + 81920);
#pragma unroll
    for (int it_ = 0; it_ < 3; ++it_) {
        const int idx = tid + it_ * NTHREADS; if (idx >= 79 * 16) break;
        const int r = idx >> 4, q = idx & 15, t = t0 - 15 + r; float f[16];
        if (t >= 0) { const u32x4 v = *(const u32x4*)(P + (size_t)(row0 - 15 + r) * INP + POOL_OFF + q * 16); unpack16f8(v, f, PINV); }
        else {
#pragma unroll
            for (int j = 0; j < 16; ++j) f[j] = 0.f;
        }
#pragma unroll
        for (int g4 = 0; g4 < 4; ++g4) *(LAS f32x4*)(U + r * 256 + q * 16 + g4 * 4) = (f32x4){f[g4 * 4], f[g4 * 4 + 1], f[g4 * 4 + 2], f[g4 * 4 + 3]};
    }
    __syncthreads();
    for (int idx = tid; idx < 64 * 64; idx += NTHREADS) {
        const int i = idx >> 6, c4 = (idx & 63) * 4, g = c4 >> 6, win = 2 << g, t = t0 + i;
        const int cnt = (t + 1 < win) ? t + 1 : win;
        f32x4 s = (f32x4){0.f, 0.f, 0.f, 0.f};
        for (int q = 0; q < cnt; ++q) s += *(const LAS f32x4*)(U + (15 + i - q) * 256 + c4);
        const f32x4 cur = *(const LAS f32x4*)(U + (15 + i) * 256 + c4);
        const float ic = 1.0f / (float)cnt;
        u32x2 w; w.x = pack2(s[0] * ic - cur[0], s[1] * ic - cur[1]); w.y = pack2(s[2] * ic - cur[2], s[3] * ic - cur[3]);
        *(LAS u32x2*)(PL + i * PLS + c4) = w;
    }
    __syncthreads();
    {
        const int g = F.wave >> 1; const bf16_t* PW = (const bf16_t*)(F.ws + WS_POOLWT) + ((size_t)l * 4 + g) * 64 * 64;
        bf16_t* MX = (bf16_t*)(F.ws + WS_H);
#pragma unroll
        for (int mq = 0; mq < 2; ++mq) {
            const int mt = (F.wave & 1) * 2 + mq;
            f32x4 acc[4];
#pragma unroll
            for (int nt = 0; nt < 4; ++nt) acc[nt] = (f32x4){0.f, 0.f, 0.f, 0.f};
#pragma unroll
            for (int ks = 0; ks < 2; ++ks) {
                const bf16x8 xf = *(const LAS bf16x8*)(PL + (mt * 16 + fr) * PLS + g * 64 + ks * 32 + fq * 8);
#pragma unroll
                for (int nt = 0; nt < 4; ++nt) { const bf16x8 wf = *(const bf16x8*)(PW + (size_t)(nt * 16 + fr) * 64 + ks * 32 + fq * 8); acc[nt] = __builtin_amdgcn_mfma_f32_16x16x32_bf16(wf, xf, acc[nt], 0, 0, 0); }
            }
            LAS unsigned char* sbp = F.lds + 120320 + F.wave * 4352;
#pragma unroll
            for (int nt = 0; nt < 4; ++nt) {
                const int d0 = nt * 16 + fq * 4; const f32x4 ps = *(const f32x4*)(p->pool_scale + (size_t)l * 256 + g * 64 + d0);
                u32x2 w; w.x = pack2(acc[nt][0] * ps[0], acc[nt][1] * ps[1]); w.y = pack2(acc[nt][2] * ps[2], acc[nt][3] * ps[3]);
                *(LAS u32x2*)(sbp + fr * 136 + d0 * 2) = w;
            }
            asm volatile("" ::: "memory");
#pragma unroll
            for (int m = 0; m < 2; ++m) { const int rw_ = m * 8 + (lane >> 3); const u32x4 q_ = *(const LAS u32x4*)(sbp + rw_ * 136 + (lane & 7) * 16);
                *(u32x4*)(MX + (size_t)(row0 + mt * 16 + rw_) * D + 768 + g * 64 + (lane & 7) * 8) = q_; }
            asm volatile("" ::: "memory");
        }
    }
    __syncthreads();
}

__device__ __forceinline__ void rwkv_scan_block(Frame& F, int blk) {
    const int tid = F.tid, lane = F.lane, w = F.wave, rs = lane >> 4, jg = lane & 15;
    const int bh = blk >> 1, half = blk & 1, b = bh / RH, h = bh % RH;
    const int rl = w * 4 + rs;
    const size_t base = (size_t)bh * SEQ * 64;
    const float* SWp = (const float*)(F.ws + WS_SW) + base;
    const unsigned char* SXp = F.ws + WS_SX + base * 2;
    float* YS = (float*)(F.ws + WS_YS);
    LAS unsigned char* opb = F.lds;
    LAS unsigned char* yb2 = F.lds + 98304;
    f32x4 pw; u32x4 pb[3];
    float S[4] = {0.f, 0.f, 0.f, 0.f};
#define SCAN_LOAD(c) do { pw = *(const f32x4*)(SWp + (size_t)(c) * 2048 + tid * 4); \
        _Pragma("unroll") for (int q = 0; q < 3; ++q) { const int idx = tid + NTHREADS * q; if (idx < 1280) { const int arr = idx >> 8, ch = idx & 255; \
            pb[q] = *(const u32x4*)(SXp + (size_t)arr * SARR + ((size_t)(c) * 2048 + ch * 8) * 2); } } } while (0)
#define SCAN_STORE(buf) do { *(LAS f32x4*)(opb + (buf) * 49152 + tid * 16) = pw; \
        _Pragma("unroll") for (int q = 0; q < 3; ++q) { const int idx = tid + NTHREADS * q; if (idx < 1280) { const int arr = idx >> 8, ch = idx & 255; float f[8]; unpack8(pb[q], f); \
            LAS unsigned char* d = opb + (buf) * 49152 + (1 + arr) * 8192 + ch * 32; *(LAS f32x4*)d = (f32x4){f[0], f[1], f[2], f[3]}; *(LAS f32x4*)(d + 16) = (f32x4){f[4], f[5], f[6], f[7]}; } } } while (0)
#define SCAN_OPS(st, W4, A4, B4, K4, R4, V1) do { W4 = *(const LAS f32x4*)(ob + (st) * 256); A4 = *(const LAS f32x4*)(ob + 8192 + (st) * 256); B4 = *(const LAS f32x4*)(ob + 16384 + (st) * 256); \
        K4 = *(const LAS f32x4*)(ob + 24576 + (st) * 256); R4 = *(const LAS f32x4*)(ob + 32768 + (st) * 256); V1 = *(const LAS float*)(vb + (st) * 256); } while (0)
    SCAN_LOAD(0); SCAN_STORE(0); __syncthreads();
#pragma unroll 1
    for (int c = 0; c < SEQ / 32; ++c) {
        const int buf = c & 1;
        if (c + 1 < SEQ / 32) SCAN_LOAD(c + 1);
        const LAS unsigned char* ob = opb + buf * 49152 + jg * 16;
        const LAS unsigned char* vb = opb + buf * 49152 + 5 * 8192 + (half * 32 + rl) * 4;
        float yk0 = 0.f, yk1 = 0.f;
        f32x4 cw, ca, cb, ck, cr; float cv;
        SCAN_OPS(0, cw, ca, cb, ck, cr, cv);
        float yp = 0.f;
#pragma unroll
        for (int st = 0; st < 32; ++st) {
            f32x4 nw = cw, na = ca, nb = cb, nk = ck, nr = cr; float nv = cv;
            if (st + 1 < 32) SCAN_OPS(st + 1, nw, na, nb, nk, nr, nv);
            float sa = S[0] * ca[0]; sa = __builtin_fmaf(S[1], ca[1], sa); sa = __builtin_fmaf(S[2], ca[2], sa); sa = __builtin_fmaf(S[3], ca[3], sa);
            sa += dpp_ror<8>(sa); yp += dpp_ror<8>(yp); sa += dpp_ror<4>(sa); yp += dpp_ror<4>(yp); sa += dpp_ror<2>(sa); yp += dpp_ror<2>(yp); sa += dpp_ror<1>(sa); yp += dpp_ror<1>(yp);
            if (st >= 1) { if (st - 1 < 16) yk0 = (jg == st - 1) ? yp : yk0; else yk1 = (jg == st - 17) ? yp : yk1; }
#pragma unroll
            for (int j = 0; j < 4; ++j) { float t_ = cv * ck[j]; t_ = __builtin_fmaf(sa, cb[j], t_); S[j] = __builtin_fmaf(S[j], cw[j], t_); asm volatile("" : "+v"(S[j])); }
            yp = S[0] * cr[0]; yp = __builtin_fmaf(S[1], cr[1], yp); yp = __builtin_fmaf(S[2], cr[2], yp); yp = __builtin_fmaf(S[3], cr[3], yp);
            cw = nw; ca = na; cb = nb; ck = nk; cr = nr; cv = nv;
        }
        yp = row16_sum(yp); yk1 = (jg == 15) ? yp : yk1;
        { LAS float* yo = (LAS float*)(yb2 + buf * 4096); yo[jg * 32 + rl] = yk0; yo[(16 + jg) * 32 + rl] = yk1; }
        if (c + 1 < SEQ / 32) SCAN_STORE(buf ^ 1);
        __syncthreads();
        if (tid < 256) { const int st = tid >> 3, c4 = tid & 7; const f32x4 yv = *(const LAS f32x4*)(yb2 + buf * 4096 + st * 128 + c4 * 16);
          *(f32x4*)(YS + ((size_t)b * SEQ + c * 32 + st) * RW + h * 64 + half * 32 + c4 * 4) = yv; }
    }
#undef SCAN_LOAD
#undef SCAN_STORE
#undef SCAN_OPS
    __syncthreads();
}

__device__ __forceinline__ void retention_item(Frame& F, int bh) {
    const int tid = F.tid, lane = F.lane, w = F.wave, fr = lane & 15, fq = lane >> 4;
    const int b = bh / RH, h = bh % RH;
    const unsigned char* P = (const unsigned char*)(F.ws + WS_P);
    const float* ROPE = (const float*)(F.ws + WS_ROPE);
    bf16_t* MX = (bf16_t*)(F.ws + WS_H);
    constexpr int QS = 72, TS = 136;
    LAS bf16_t* Qs = (LAS bf16_t*)F.lds;
    LAS bf16_t* Ks = (LAS bf16_t*)(F.lds + 18432);
    LAS bf16_t* KTs = (LAS bf16_t*)(F.lds + 36864);
    LAS bf16_t* VTs = (LAS bf16_t*)(F.lds + 54272);
    LAS bf16_t* Ps = (LAS bf16_t*)(F.lds + 71680);
    LAS bf16_t* RTs = (LAS bf16_t*)(F.lds + 106496);
    const float lg = log1pf(-exp2f(-5.0f - (float)h)), lg2 = lg * 1.4426950408889634f;
    const float cd = exp2f(lg2 * 128.0f);
    for (int i = tid; i < 64 * QS / 2; i += NTHREADS) ((LAS unsigned*)RTs)[i] = 0u;
    f32x4 Rreg[2] = {(f32x4){0.f, 0.f, 0.f, 0.f}, (f32x4){0.f, 0.f, 0.f, 0.f}};
    u32x2 rq0, rq1, rk0, rk1; u32x4 rvv; f32x4 rc0, rc1, rs0, rs1;
#define RET_LOAD(n_) do { const int tk_ = tid >> 2, c0_ = (tid & 3) * 8, pos_ = (n_) * 128 + tk_; const unsigned char* pb_ = P + (size_t)(b * SEQ + pos_) * INP + RET_OFF + h * 64; \
        rq0 = *(const u32x2*)(pb_ + c0_); rq1 = *(const u32x2*)(pb_ + 32 + c0_); rk0 = *(const u32x2*)(pb_ + 384 + c0_); rk1 = *(const u32x2*)(pb_ + 384 + 32 + c0_); rvv = *(const u32x4*)(pb_ + 768 + (tid & 3) * 16); \
        rc0 = *(const f32x4*)(ROPE + pos_ * 32 + c0_); rc1 = *(const f32x4*)(ROPE + pos_ * 32 + c0_ + 4); rs0 = *(const f32x4*)(ROPE + 65536 + pos_ * 32 + c0_); rs1 = *(const f32x4*)(ROPE + 65536 + pos_ * 32 + c0_ + 4); } while (0)
    RET_LOAD(0);
    for (int n = 0; n < SEQ / 128; ++n) {
        const int tok0 = b * SEQ + n * 128;
        LDS_BAR();
        {
            const int tk = tid >> 2, part = tid & 3, c0 = part * 8;
            float ql[8], qh[8], kl[8], kh[8], cs[8], sn[8];
            unpack8f8(rq0, ql, PINV); unpack8f8(rq1, qh, PINV);
            unpack8f8(rk0, kl, PINV); unpack8f8(rk1, kh, PINV);
            { const f32x4 c_0 = rc0, c_1 = rc1, s_0 = rs0, s_1 = rs1;
#pragma unroll
              for (int j = 0; j < 4; ++j) { cs[j] = c_0[j]; cs[4 + j] = c_1[j]; sn[j] = s_0[j]; sn[4 + j] = s_1[j]; } }
            float q1[8], q2[8], k1[8], k2[8];
#pragma unroll
            for (int j = 0; j < 8; ++j) { q1[j] = ql[j] * cs[j] - qh[j] * sn[j]; q2[j] = ql[j] * sn[j] + qh[j] * cs[j]; k1[j] = (kl[j] * cs[j] - kh[j] * sn[j]) * 0.125f; k2[j] = (kl[j] * sn[j] + kh[j] * cs[j]) * 0.125f; }
            *(LAS u32x4*)(Qs + tk * QS + c0) = pack8(q1); *(LAS u32x4*)(Qs + tk * QS + 32 + c0) = pack8(q2);
            *(LAS u32x4*)(Ks + tk * QS + c0) = pack8(k1); *(LAS u32x4*)(Ks + tk * QS + 32 + c0) = pack8(k2);
            const float zeta = exp2f(lg2 * (float)(127 - tk));
#pragma unroll
            for (int j = 0; j < 8; ++j) { KTs[(c0 + j) * TS + tk] = (bf16_t)f2bf(k1[j] * zeta); KTs[(32 + c0 + j) * TS + tk] = (bf16_t)f2bf(k2[j] * zeta); }
            { float vf[16]; unpack16f8(rvv, vf, PINV);
#pragma unroll
              for (int j = 0; j < 16; ++j) VTs[(part * 16 + j) * TS + tk] = (bf16_t)f2bf(vf[j]); }
        }
        if (n + 1 < SEQ / 128) RET_LOAD(n + 1);
        LDS_BAR();
        const int i0 = 16 * w;
        f32x4 yc[4];
        unsigned gq[4];
#pragma unroll
        for (int et = 0; et < 4; ++et) gq[et] = *(const unsigned*)(P + ((size_t)tok0 + i0 + fr) * INP + RET_OFF + 1152 + h * 64 + et * 16 + fq * 4);
        {
            bf16x8 qf[2];
#pragma unroll
            for (int ks = 0; ks < 2; ++ks) qf[ks] = *(const LAS bf16x8*)(Qs + (i0 + fr) * QS + ks * 32 + fq * 8);
            for (int jt = 0; jt <= w; ++jt) {
                f32x4 a = (f32x4){0.f, 0.f, 0.f, 0.f};
#pragma unroll
                for (int ks = 0; ks < 2; ++ks) { const bf16x8 kf = *(const LAS bf16x8*)(Ks + (jt * 16 + fr) * QS + ks * 32 + fq * 8); a = __builtin_amdgcn_mfma_f32_16x16x32_bf16(kf, qf[ks], a, 0, 0, 0); }
                const int i = i0 + fr, j0 = jt * 16 + fq * 4; float o[4];
#pragma unroll
                for (int r = 0; r < 4; ++r) { const int dd = i - (j0 + r); o[r] = (dd >= 0) ? a[r] * exp2f(lg2 * (float)dd) : 0.f; }
                u32x2 pw2; pw2.x = pack2(o[0], o[1]); pw2.y = pack2(o[2], o[3]); *(LAS u32x2*)(Ps + i * TS + j0) = pw2;
            }
            if ((w & 1) == 0) { *(LAS u32x2*)(Ps + (i0 + fr) * TS + (w + 1) * 16 + fq * 4) = (u32x2){0u, 0u}; }
#pragma unroll
            for (int et = 0; et < 4; ++et) { f32x4 a = (f32x4){0.f, 0.f, 0.f, 0.f};
#pragma unroll
                for (int ks = 0; ks < 2; ++ks) { const bf16x8 rf = *(const LAS bf16x8*)(RTs + (et * 16 + fr) * QS + ks * 32 + fq * 8); a = __builtin_amdgcn_mfma_f32_16x16x32_bf16(rf, qf[ks], a, 0, 0, 0); }
                yc[et] = a; }
        }
        LDS_BAR();
        {
            f32x4 y[4];
#pragma unroll
            for (int et = 0; et < 4; ++et) y[et] = (f32x4){0.f, 0.f, 0.f, 0.f};
            const int kmax = (i0 + 15) >> 5;
            for (int ks = 0; ks <= kmax; ++ks) {
                const bf16x8 pf = *(const LAS bf16x8*)(Ps + (i0 + fr) * TS + ks * 32 + fq * 8);
#pragma unroll
                for (int et = 0; et < 4; ++et) { const bf16x8 vf = *(const LAS bf16x8*)(VTs + (et * 16 + fr) * TS + ks * 32 + fq * 8); y[et] = __builtin_amdgcn_mfma_f32_16x16x32_bf16(vf, pf, y[et], 0, 0, 0); }
            }
            const float xi = exp2f(lg2 * (float)(i0 + fr + 1)); float ss = 0.f;
#pragma unroll
            for (int et = 0; et < 4; ++et)
#pragma unroll
                for (int r = 0; r < 4; ++r) { const float v = y[et][r] + xi * yc[et][r]; y[et][r] = v; ss += v * v; }
            ss += shx(ss, 16, lane); ss += shx(ss, 32, lane);
            const float rn = rsqrtf(ss * (1.0f / 64.0f) + 1e-6f);
            const size_t row = (size_t)tok0 + i0 + fr;
#pragma unroll
            for (int et = 0; et < 4; ++et) {
                const int e0 = et * 16 + fq * 4; float gf[4]; unpack4f8(gq[et], gf, PINV); float o[4];
#pragma unroll
                for (int r = 0; r < 4; ++r) o[r] = gf[r] * sigmoidf_(gf[r]) * y[et][r] * rn;
                u32x2 w2; w2.x = pack2(o[0], o[1]); w2.y = pack2(o[2], o[3]); *(u32x2*)(MX + row * D + 384 + h * 64 + e0) = w2;
            }
        }
        {
#pragma unroll
            for (int s = 0; s < 2; ++s) {
                const int tt = 2 * w + s, dt = tt >> 2, et = tt & 3; f32x4 a = (f32x4){0.f, 0.f, 0.f, 0.f};
#pragma unroll
                for (int ks = 0; ks < 4; ++ks) { const bf16x8 kf = *(const LAS bf16x8*)(KTs + (dt * 16 + fr) * TS + ks * 32 + fq * 8), vf = *(const LAS bf16x8*)(VTs + (et * 16 + fr) * TS + ks * 32 + fq * 8);
                    a = __builtin_amdgcn_mfma_f32_16x16x32_bf16(kf, vf, a, 0, 0, 0); }
                Rreg[s] = Rreg[s] * cd + a;
                u32x2 w2; w2.x = pack2(Rreg[s][0], Rreg[s][1]); w2.y = pack2(Rreg[s][2], Rreg[s][3]);
                *(LAS u32x2*)(RTs + (et * 16 + fr) * QS + dt * 16 + fq * 4) = w2;
            }
        }
    }
    __syncthreads();
}
#undef RET_LOAD


typedef short bf16x4 __attribute__((ext_vector_type(4)));
__device__ __forceinline__ bf16x4 cvt4(const f32x4 v) { u32x2 w; w.x = pack2(v[0], v[1]); w.y = pack2(v[2], v[3]); return __builtin_bit_cast(bf16x4, w); }
__device__ __forceinline__ bf16x8 cvt8(const f32x4 a, const f32x4 b) { u32x4 w; w.x = pack2(a[0], a[1]); w.y = pack2(a[2], a[3]); w.z = pack2(b[0], b[1]); w.w = pack2(b[2], b[3]); return __builtin_bit_cast(bf16x8, w); }
__device__ __forceinline__ f32x4 mm4(const f32x4 fat, const f32x4 fb, f32x4 c) {
#pragma unroll
    for (int i = 0; i < 4; ++i) c = __builtin_amdgcn_mfma_f32_16x16x4f32(fat[i], fb[i], c, 0, 0, 0);
    return c;
}
constexpr int CK_IMG = 8 * 272;
constexpr int CK_AH = 0, CK_RH = CK_IMG, CK_T = 2 * CK_IMG, CK_ARB = CK_T + 512, CK_BT = CK_ARB + 512, CK_KT = CK_BT + 2048, CK_PL = CK_KT + 2048, CK_V = CK_PL + 256, CK_CAK = CK_V + 2048, CK_CRK = CK_CAK + 2048, CK_BYTES = CK_CRK + 2048;
constexpr int CK_STG = 8 * CK_BYTES;
static_assert(CK_STG + 8 * 2 * CK_IMG <= MISC_OFF, "chunk images exceed LDS");

struct ChunkRaw { float w[16]; unsigned a[16], b[16], k[16], r[16], v[16]; };
__device__ __forceinline__ void rwkv_chunk_load(ChunkRaw& R, const int lane, const float* SWp, const bf16_t* SXp, const int t0) {
    const float* wp = SWp + (size_t)t0 * 64 + lane;
    const bf16_t* ap = SXp + (size_t)t0 * 64 + lane, *bp = ap + SARR / 2, *kp = bp + SARR / 2, *rp = kp + SARR / 2, *vp = rp + SARR / 2;
#pragma unroll
    for (int t = 0; t < 16; ++t) { R.w[t] = wp[t * 64]; R.a[t] = ap[t * 64]; R.b[t] = bp[t * 64]; R.k[t] = kp[t * 64]; R.r[t] = rp[t * 64]; R.v[t] = vp[t * 64]; }
}
__device__ __forceinline__ void rwkv_chunk_prep(const ChunkRaw& R, const int lane, LAS unsigned char* pk, LAS unsigned char* stg) {
    const int c = lane, cp = c & 31;
    const int ahb = ((c >> 5) * 4 + ((cp & 15) >> 2)) * 272 + ((cp >> 4) * 4 + (cp & 3)) * 2;
    const int btb = ((c >> 4) * 64 + (c & 15)) * 8;
    float P[16];
    { float run = 1.0f;
#pragma unroll
      for (int t = 0; t < 16; ++t) { run *= R.w[t]; P[t] = run; } }
    const float PL = P[15];
    *(LAS float*)(pk + CK_PL + c * 4) = PL;
#pragma unroll
    for (int kg = 0; kg < 4; ++kg) {
        float btv[4], ktv[4], vv[4];
#pragma unroll
        for (int i2 = 0; i2 < 4; i2 += 2) {
            float ah[2], rh[2], bh[2], kh[2];
#pragma unroll
            for (int u = 0; u < 2; ++u) {
                const int i = i2 + u, t = kg * 4 + i;
                const float a = bf2f(R.a[t]), b = bf2f(R.b[t]), k = bf2f(R.k[t]), r = bf2f(R.r[t]);
                const float Pi = __builtin_amdgcn_rcpf(P[t]), Pm = (t == 0) ? 1.0f : P[t == 0 ? 0 : t - 1], Pe = PL * Pi;
                ah[u] = a * Pm; rh[u] = r * P[t]; bh[u] = b * Pi; kh[u] = k * Pi;
                btv[i] = b * Pe; ktv[i] = k * Pe; vv[i] = bf2f(R.v[t]);
            }
            const int t = kg * 4 + i2;
            const unsigned pa = pack2(ah[0], ah[1]), pr = pack2(rh[0], rh[1]), pb = pack2(bh[0], bh[1]), pkk = pack2(kh[0], kh[1]);
            *(LAS unsigned short*)(pk + CK_AH + ahb + t * 16) = (unsigned short)pa; *(LAS unsigned short*)(pk + CK_AH + ahb + t * 16 + 16) = (unsigned short)(pa >> 16);
            *(LAS unsigned short*)(pk + CK_RH + ahb + t * 16) = (unsigned short)pr; *(LAS unsigned short*)(pk + CK_RH + ahb + t * 16 + 16) = (unsigned short)(pr >> 16);
            *(LAS unsigned short*)(stg + ahb + t * 16) = (unsigned short)pb; *(LAS unsigned short*)(stg + ahb + t * 16 + 16) = (unsigned short)(pb >> 16);
            *(LAS unsigned short*)(stg + CK_IMG + ahb + t * 16) = (unsigned short)pkk; *(LAS unsigned short*)(stg + CK_IMG + ahb + t * 16 + 16) = (unsigned short)(pkk >> 16);
        }
        u32x2 w0, w1, w2; w0.x = pack2(btv[0], btv[1]); w0.y = pack2(btv[2], btv[3]); w1.x = pack2(ktv[0], ktv[1]); w1.y = pack2(ktv[2], ktv[3]); w2.x = pack2(vv[0], vv[1]); w2.y = pack2(vv[2], vv[3]);
        *(LAS u32x2*)(pk + CK_BT + btb + kg * 128) = w0; *(LAS u32x2*)(pk + CK_KT + btb + kg * 128) = w1; *(LAS u32x2*)(pk + CK_V + btb + kg * 128) = w2;
    }
    asm volatile("s_waitcnt lgkmcnt(0)" ::: "memory");
    const int n = lane & 15, kg4 = (lane >> 4) * 4;
    const f32x4 z4 = (f32x4){0.f, 0.f, 0.f, 0.f};
    f32x4 FN, FNT, FARB, FAAK, FARK;
    { bf16x8 ah[2], rh[2], bh[2], kh[2];
#pragma unroll
      for (int s_ = 0; s_ < 2; ++s_) { const int io = (s_ * 4 + (lane >> 4)) * 272 + (lane & 15) * 16;
          ah[s_] = *(const LAS bf16x8*)(pk + CK_AH + io); rh[s_] = *(const LAS bf16x8*)(pk + CK_RH + io);
          bh[s_] = *(const LAS bf16x8*)(stg + io); kh[s_] = *(const LAS bf16x8*)(stg + CK_IMG + io); }
      FN = z4; FNT = z4; FARB = z4; FAAK = z4; FARK = z4;
#pragma unroll
      for (int s_ = 0; s_ < 2; ++s_) {
          FN   = __builtin_amdgcn_mfma_f32_16x16x32_bf16(ah[s_], bh[s_], FN, 0, 0, 0);
          FNT  = __builtin_amdgcn_mfma_f32_16x16x32_bf16(bh[s_], ah[s_], FNT, 0, 0, 0);
          FARB = __builtin_amdgcn_mfma_f32_16x16x32_bf16(bh[s_], rh[s_], FARB, 0, 0, 0);
          FAAK = __builtin_amdgcn_mfma_f32_16x16x32_bf16(kh[s_], ah[s_], FAAK, 0, 0, 0);
          FARK = __builtin_amdgcn_mfma_f32_16x16x32_bf16(kh[s_], rh[s_], FARK, 0, 0, 0);
      } }
    f32x4 ID;
#pragma unroll
    for (int i = 0; i < 4; ++i) {
        const int m = kg4 + i;
        FN[i] = (n < m) ? FN[i] : 0.f;
        FNT[i] = (m < n) ? FNT[i] : 0.f; FAAK[i] = (m < n) ? FAAK[i] : 0.f;
        FARB[i] = (m <= n) ? FARB[i] : 0.f; FARK[i] = (m <= n) ? FARK[i] : 0.f;
        ID[i] = (m == n) ? 1.0f : 0.f;
    }
    const f32x4 FN2 = mm4(FNT, FN, z4), FN2T = mm4(FN, FNT, z4);
    const f32x4 FN4 = mm4(FN2T, FN2, z4), FN4T = mm4(FN2, FN2T, z4);
    const f32x4 FN8T = mm4(FN4, FN4T, z4);
    const f32x4 FQ1 = ID + FNT, FQ1T = ID + FN;
    const f32x4 FQ2 = mm4(FQ1T, FN2T, FQ1), FQ2T = mm4(FQ1, FN2, FQ1T);
    const f32x4 FQ3 = mm4(FQ2T, FN4T, FQ2), FQ3T = mm4(FQ2, FN4, FQ2T);
    const f32x4 FTT = mm4(FQ3T, FN8T, FQ3);
    *(LAS bf16x4*)(pk + CK_T + lane * 8) = cvt4(FTT);
    *(LAS bf16x4*)(pk + CK_ARB + lane * 8) = cvt4(FARB);
    const bf16x4 aak = cvt4(FAAK), ark = cvt4(FARK);
#pragma unroll
    for (int q = 0; q < 4; ++q) {
        const bf16x4 vq = *(const LAS bf16x4*)(pk + CK_V + (q * 64 + lane) * 8);
        const f32x4 cak = __builtin_amdgcn_mfma_f32_16x16x16bf16_1k(aak, vq, z4, 0, 0, 0), crk = __builtin_amdgcn_mfma_f32_16x16x16bf16_1k(ark, vq, z4, 0, 0, 0);
        *(LAS bf16x4*)(pk + CK_CAK + (q * 64 + lane) * 8) = cvt4(cak); *(LAS bf16x4*)(pk + CK_CRK + (q * 64 + lane) * 8) = cvt4(crk);
    }
}

struct ChunkEarly { bf16x8 ah0, ah1, rh0, rh1; bf16x4 top; u32x2 cak; };
struct ChunkLate { bf16x4 arb, vop, bt[4], kt[4]; f32x4 pl[4]; u32x2 crk; };
__device__ __forceinline__ void rwkv_chunk_early(ChunkEarly& O, const LAS unsigned char* pk, const int q, const int lane) {
    const int io = (lane >> 4) * 272 + (lane & 15) * 16;
    O.ah0 = *(const LAS bf16x8*)(pk + CK_AH + io); O.ah1 = *(const LAS bf16x8*)(pk + CK_AH + io + 4 * 272);
    O.rh0 = *(const LAS bf16x8*)(pk + CK_RH + io); O.rh1 = *(const LAS bf16x8*)(pk + CK_RH + io + 4 * 272);
    O.cak = *(const LAS u32x2*)(pk + CK_CAK + (q * 64 + lane) * 8); O.top = *(const LAS bf16x4*)(pk + CK_T + lane * 8);
}
__device__ __forceinline__ void rwkv_chunk_late(ChunkLate& O, const LAS unsigned char* pk, const int q, const int lane) {
    O.arb = *(const LAS bf16x4*)(pk + CK_ARB + lane * 8); O.vop = *(const LAS bf16x4*)(pk + CK_V + (q * 64 + lane) * 8);
    O.crk = *(const LAS u32x2*)(pk + CK_CRK + (q * 64 + lane) * 8);
#pragma unroll
    for (int mt = 0; mt < 4; ++mt) { O.pl[mt] = *(const LAS f32x4*)(pk + CK_PL + (mt * 16 + (lane >> 4) * 4) * 4);
        O.bt[mt] = *(const LAS bf16x4*)(pk + CK_BT + (mt * 64 + lane) * 8); O.kt[mt] = *(const LAS bf16x4*)(pk + CK_KT + (mt * 64 + lane) * 8); }
}

__device__ __forceinline__ void rwkv_chunk_block(Frame& F, int bh) {
    const int lane = F.lane, w = F.wave;
    const int b = bh / RH, h = bh % RH;
    const size_t base = (size_t)bh * SEQ * 64;
    const float* SWp = (const float*)(F.ws + WS_SW) + base;
    const bf16_t* SXp = (const bf16_t*)(F.ws + WS_SX) + base;
    float* YSp = (float*)(F.ws + WS_YS) + (size_t)b * SEQ * RW + h * 64 + w * 16 + (lane & 15);
    f32x4 Sacc[4];
#pragma unroll
    for (int mt = 0; mt < 4; ++mt) Sacc[mt] = (f32x4){0.f, 0.f, 0.f, 0.f};
    const f32x4 z4 = (f32x4){0.f, 0.f, 0.f, 0.f};
    ChunkRaw R; rwkv_chunk_load(R, lane, SWp, SXp, w * 16);
#pragma unroll 1
    for (int grp = 0; grp < SEQ / 128; ++grp) {
#pragma unroll
        for (int t = 0; t < 16; ++t) asm volatile("" : "+v"(R.v[t]));
        rwkv_chunk_prep(R, lane, F.lds + w * CK_BYTES, F.lds + CK_STG + w * 2 * CK_IMG);
        if (grp + 1 < SEQ / 128) rwkv_chunk_load(R, lane, SWp, SXp, (grp + 1) * 128 + w * 16);
        LDS_BAR();
        if (w < 4) {
            ChunkEarly C; rwkv_chunk_early(C, F.lds, w, lane);
#pragma unroll 1
            for (int g = 0; g < 8; ++g) {
                ChunkLate Lt; rwkv_chunk_late(Lt, F.lds + g * CK_BYTES, w, lane);
                ChunkEarly N = C;
                if (g + 1 < 8) rwkv_chunk_early(N, F.lds + (g + 1) * CK_BYTES, w, lane);
                const bf16x8 s0 = cvt8(Sacc[0], Sacc[1]), s1 = cvt8(Sacc[2], Sacc[3]);
                f32x4 W1 = __builtin_amdgcn_mfma_f32_16x16x32_bf16(C.ah0, s0, z4, 0, 0, 0); W1 = __builtin_amdgcn_mfma_f32_16x16x32_bf16(C.ah1, s1, W1, 0, 0, 0);
                f32x4 Y = __builtin_amdgcn_mfma_f32_16x16x32_bf16(C.rh0, s0, z4, 0, 0, 0); Y = __builtin_amdgcn_mfma_f32_16x16x32_bf16(C.rh1, s1, Y, 0, 0, 0);
                W1[0] += bf2f(C.cak.x & 0xffffu); W1[1] += __uint_as_float(C.cak.x & 0xffff0000u); W1[2] += bf2f(C.cak.y & 0xffffu); W1[3] += __uint_as_float(C.cak.y & 0xffff0000u);
                const f32x4 U = __builtin_amdgcn_mfma_f32_16x16x16bf16_1k(C.top, cvt4(W1), z4, 0, 0, 0);
                const bf16x4 uop = cvt4(U);
#pragma unroll
                for (int mt = 0; mt < 4; ++mt) {
                    f32x4 a_;
#pragma unroll
                    for (int i = 0; i < 4; ++i) { float v_ = Sacc[mt][i] * Lt.pl[mt][i]; asm volatile("" : "+v"(v_)); a_[i] = v_; }
                    a_ = __builtin_amdgcn_mfma_f32_16x16x16bf16_1k(Lt.kt[mt], Lt.vop, a_, 0, 0, 0);
                    a_ = __builtin_amdgcn_mfma_f32_16x16x16bf16_1k(Lt.bt[mt], uop, a_, 0, 0, 0);
                    Sacc[mt] = a_;
                }
                Y = __builtin_amdgcn_mfma_f32_16x16x16bf16_1k(Lt.arb, uop, Y, 0, 0, 0);
                Y[0] += bf2f(Lt.crk.x & 0xffffu); Y[1] += __uint_as_float(Lt.crk.x & 0xffff0000u); Y[2] += bf2f(Lt.crk.y & 0xffffu); Y[3] += __uint_as_float(Lt.crk.y & 0xffff0000u);
                { float* yo = YSp + (size_t)(grp * 128 + g * 16 + (lane >> 4) * 4) * RW;
#pragma unroll
                  for (int i = 0; i < 4; ++i) yo[(size_t)i * RW] = Y[i]; }
                C = N;
            }
        }
        LDS_BAR();
    }
}

__device__ __forceinline__ void phase_rwkv_post(Frame& F, int l) {
    const PP p = F.p; const int lane = F.lane;
    const float* YS = (const float*)(F.ws + WS_YS); const bf16_t* SKp = (const bf16_t*)(F.ws + WS_SX) + 2 * (SARR / 2); const bf16_t* SRp = SKp + SARR / 2; const bf16_t* SVp = SRp + SARR / 2;
    const bf16_t* Gp = (const bf16_t*)(F.ws + WS_G); bf16_t* MX = (bf16_t*)(F.ws + WS_H);
    const float lw_[6] = {p->rwkv_lnx_w[(size_t)l * RW + lane], p->rwkv_lnx_w[(size_t)l * RW + 64 + lane], p->rwkv_lnx_w[(size_t)l * RW + 128 + lane], p->rwkv_lnx_w[(size_t)l * RW + 192 + lane], p->rwkv_lnx_w[(size_t)l * RW + 256 + lane], p->rwkv_lnx_w[(size_t)l * RW + 320 + lane]};
    (void)lw_;
#pragma unroll 1
    for (int it0 = (F.bid * 8 + F.wave) * 4; it0 < NTOK * RH; it0 += F.G * 8 * 4) {
        float y[4], r[4], k[4], v[4], g[4], lw[4], lb[4], rk[4]; int tokv[4], chv[4];
#pragma unroll
        for (int q = 0; q < 4; ++q) {
            const int it = it0 + q, tok = it / RH, h = it % RH, b = tok / SEQ, t = tok % SEQ, ch = h * 64 + lane;
            const size_t so = (((size_t)b * RH + h) * SEQ + t) * 64 + lane;
            tokv[q] = tok; chv[q] = ch;
            y[q] = YS[(size_t)tok * RW + ch]; r[q] = bf2f(SRp[so]); k[q] = bf2f(SKp[so]); v[q] = bf2f(SVp[so]); g[q] = bf2f(Gp[(size_t)tok * RW + ch]);
            lw[q] = p->rwkv_lnx_w[(size_t)l * RW + ch]; lb[q] = p->rwkv_lnx_b[(size_t)l * RW + ch]; rk[q] = p->rwkv_r_k[(size_t)l * RW + ch];
        }
#pragma unroll
        for (int q = 0; q < 4; ++q) {
            const float mean = wave_sum(y[q], lane) * (1.0f / 64.0f); const float d = y[q] - mean; const float var = wave_sum(d * d, lane) * (1.0f / 64.0f);
            const float yn = d * rsqrtf(var + 64e-5f) * lw[q] + lb[q];
            const float bonus = wave_sum(r[q] * k[q] * rk[q], lane) * v[q];
            MX[(size_t)tokv[q] * D + chv[q]] = (bf16_t)f2bf((yn + bonus) * g[q]);
        }
    }
}

__device__ __forceinline__ void phase_norm2_router(Frame& F, int l, bool count) {
    const PP p = F.p; const int tid = F.tid, lane = F.lane, w = F.wave, fr = lane & 15, fq = lane >> 4;
    const bf16_t* XBp = (const bf16_t*)(F.ws + WS_XB); bf16_t* H = (bf16_t*)(F.ws + WS_H);
    const float* mod_l = (const float*)(F.ws + WS_MOD) + (size_t)l * 16 * 6144;
    constexpr int HS = 1032;
    LAS bf16_t* HI = (LAS bf16_t*)F.lds;
    LAS bf16_t* LO = (LAS bf16_t*)(F.lds + 66048);
    LAS float* PART = (LAS float*)F.lds;
    LAS float* LG = (LAS float*)(F.lds + 132096);
    LAS unsigned* HIST = (LAS unsigned*)(F.lds + 132096 + 8192);
    LAS float* TA = (LAS float*)(F.lds + 132096 + 8192 + 256);
    LAS float* TB = TA + 1024;
#define STAGE_MOD2(tile_) do { if (tid < 256 && (tile_) < 1024) { const int b_ = ((tile_) * 32) / SEQ, c_ = tid * 4; \
        const f32x4 gg = *(const f32x4*)(p->norm2_g + (size_t)l * D + c_), sc = *(const f32x4*)(mod_l + (size_t)b_ * 6144 + 4096 + c_), sh = *(const f32x4*)(mod_l + (size_t)b_ * 6144 + 3072 + c_); \
        *(LAS f32x4*)(TA + c_) = (f32x4){gg[0] * (1.0f + sc[0]), gg[1] * (1.0f + sc[1]), gg[2] * (1.0f + sc[2]), gg[3] * (1.0f + sc[3])}; *(LAS f32x4*)(TB + c_) = sh; } } while (0)
    bf16x8 bh[4][4], bl[4][4];
    { const bf16_t* WH = (const bf16_t*)(F.ws + WS_WRT) + (size_t)l * 2 * 64 * 1024, *WL = WH + 64 * 1024;
#pragma unroll
      for (int nt = 0; nt < 4; ++nt)
#pragma unroll
          for (int ks = 0; ks < 4; ++ks) { bh[nt][ks] = *(const bf16x8*)(WH + (size_t)(nt * 16 + fr) * 1024 + w * 128 + ks * 32 + fq * 8); bl[nt][ks] = *(const bf16x8*)(WL + (size_t)(nt * 16 + fr) * 1024 + w * 128 + ks * 32 + fq * 8); } }
    const float bias = p->router_bias[(size_t)l * NE + lane];
    STAGE_MOD2(F.bid);
    __syncthreads();
#pragma unroll 1
    for (int tile = F.bid; tile < 1024; tile += F.G) {
        const int row0 = tile * 32;
        GPTR wsg_ = (GPTR)F.ws; asm volatile("" : "+s"(wsg_)); unsigned char* wsl = (unsigned char*)wsg_;
        if (tid < 64) HIST[tid] = 0u;
#pragma unroll 1
        for (int qq = 0; qq < 4; qq += 2) {
            u32x2 xr[2][4];
#pragma unroll
            for (int q = 0; q < 2; ++q)
#pragma unroll
                for (int u = 0; u < 4; ++u) xr[q][u] = *(const u32x2*)(XBp + (size_t)(row0 + w * 4 + qq + q) * D + u * 256 + lane * 4);
#pragma unroll
            for (int q = 0; q < 2; ++q) {
                const int i = w * 4 + qq + q, row = row0 + i; float ss = 0.f;
#pragma unroll
                for (int u = 0; u < 4; ++u) { const float x0 = bf2f(xr[q][u].x & 0xffffu), x1 = __uint_as_float(xr[q][u].x & 0xffff0000u), x2 = bf2f(xr[q][u].y & 0xffffu), x3 = __uint_as_float(xr[q][u].y & 0xffff0000u); ss += x0 * x0 + x1 * x1 + x2 * x2 + x3 * x3; }
                ss = wave_sum(ss, lane); const float rstd = rsqrtf(ss * (1.0f / D) + 1e-6f);
#pragma unroll
                for (int u = 0; u < 4; ++u) { const int c0 = u * 256 + lane * 4; const f32x4 ta = *(const LAS f32x4*)(TA + c0), tb = *(const LAS f32x4*)(TB + c0);
                    const float xq[4] = {bf2f(xr[q][u].x & 0xffffu), __uint_as_float(xr[q][u].x & 0xffff0000u), bf2f(xr[q][u].y & 0xffffu), __uint_as_float(xr[q][u].y & 0xffff0000u)};
                    float o[4], lo[4]; unsigned hb[4];
#pragma unroll
                    for (int j = 0; j < 4; ++j) { o[j] = xq[j] * rstd * ta[j] + tb[j]; hb[j] = f2bf(o[j]); lo[j] = o[j] - bf2f(hb[j]); }
                    u32x2 wh; wh.x = hb[0] | (hb[1] << 16); wh.y = hb[2] | (hb[3] << 16); *(u32x2*)(H + (size_t)row * D + c0) = wh; *(LAS u32x2*)(HI + i * HS + c0) = wh;
                    u32x2 wl; wl.x = pack2(lo[0], lo[1]); wl.y = pack2(lo[2], lo[3]); *(LAS u32x2*)(LO + i * HS + c0) = wl; }
            }
        }
        __syncthreads();
        f32x4 acc[2][4];
#pragma unroll
        for (int mt = 0; mt < 2; ++mt) {
#pragma unroll
            for (int nt = 0; nt < 4; ++nt) acc[mt][nt] = (f32x4){0.f, 0.f, 0.f, 0.f};
#pragma unroll
            for (int ks = 0; ks < 4; ++ks) {
                const bf16x8 ah = *(const LAS bf16x8*)(HI + (mt * 16 + fr) * HS + w * 128 + ks * 32 + fq * 8), al = *(const LAS bf16x8*)(LO + (mt * 16 + fr) * HS + w * 128 + ks * 32 + fq * 8);
#pragma unroll
                for (int nt = 0; nt < 4; ++nt) {
                    acc[mt][nt] = __builtin_amdgcn_mfma_f32_16x16x32_bf16(ah, bh[nt][ks], acc[mt][nt], 0, 0, 0);
                    acc[mt][nt] = __builtin_amdgcn_mfma_f32_16x16x32_bf16(al, bh[nt][ks], acc[mt][nt], 0, 0, 0);
                    acc[mt][nt] = __builtin_amdgcn_mfma_f32_16x16x32_bf16(ah, bl[nt][ks], acc[mt][nt], 0, 0, 0);
                }
            }
        }
        __syncthreads();
#pragma unroll
        for (int mt = 0; mt < 2; ++mt)
#pragma unroll
            for (int nt = 0; nt < 4; ++nt)
#pragma unroll
                for (int r = 0; r < 4; ++r) PART[(w * 32 + mt * 16 + fq * 4 + r) * 64 + nt * 16 + fr] = acc[mt][nt][r];
        __syncthreads();
        for (int o = tid; o < 32 * 64; o += NTHREADS) { float sacc = 0.f;
#pragma unroll
            for (int q = 0; q < 8; ++q) sacc += PART[q * 2048 + o];
            LG[o] = sacc; }
        __syncthreads();
        {
            const int g = lane >> 3;
#pragma unroll 1
            for (int q = 0; q < 4; ++q) {
                const int i = w * 4 + q, row = row0 + i;
                const float sc = sigmoidf_(LG[i * 64 + lane]), c = sc + bias;
                const float m1 = gmax8(c);
                const unsigned long long eqm = __ballot(c == m1);
                const unsigned byte = (unsigned)(eqm >> (g * 8)) & 0xffu;
                const int first = __builtin_ctz(byte | 0x100u);
                const float c2 = ((lane & 7) == first) ? -INFINITY : c;
                const float gs = m1 + gmax8(c2);
                int rg = 0;
#pragma unroll
                for (int g2 = 0; g2 < 8; ++g2) { const float sg = __builtin_bit_cast(float, __builtin_amdgcn_readlane(__builtin_bit_cast(int, gs), g2 * 8)); rg += ((sg > gs) || (sg == gs && g2 < g)) ? 1 : 0; }
                const bool elig = rg < 4;
                unsigned u = __float_as_uint(c); u = (u & 0x80000000u) ? ~u : (u | 0x80000000u); u = (u & ~63u) | (unsigned)(63 - lane);
                const unsigned key = elig ? u : 0u;
                int rk = 0;
#pragma unroll
                for (int j = 0; j < 64; ++j) { const unsigned kj = (unsigned)__builtin_amdgcn_readlane((int)key, j); rk += (kj > key) ? 1 : 0; }
                const bool sel = elig && rk < 8;
                const float wsum = wave_sum(sel ? sc : 0.f, lane);
                if (sel) { ((int*)(wsl + WS_TOPI))[(size_t)row * 8 + rk] = lane; ((float*)(wsl + WS_TOPW))[(size_t)row * 8 + rk] = sc * 2.5f / wsum;
                    __hip_atomic_fetch_add(&HIST[lane], 1u, __ATOMIC_RELAXED, __HIP_MEMORY_SCOPE_WORKGROUP); }
            }
        }
        __syncthreads();
        if (tid < 64) { const unsigned c = HIST[tid]; ((unsigned*)(wsl + WS_TILECNT))[(size_t)tile * 64 + tid] = c;
            if (c && count) atomicAdd((unsigned*)(wsl + WS_CTL + CTL_TOTALS) + ((size_t)l * 2 + (tile >> 9)) * 64 + tid, c); }
        STAGE_MOD2(tile + F.G);
        __syncthreads();
    }
#undef STAGE_MOD2
}

__device__ __forceinline__ void expert_convert_wave(Frame& F, int l, int j) {
    const PP p = F.p; LAS float* T = (LAS float*)(F.lds + F.wave * 16640);
    const int e = j / 192, r = j % 192, kind = r / 64, q = r % 64;
    bf16_t* WGU = (bf16_t*)(F.ws + WS_WGU) + (size_t)e * 512 * 1024; bf16_t* WD = (bf16_t*)(F.ws + WS_WD) + (size_t)e * 1024 * 256;
    if (kind < 2) {
        const float* src = (e < 64) ? ((kind == 0 ? p->we_gate : p->we_up) + ((size_t)l * NE + e) * 1024 * 256) : ((kind == 0 ? p->ws_gate : p->ws_up) + (size_t)l * 1024 * 256);
        const int kt = q >> 2, ntile = q & 3, n0 = ntile * 64, drow = (n0 >> 7) * 256 + (n0 & 127) + kind * 128;
        tr_tile_wave(F.lane, T, src + (size_t)kt * 64 * 256 + n0, 256, WGU + (size_t)drow * 1024 + kt * 64, 1024);
    } else {
        const float* src = (e < 64) ? (p->we_down + ((size_t)l * NE + e) * 256 * 1024) : (p->ws_down + (size_t)l * 256 * 1024);
        const int kt = q >> 4, ntile = q & 15;
        tr_tile_wave(F.lane, T, src + (size_t)kt * 64 * 1024 + ntile * 64, 1024, WD + (size_t)ntile * 64 * 256 + kt * 64, 256);
    }
}

__device__ __forceinline__ void convert_queue(Frame& F, int l, int qi) {
    volatile LAS int* slot = (volatile LAS int*)(F.lds + MISC_OFF + 64);
    unsigned* ctr = (unsigned*)(F.ws + WS_CTL + CTL_QUEUE) + qi * 64;
#pragma unroll 1
    for (;;) {
        __syncthreads();
        if (F.tid == 0) *slot = (int)atomicAdd(ctr, 1u);
        __syncthreads();
        const int item = *slot;
        if (item >= 65 * 192 / 8) break;
        expert_convert_wave(F, l, item * 8 + F.wave);
    }
}

__device__ __forceinline__ void phase_route(Frame& F, int l) {
    const int tid = F.tid;
    LAS int* PST = (LAS int*)F.lds;
    LAS int* PEN = PST + 128;
    LAS int* CNT = PST + 256;
    LAS unsigned* PART = (LAS unsigned*)(PST + 384);
    LAS unsigned* BASE = PART + 512;
    LAS unsigned* LCNT = BASE + 64;
    const unsigned* totals = (const unsigned*)(F.ws + WS_CTL + CTL_TOTALS) + (size_t)l * 2 * 64;
    if (tid < 2) { int run = 0; for (int e = 0; e < 64; ++e) { const int c = (int)ld_u32_agent(totals + tid * 64 + e); CNT[tid * 64 + e] = c; PST[tid * 64 + e] = run; run += (c + 255) & ~255; PEN[tid * 64 + e] = run; } }
    __syncthreads();
    if (F.bid == 0 && tid < 128) ((int*)(F.ws + WS_PADEND))[tid] = PEN[tid];
    if (F.bid == 0) for (int t = tid; t < 2 * 576; t += NTHREADS) { const int hf2 = t / 576, rt = t % 576; int e = 0; while (e < 63 && rt * 256 >= PEN[hf2 * 64 + e]) ++e; ((int*)(F.ws + WS_TILEE))[t] = e; }
    const unsigned* tc = (const unsigned*)(F.ws + WS_TILECNT);
    int* rowtok = (int*)(F.ws + WS_ROWTOK); float* roww = (float*)(F.ws + WS_ROWW); int* rowdst = (int*)(F.ws + WS_ROWDST);
    for (int tile = F.bid; tile < 1024; tile += F.G) {
        const int hf = tile >> 9, e = tid & 63, part = tid >> 6; unsigned s = 0;
        for (int t2 = hf * 512 + part; t2 < tile; t2 += 8) s += tc[(size_t)t2 * 64 + e];
        PART[part * 64 + e] = s;
        __syncthreads();
        if (tid < 64) { unsigned b = (unsigned)PST[hf * 64 + tid];
#pragma unroll
            for (int q = 0; q < 8; ++q) b += PART[q * 64 + tid];
            BASE[tid] = b; LCNT[tid] = 0u; }
        __syncthreads();
        if (tid < 256) { const int i = tid >> 3, k = tid & 7, tok = tile * 32 + i; const int ex = ((const int*)(F.ws + WS_TOPI))[(size_t)tok * 8 + k]; const float wv = ((const float*)(F.ws + WS_TOPW))[(size_t)tok * 8 + k];
            const unsigned r = __hip_atomic_fetch_add(&LCNT[ex], 1u, __ATOMIC_RELAXED, __HIP_MEMORY_SCOPE_WORKGROUP); const size_t pos = (size_t)hf * PMAXH + BASE[ex] + r;
            rowtok[pos] = tok; roww[pos] = wv; rowdst[pos] = (tok - hf * HT) * 9 + k; }
        __syncthreads();
    }
    if (F.bid < 128) { const int hf = F.bid >> 6, e = F.bid & 63; const int s = PST[hf * 64 + e] + CNT[hf * 64 + e], en = PEN[hf * 64 + e];
        for (int pos = s + tid; pos < en; pos += NTHREADS) { rowtok[(size_t)hf * PMAXH + pos] = NTOK; roww[(size_t)hf * PMAXH + pos] = 0.f; rowdst[(size_t)hf * PMAXH + pos] = -1; } }
    __syncthreads();
}

__device__ __forceinline__ int load_padend(Frame& F, int hf) {
    LAS int* pe = (LAS int*)(F.lds + MISC_OFF + 256);
    __syncthreads();
    if (F.tid < 64) pe[F.tid] = (int)ld_u32_agent((const unsigned*)(F.ws + WS_PADEND) + hf * 64 + F.tid);
    { LAS int* te = (LAS int*)(F.lds + TILEE_OFF); for (int t = F.tid; t < 576; t += NTHREADS) te[t] = (int)ld_u32_agent((const unsigned*)(F.ws + WS_TILEE) + hf * 576 + t); }
    __syncthreads();
    return __builtin_amdgcn_readfirstlane(pe[63]) >> 8;
}
constexpr int ROWMETA_OFF = 131072;
__device__ __forceinline__ void run_gu(Frame& F, int hf) {
    const int ntr = load_padend(F, hf);
    LAS int* ltok = (LAS int*)(F.lds + ROWMETA_OFF); LAS float* lw = (LAS float*)(F.lds + ROWMETA_OFF + 8 * 1024);
    { const int* rowtok = (const int*)(F.ws + WS_ROWTOK) + (size_t)hf * PMAXH; const float* roww = (const float*)(F.ws + WS_ROWW) + (size_t)hf * PMAXH;
      for (int i = 0; i < 8; ++i) { const int uu = F.bid + i * F.G; if (uu >= (ntr + 64) * 2) break; const int rt = uu >> 1;
          if (rt < ntr && F.tid < 256) { ltok[i * 256 + F.tid] = rowtok[rt * 256 + F.tid]; lw[i * 256 + F.tid] = roww[rt * 256 + F.tid]; } }
      __syncthreads(); }
    TaskGU t; t.A = (const char*)(F.ws + WS_H); t.W = (const char*)(F.ws + WS_WGU); t.ltok = ltok; t.lw = lw;
    t.act = (bf16_t*)(F.ws + WS_ACT); t.tilee = (const LAS int*)(F.lds + TILEE_OFF); t.hf = hf; t.ntr = ntr; t.G = F.G; t.c = F.bid;
    pg8::gemm_run(F.lds, t);
}
__device__ __forceinline__ void run_down(Frame& F, int hf) {
    const int ntr = load_padend(F, hf);
    LAS int* ldst = (LAS int*)(F.lds + ROWMETA_OFF);
    { const int* rowdst = (const int*)(F.ws + WS_ROWDST) + (size_t)hf * PMAXH;
      for (int i = 0; i < 16; ++i) { const int uu = F.bid + i * F.G; if (uu >= (ntr + 64) * 4) break; const int rt = uu >> 2;
          if (rt < ntr && F.tid < 256) ldst[i * 256 + F.tid] = rowdst[rt * 256 + F.tid]; }
      __syncthreads(); }
    TaskDown t; t.A = (const char*)(F.ws + WS_ACT); t.W = (const char*)(F.ws + WS_WD); t.ldst = ldst; t.yb = (unsigned char*)(F.ws + WS_YB);
    t.tilee = (const LAS int*)(F.lds + TILEE_OFF); t.hf = hf; t.ntr = ntr; t.G = F.G; t.c = F.bid;
    pg8::gemm_run(F.lds, t);
}
__device__ __forceinline__ void phase_combine(Frame& F, int l, int hf) {
    typedef float f32x2v __attribute__((ext_vector_type(2)));
    const PP p = F.p; const int lane = F.lane;
    const unsigned char* YB = (const unsigned char*)(F.ws + WS_YB); float* X = p->out; bf16_t* XBp = (bf16_t*)(F.ws + WS_XB); bf16_t* H = (bf16_t*)(F.ws + WS_H);
    const float* mod_l = (const float*)(F.ws + WS_MOD) + (size_t)l * 16 * 6144;
    const float* mod_n = (const float*)(F.ws + WS_MOD) + (size_t)1 * 16 * 6144;
    const int c0 = lane * 16;
#pragma unroll 1
    for (int tl = F.bid * 8 + F.wave; tl < HT; tl += F.G * 8) {
        const int tok = hf * HT + tl, b = tok / SEQ;
        u32x4 yv[9];
#pragma unroll
        for (int k = 0; k < 9; ++k) yv[k] = *(const u32x4*)(YB + ((size_t)tl * 9 + k) * 1024 + c0);
        f32x4 xv[4], gv[4];
        { float xa[8], xc[8]; unpack8(*(const u32x4*)(XBp + (size_t)tok * D + c0), xa); unpack8(*(const u32x4*)(XBp + (size_t)tok * D + c0 + 8), xc);
          xv[0] = (f32x4){xa[0], xa[1], xa[2], xa[3]}; xv[1] = (f32x4){xa[4], xa[5], xa[6], xa[7]}; xv[2] = (f32x4){xc[0], xc[1], xc[2], xc[3]}; xv[3] = (f32x4){xc[4], xc[5], xc[6], xc[7]}; }
#pragma unroll
        for (int q = 0; q < 4; ++q) gv[q] = *(const f32x4*)(mod_l + (size_t)b * 6144 + 5120 + c0 + q * 4);
        float s[16];
#pragma unroll
        for (int j = 0; j < 16; ++j) s[j] = 0.f;
#pragma unroll
        for (int k = 0; k < 9; ++k) { const unsigned wd[4] = {yv[k].x, yv[k].y, yv[k].z, yv[k].w};
#pragma unroll
            for (int q = 0; q < 4; ++q) { const f32x2v lo = __builtin_amdgcn_cvt_pk_f32_fp8((int)wd[q], false), hi = __builtin_amdgcn_cvt_pk_f32_fp8((int)wd[q], true);
                s[q * 4 + 0] += lo.x; s[q * 4 + 1] += lo.y; s[q * 4 + 2] += hi.x; s[q * 4 + 3] += hi.y; } }
        float xn[16]; float ss = 0.f;
#pragma unroll
        for (int q = 0; q < 4; ++q)
#pragma unroll
            for (int j = 0; j < 4; ++j) { const float v = xv[q][j] + gv[q][j] * (s[q * 4 + j] * 0.015625f); xn[q * 4 + j] = v; ss += v * v; }
        ss = wave_sum(ss, lane); const float rstd = rsqrtf(ss * (1.0f / D) + 1e-6f);
        if (l == 0) {
            float o[16];
            { u32x4 x0, x1; x0.x = pack2(xn[0], xn[1]); x0.y = pack2(xn[2], xn[3]); x0.z = pack2(xn[4], xn[5]); x0.w = pack2(xn[6], xn[7]); x1.x = pack2(xn[8], xn[9]); x1.y = pack2(xn[10], xn[11]); x1.z = pack2(xn[12], xn[13]); x1.w = pack2(xn[14], xn[15]);
              *(u32x4*)(XBp + (size_t)tok * D + c0) = x0; *(u32x4*)(XBp + (size_t)tok * D + c0 + 8) = x1; }
#pragma unroll
            for (int q = 0; q < 4; ++q) {
                const f32x4 gg = *(const f32x4*)(p->norm1_g + (size_t)D + c0 + q * 4), sc = *(const f32x4*)(mod_n + (size_t)b * 6144 + 1024 + c0 + q * 4), sh = *(const f32x4*)(mod_n + (size_t)b * 6144 + c0 + q * 4);
#pragma unroll
                for (int j = 0; j < 4; ++j) o[q * 4 + j] = xn[q * 4 + j] * rstd * gg[j] * (1.0f + sc[j]) + sh[j]; }
            u32x4 h0, h1; h0.x = pack2(o[0], o[1]); h0.y = pack2(o[2], o[3]); h0.z = pack2(o[4], o[5]); h0.w = pack2(o[6], o[7]); h1.x = pack2(o[8], o[9]); h1.y = pack2(o[10], o[11]); h1.z = pack2(o[12], o[13]); h1.w = pack2(o[14], o[15]);
            *(u32x4*)(H + (size_t)tok * D + c0) = h0; *(u32x4*)(H + (size_t)tok * D + c0 + 8) = h1;
        } else {
#pragma unroll
            for (int q = 0; q < 4; ++q) { const f32x4 gg = *(const f32x4*)(p->final_g + c0 + q * 4);
                *(f32x4*)(X + (size_t)tok * D + c0 + q * 4) = (f32x4){xn[q * 4] * rstd * gg[0], xn[q * 4 + 1] * rstd * gg[1], xn[q * 4 + 2] * rstd * gg[2], xn[q * 4 + 3] * rstd * gg[3]}; }
        }
    }
}

#define LAUNDER() do { F.tid = opaque_tid(); F.lane = F.tid & 63; F.wave = __builtin_amdgcn_readfirstlane(F.tid >> 6); \
        { PP q_ = (PP)__builtin_amdgcn_kernarg_segment_ptr(); asm volatile("" : "+s"(q_)); F.p = q_; } \
        { GPTR w_ = (GPTR)F.p->ws; asm volatile("" : "+s"(w_)); F.ws = (unsigned char*)w_; } \
        { LAS unsigned char* l_ = (LAS unsigned char*)smem; asm volatile("" : "+s"(l_)); F.lds = l_; } \
        { int b_ = blockIdx.x; asm volatile("" : "+s"(b_)); F.bid = b_; } \
        { unsigned x_ = bar.x; asm volatile("" : "+s"(x_)); bar.x = x_; } } while (0)
#define PHASE(ph, ...) do { if (lo <= (ph) && (ph) < hi) { LAUNDER(); { __VA_ARGS__; } if ((ph) + 1 < hi) xcd_barrier(bar); } } while (0)
#define PHASE_R(ph, s, ...) do { PHASE(ph, __VA_ARGS__); if ((s) == REPEAT_STEP) PHASE(ph, __VA_ARGS__); } while (0)

__global__ void __launch_bounds__(NTHREADS, 2) mega(Params prm_unused) {
    extern __shared__ __attribute__((aligned(16))) unsigned char smem[];
    Frame F;
    F.p = (PP)__builtin_amdgcn_kernarg_segment_ptr();
    F.lds = (LAS unsigned char*)smem; F.ws = F.p->ws;
    F.tid = opaque_tid(); F.lane = F.tid & 63; F.wave = __builtin_amdgcn_readfirstlane(F.tid >> 6); F.G = gridDim.x; F.bid = blockIdx.x;
    volatile LAS unsigned* misc = (volatile LAS unsigned*)(F.lds + MISC_OFF);
    if (F.tid < 4) misc[F.tid] = 0u;
    __syncthreads();
    XcdBarrier bar; bar.bar = (unsigned*)(F.ws + WS_CTL); bar.x = 0; bar.st = misc;
    const int lo = F.p->ph_lo, hi = F.p->ph_hi;
    if (hi - lo > 1) bar = xcd_barrier_post((unsigned*)(F.ws + WS_CTL), misc);
#define MODP ((const float*)(F.ws + WS_MOD))
#define LAYER(l) \
    if ((l) == 0) PHASE_R(1 + 13 * (l) + 0, 0, phase_norm(F, F.p->x, F.p->norm1_g, MODP, 0, 1024)); \
    PHASE_R(1 + 13 * (l) + 1, 1, TaskIn t; t.A = (const char*)(F.ws + WS_H); t.Bt = (const char*)(F.ws + WS_WINT) + (size_t)(l) * INP * 1024 * 2; t.O = (unsigned char*)(F.ws + WS_P); t.G = F.G; t.c = F.bid; pg8::gemm_run(F.lds, t)); \
    PHASE_R(1 + 13 * (l) + 2, 2, phase_prep_rwkv(F, (l)); for (int it = F.bid; it < 512; it += F.G) pool_tile(F, (l), it)); \
    PHASE(1 + 13 * (l) + 3, if (F.bid < 96) rwkv_chunk_block(F, F.bid); else for (int it = F.bid - 96; it < 96; it += F.G - 96) retention_item(F, it); \
        F.tid = opaque_tid(); F.lane = F.tid & 63; F.wave = __builtin_amdgcn_readfirstlane(F.tid >> 6); convert_queue(F, (l), (l))); \
    if (3 == REPEAT_STEP) PHASE(1 + 13 * (l) + 3, if (F.bid < 96) rwkv_chunk_block(F, F.bid); else for (int it = F.bid - 96; it < 96; it += F.G - 96) retention_item(F, it); \
        F.tid = opaque_tid(); F.lane = F.tid & 63; F.wave = __builtin_amdgcn_readfirstlane(F.tid >> 6); convert_queue(F, (l), 2 + (l))); \
    if (33 == REPEAT_STEP) PHASE(1 + 13 * (l) + 3, convert_queue(F, (l), 2 + (l))); \
    if (31 == REPEAT_STEP) PHASE(1 + 13 * (l) + 3, if (F.bid < 96) rwkv_chunk_block(F, F.bid)); \
    if (32 == REPEAT_STEP) PHASE(1 + 13 * (l) + 3, if (F.bid >= 96) for (int it = F.bid - 96; it < 96; it += F.G - 96) retention_item(F, it)); \
    PHASE_R(1 + 13 * (l) + 4, 4, phase_rwkv_post(F, (l))); \
    PHASE(1 + 13 * (l) + 5, TaskOut t; t.A = (const char*)(F.ws + WS_H); t.Bt = (const char*)(F.ws + WS_WOUTT) + (size_t)(l) * 1024 * 1024 * 2; t.xf = (l) == 0 ? F.p->x : nullptr; t.xb = (bf16_t*)(F.ws + WS_XB); t.gate = MODP + (size_t)(l) * 16 * 6144 + 2048; t.G = F.G; t.c = F.bid; pg8::gemm_run(F.lds, t)); \
    PHASE(1 + 13 * (l) + 6, phase_norm2_router(F, (l), true)); \
    if (6 == REPEAT_STEP) PHASE(1 + 13 * (l) + 6, phase_norm2_router(F, (l), false)); \
    PHASE_R(1 + 13 * (l) + 7, 7, phase_route(F, (l))); \
    PHASE_R(1 + 13 * (l) + 8, 8, run_gu(F, 0)); \
    PHASE_R(1 + 13 * (l) + 9, 9, run_down(F, 0)); \
    PHASE(1 + 13 * (l) + 10, phase_combine(F, (l), 0); run_gu(F, 1)); \
    PHASE_R(1 + 13 * (l) + 11, 11, run_down(F, 1)); \
    PHASE(1 + 13 * (l) + 12, phase_combine(F, (l), 1));
    PHASE(0, phase_init(F));
    LAYER(0)
    LAYER(1)
}

extern "C" void kernel_launch(void* const* d_in, const int* in_sizes, int n_in, void* d_out, int out_size, void* d_ws, size_t ws_size, hipStream_t stream) {
    static int grid = 0;
    if (grid == 0) {
        if (n_in != 30 || out_size != NTOK * D || ws_size < WS_END) { fprintf(stderr, "kernel_launch: unexpected sizes: n_in %d out %d ws %zu (need %zu)\n", n_in, out_size, ws_size, (size_t)WS_END); grid = -1; return; }
        int dev = 0, cus = 0;
        if (hipGetDevice(&dev) != hipSuccess || hipDeviceGetAttribute(&cus, hipDeviceAttributeMultiprocessorCount, dev) != hipSuccess) { grid = -1; return; }
        if (hipFuncSetAttribute((const void*)mega, hipFuncAttributeMaxDynamicSharedMemorySize, LDS_BYTES) != hipSuccess) { fprintf(stderr, "kernel_launch: hipFuncSetAttribute failed\n"); grid = -1; return; }
        int per_cu = 0; (void)hipOccupancyMaxActiveBlocksPerMultiprocessor(&per_cu, (const void*)mega, NTHREADS, LDS_BYTES); (void)hipGetLastError();
        grid = cus;
        if (per_cu < 1) fprintf(stderr, "kernel_launch: occupancy query says %d blocks per CU\n", per_cu);
    }
    if (grid < 0) return;
    (void)hipMemsetAsync((char*)d_ws + WS_CTL, 0, CTL_BYTES, stream);
    Params p{};
    const float** f = (const float**)&p;
    for (int i = 0; i < 30; ++i) f[i] = (const float*)d_in[i];
    p.out = (float*)d_out; p.ws = (unsigned char*)d_ws;
#if N_LAUNCH_MODE == 0
    p.ph_lo = 0; p.ph_hi = LAST_PHASE + 1;
    hipLaunchKernelGGL(mega, dim3(grid), dim3(NTHREADS), LDS_BYTES, stream, p);
#else
    for (int ph = 0; ph <= LAST_PHASE; ++ph) { p.ph_lo = ph; p.ph_hi = ph + 1; hipLaunchKernelGGL(mega, dim3(grid), dim3(NTHREADS), LDS_BYTES, stream, p); }
#endif
}
```

```cpp
#include <hip/hip_runtime.h>
#include <cstdio>
#include <cstdint>

#ifndef N_LAUNCH_MODE
#define N_LAUNCH_MODE 0
#endif
#ifndef LAST_PHASE
#define LAST_PHASE 26
#endif
#ifndef STEP_MASK
#define STEP_MASK 0xFFFF
#endif
#define STEP_ON(s) ((STEP_MASK >> (s)) & 1)
#ifndef REPEAT_STEP
#define REPEAT_STEP -1
#endif

#define LAS __attribute__((address_space(3)))
typedef unsigned short bf16_t;
typedef short bf16x8 __attribute__((ext_vector_type(8)));
typedef float f32x4 __attribute__((ext_vector_type(4)));
typedef float f32x2 __attribute__((ext_vector_type(2)));
typedef unsigned u32x4 __attribute__((ext_vector_type(4)));
typedef unsigned u32x2 __attribute__((ext_vector_type(2)));
typedef __attribute__((address_space(1))) unsigned char* GPTR;

constexpr int D = 1024, NB = 16, SEQ = 2048, NTOK = NB * SEQ, NL = 2;
constexpr int RH = 6, RW = 384, RCOLS = 1408, INC = 3200, INP = 3328;
constexpr int RET_OFF = 1408, POOL_OFF = 2944;
constexpr int NE = 64, HT = 16384, PMAXH = 576 * 256, ACT_ROWS = PMAXH + 2 * HT;
constexpr int NTHREADS = 512;
constexpr int LDS_BYTES = 163840;
constexpr int MISC_OFF = LDS_BYTES - 1024;
constexpr int TILEE_OFF = LDS_BYTES - 4096;

constexpr size_t al256(size_t x) { return (x + 255) & ~(size_t)255; }
constexpr size_t WS_CTL = 0, CTL_BYTES = 65536;
constexpr size_t CTL_TOTALS = 16384;
constexpr size_t WS_MOD = WS_CTL + CTL_BYTES;
constexpr size_t WS_ROPE = WS_MOD + al256((size_t)NL * 16 * 6144 * 4);
constexpr size_t WS_WINT = WS_ROPE + (size_t)2 * 2048 * 32 * 4;
constexpr size_t WS_WOUTT = WS_WINT + (size_t)NL * INP * 1024 * 2;
constexpr size_t WS_WUPT = WS_WOUTT + (size_t)NL * 1024 * 1024 * 2;
constexpr size_t WS_AUPT = WS_WUPT + (size_t)NL * 384 * 64 * 2;
constexpr size_t WS_GUPT = WS_AUPT + (size_t)NL * 384 * 64 * 2;
constexpr size_t WS_POOLWT = WS_GUPT + (size_t)NL * 384 * 128 * 2;
constexpr size_t WS_WRT = WS_POOLWT + (size_t)NL * 4 * 64 * 64 * 2;
constexpr size_t WS_TOPI = WS_WRT + (size_t)NL * 2 * 64 * 1024 * 2;
constexpr size_t WS_TOPW = WS_TOPI + (size_t)NTOK * 8 * 4;
constexpr size_t WS_TILECNT = WS_TOPW + (size_t)NTOK * 8 * 4;
constexpr size_t WS_ROWTOK = WS_TILECNT + (size_t)1024 * 64 * 4;
constexpr size_t WS_ROWW = WS_ROWTOK + (size_t)2 * PMAXH * 4;
constexpr size_t WS_ROWDST = WS_ROWW + (size_t)2 * PMAXH * 4;
constexpr size_t WS_PADEND = WS_ROWDST + (size_t)2 * PMAXH * 4;
constexpr size_t WS_TILEE = WS_PADEND + 1024;
constexpr size_t WS_H = WS_TILEE + 2 * 576 * 4 + 512;
constexpr size_t WS_XB = WS_H + al256((size_t)(NTOK + 1) * 1024 * 2);
constexpr size_t WS_BIG = WS_XB + (size_t)NTOK * 1024 * 2;
constexpr size_t WS_P = WS_BIG;
constexpr size_t WS_SW = WS_P + (size_t)NTOK * INP;
constexpr size_t SARR = (size_t)NTOK * RW * 2;
constexpr size_t WS_SX = WS_SW + (size_t)NTOK * RW * 4;
constexpr size_t WS_YS = WS_SX + 5 * SARR;
constexpr size_t WS_G = WS_YS + (size_t)NTOK * RW * 4;
constexpr size_t WS_END_MIX = WS_G + SARR;
constexpr size_t WS_ACT = WS_BIG;
constexpr size_t WS_YB = WS_ACT + (size_t)ACT_ROWS * 256 * 2;
constexpr size_t WS_END_MOE = WS_YB + (size_t)HT * 9 * 1024;
constexpr size_t WS_WGU = al256(WS_END_MIX > WS_END_MOE ? WS_END_MIX : WS_END_MOE);
constexpr size_t WS_WD = WS_WGU + (size_t)65 * 512 * 1024 * 2;
constexpr size_t WS_END = WS_WD + (size_t)65 * 1024 * 256 * 2;
constexpr size_t CTL_QUEUE = 32768;

struct Params {
    const float* x; const float* c; const float* norm1_g; const float* norm2_g; const float* w_ada; const float* b_ada; const float* w_in; const float* w_out;
    const float* rwkv_mu; const float* rwkv_w_up; const float* rwkv_w0; const float* rwkv_a_up; const float* rwkv_a0; const float* rwkv_g_up; const float* rwkv_k_k; const float* rwkv_k_a;
    const float* rwkv_r_k; const float* rwkv_lnx_w; const float* rwkv_lnx_b; const float* pool_w; const float* pool_scale; const float* w_router; const float* router_bias;
    const float* we_gate; const float* we_up; const float* we_down; const float* ws_gate; const float* ws_up; const float* ws_down; const float* final_g;
    float* out; unsigned char* ws;
    int ph_lo, ph_hi;
};

__device__ __forceinline__ float bf2f(unsigned b) { return __uint_as_float(b << 16); }
__device__ __forceinline__ unsigned f2bf(float f) { unsigned u = __float_as_uint(f); u += 0x7FFFu + ((u >> 16) & 1u); return u >> 16; }
typedef __bf16 bf16x2_t __attribute__((ext_vector_type(2)));
__device__ __forceinline__ unsigned cvt_pk_bf16(float lo, float hi) { const bf16x2_t v = {(__bf16)lo, (__bf16)hi}; return __builtin_bit_cast(unsigned, v); }
__device__ __forceinline__ unsigned pack2(float lo, float hi) { return cvt_pk_bf16(lo, hi); }
__device__ __forceinline__ float sigmoidf_(float x) { return __builtin_amdgcn_rcpf(1.0f + __expf(-x)); }
__device__ __forceinline__ float tanhf_(float x) { const float e = __expf(2.0f * x); return 1.0f - 2.0f * __builtin_amdgcn_rcpf(e + 1.0f); }
template <int N> __device__ __forceinline__ float dpp_ror(float x) { return __builtin_bit_cast(float, __builtin_amdgcn_update_dpp(0, __builtin_bit_cast(int, x), 0x120 + N, 0xf, 0xf, false)); }
__device__ __forceinline__ float row16_sum(float x) { x += dpp_ror<8>(x); x += dpp_ror<4>(x); x += dpp_ror<2>(x); x += dpp_ror<1>(x); return x; }
template <int CTRL> __device__ __forceinline__ float dpp_mov(float x) { return __builtin_bit_cast(float, __builtin_amdgcn_update_dpp(0, __builtin_bit_cast(int, x), CTRL, 0xf, 0xf, false)); }
__device__ __forceinline__ float gmax8(float x) { x = fmaxf(x, dpp_mov<0xB1>(x)); x = fmaxf(x, dpp_mov<0x4E>(x)); x = fmaxf(x, dpp_mov<0x141>(x)); return x; }
__device__ __forceinline__ float shx(float v, int m, int lane) { return __builtin_bit_cast(float, __builtin_amdgcn_ds_bpermute((lane ^ m) << 2, __builtin_bit_cast(int, v))); }
__device__ __forceinline__ float wave_sum(float v, int lane) { v = row16_sum(v); v += shx(v, 16, lane); v += shx(v, 32, lane); return v; }
__device__ __forceinline__ unsigned ld_u32_agent(const unsigned* p) { return __hip_atomic_load(p, __ATOMIC_RELAXED, __HIP_MEMORY_SCOPE_AGENT); }
__device__ __forceinline__ void unpack8(const u32x4 v, float (&f)[8]) {
    f[0] = bf2f(v.x & 0xffffu); f[1] = __uint_as_float(v.x & 0xffff0000u); f[2] = bf2f(v.y & 0xffffu); f[3] = __uint_as_float(v.y & 0xffff0000u);
    f[4] = bf2f(v.z & 0xffffu); f[5] = __uint_as_float(v.z & 0xffff0000u); f[6] = bf2f(v.w & 0xffffu); f[7] = __uint_as_float(v.w & 0xffff0000u);
}
__device__ __forceinline__ u32x4 pack8(const float (&f)[8]) { u32x4 w; w.x = pack2(f[0], f[1]); w.y = pack2(f[2], f[3]); w.z = pack2(f[4], f[5]); w.w = pack2(f[6], f[7]); return w; }

__device__ __forceinline__ int opaque_tid() { int t = threadIdx.x; asm volatile("" : "+v"(t)); return t; }
typedef float f32x2v_ __attribute__((ext_vector_type(2)));
__device__ __forceinline__ void unpack4f8(unsigned v, float* f, float sc) { const f32x2v_ lo = __builtin_amdgcn_cvt_pk_f32_fp8((int)v, false), hi = __builtin_amdgcn_cvt_pk_f32_fp8((int)v, true); f[0] = lo.x * sc; f[1] = lo.y * sc; f[2] = hi.x * sc; f[3] = hi.y * sc; }
__device__ __forceinline__ void unpack8f8(const u32x2 v, float (&f)[8], float sc) { unpack4f8(v.x, f, sc); unpack4f8(v.y, f + 4, sc); }
__device__ __forceinline__ void unpack16f8(const u32x4 v, float (&f)[16], float sc) { unpack4f8(v.x, f, sc); unpack4f8(v.y, f + 4, sc); unpack4f8(v.z, f + 8, sc); unpack4f8(v.w, f + 12, sc); }
__device__ __forceinline__ unsigned pack4f8(float a, float b, float c, float d) { int w = 0; w = __builtin_amdgcn_cvt_pk_fp8_f32(a, b, w, false); w = __builtin_amdgcn_cvt_pk_fp8_f32(c, d, w, true); return (unsigned)w; }
constexpr float PSCALE = 16.0f, PINV = 1.0f / 16.0f;
#define XB_TMO      128
#define XB_XCNT(j)  (256  + 64 * (j))
#define XB_XSUB(j)  (1280 + 64 * (j))
#define XB_XGEN(j)  (2304 + 64 * (j))
#define XB_TOP      3328
#define XB_TOPGEN   3392
#define XCD_BAR_WORDS 3456
#define XB_SPIN_CAP (1u << 24)
__device__ __forceinline__ unsigned xb_ld(unsigned* p)              { return __hip_atomic_load(p, __ATOMIC_RELAXED, __HIP_MEMORY_SCOPE_AGENT); }
__device__ __forceinline__ unsigned xb_add(unsigned* p, unsigned v) { return __hip_atomic_fetch_add(p, v, __ATOMIC_RELAXED, __HIP_MEMORY_SCOPE_AGENT); }
__device__ __forceinline__ unsigned xb_xcc_id() { return (unsigned)__builtin_amdgcn_s_getreg((3 << 11) | 20) & 0xFu; }
#define XB_SPIN(cond, bar) do { unsigned _sp = 0; while (cond) { __builtin_amdgcn_s_sleep(1); \
    if ((++_sp & 255u) == 0u) { if (xb_ld(&(bar)[XB_TMO])) break; if (_sp > XB_SPIN_CAP) { atomicAdd(&(bar)[XB_TMO], 1u); break; } } } } while (0)
struct XcdBarrier { unsigned* bar; unsigned x; volatile LAS unsigned* st; };
__device__ __forceinline__ XcdBarrier xcd_barrier_post(unsigned* bar, volatile LAS unsigned* st) {
    XcdBarrier b; b.bar = bar; b.x = xb_xcc_id(); b.st = st;
    if (threadIdx.x == 0) (void)xb_add(&bar[XB_XCNT(b.x)], 1u);
    return b;
}
__device__ __forceinline__ void xcd_barrier_complete(unsigned* bar, unsigned x, unsigned& nloc, unsigned& nx) {
    const unsigned G = gridDim.x * gridDim.y * gridDim.z;
    unsigned sum, cnt, mine, sp = 0u;
    for (;;) {
        sum = 0u; cnt = 0u; mine = 0u;
#pragma unroll
        for (unsigned j = 0; j < 16; ++j) { const unsigned c = xb_ld(&bar[XB_XCNT(j)]); sum += c; cnt += (c > 0u) ? 1u : 0u; mine = (j == x) ? c : mine; }
        if (sum == G) break;
        __builtin_amdgcn_s_sleep(1);
        if ((++sp & 255u) == 0u) { if (xb_ld(&bar[XB_TMO])) break; if (sp > XB_SPIN_CAP) { atomicAdd(&bar[XB_TMO], 1u); break; } }
    }
    nloc = mine > 0u ? mine : 1u; nx = cnt > 0u ? cnt : 1u;
}
__device__ __forceinline__ void xcd_barrier(const XcdBarrier& b) {
    asm volatile("s_waitcnt vmcnt(0)" ::: "memory");
    __syncthreads();
    if (threadIdx.x == 0) {
        unsigned* bar = b.bar;
        __builtin_amdgcn_s_waitcnt(0);
        unsigned nloc = b.st[0], nx = b.st[1];
        if (nloc == 0u) { xcd_barrier_complete(bar, b.x, nloc, nx); b.st[0] = nloc; b.st[1] = nx; }
        const unsigned old = xb_add(&bar[XB_XSUB(b.x)], 1u);
        const unsigned gen = old / nloc;
        if (old + 1u == (gen + 1u) * nloc) {
            __builtin_amdgcn_fence(__ATOMIC_RELEASE, "agent");
            asm volatile("s_waitcnt vmcnt(0)" ::: "memory");
            const unsigned og = xb_add(&bar[XB_TOP], 1u);
            const unsigned tg = og / nx;
            if (og + 1u == (tg + 1u) * nx) xb_add(&bar[XB_TOPGEN], 1u);
            else XB_SPIN(xb_ld(&bar[XB_TOPGEN]) == tg, bar);
            __builtin_amdgcn_fence(__ATOMIC_ACQUIRE, "agent");
            xb_add(&bar[XB_XGEN(b.x)], 1u);
            asm volatile("s_waitcnt vmcnt(0)" ::: "memory");
        } else {
            XB_SPIN(xb_ld(&bar[XB_XGEN(b.x)]) == gen, bar);
            __builtin_amdgcn_fence(__ATOMIC_ACQUIRE, "agent");
            asm volatile("s_waitcnt vmcnt(0)" ::: "memory");
        }
    }
    __syncthreads();
}

typedef const __attribute__((address_space(4))) Params* PP;
struct Frame {
    PP p;
    LAS unsigned char* lds;
    unsigned char* ws;
    int tid, lane, wave, G, bid;
};

namespace pg8 {
constexpr int BM = 256, BK = 64, HALF = 128, HTB = HALF * BK * 2, STAGE_BYTES = 8 * HTB, NXCD = 8, WGM = 8;
__device__ __forceinline__ int lds_byte(int r, int c) { const int st = (r >> 4) * 2 + (c >> 5), rr = r & 15, cc = c & 31, ob = rr * 64 + cc * 2; return st * 1024 + (ob ^ (((ob >> 9) & 1) << 5)); }
__device__ __forceinline__ void stage_rc(int b, int& R, int& C) { const int st = b / 1024, sb = b % 1024, swz = sb ^ (((sb >> 9) & 1) << 5); R = (st >> 1) * 16 + swz / 64; C = (st & 1) * 32 + (swz % 64) / 2; }
__device__ __forceinline__ int perm32(int rho) { const int n = rho >> 4, i = rho & 15; return 8 * (i >> 2) + 4 * n + (i & 3); }

__device__ __forceinline__ bool static_order(int nM, int nN, int G, int c, int i, int& pm, int& pn) {
    const int nwg = nM * nN; const long L = (long)i * G + c; if (L >= nwg) return false;
    int wgid = (int)L; { const int q = nwg / NXCD, r = nwg % NXCD, xcd = wgid % NXCD, off = wgid / NXCD; wgid = (xcd < r ? xcd * (q + 1) : r * (q + 1) + (xcd - r) * q) + off; }
    const int nig = WGM * nN, gid = wgid / nig, fm = gid * WGM, gsz = (nM - fm) < WGM ? (nM - fm) : WGM;
    pm = fm + ((wgid % nig) % gsz); pn = (wgid % nig) / gsz; return true;
}

struct Unit { int rt, ct, e, slot; };

template <class Task>
__device__ __forceinline__ void gemm_run(LAS unsigned char* lds, const Task& S) {
    constexpr int K = Task::K, nt = K / BK;
    const int tid = opaque_tid(), wid = __builtin_amdgcn_readfirstlane(tid >> 6), lane = tid & 63, wr = wid >> 2, wc = wid & 3, fr = lane & 15, fq = lane >> 4;
    unsigned voffB[2][2];
#pragma unroll
    for (int h = 0; h < 2; ++h)
#pragma unroll
        for (int i = 0; i < 2; ++i) { int R, C; stage_rc(tid * 16 + i * 8192, R, C); voffB[h][i] = (unsigned)(Task::brow(h, R) * K + C) * 2u; }
    const size_t kstep = (size_t)(BK * 2);
        const unsigned ldsw = (unsigned)wid * 1024u;
    const int aoff = lds_byte(wr * 64 + fr, fq * 8), boff = lds_byte(wc * 32 + fr, fq * 8);
#define PG8_SA(b, h) (((b) * 2 + (h)) * HTB)
#define PG8_SB(b, h) ((4 + (b) * 2 + (h)) * HTB)
#define PG8_STAGE(bufoff, gbase, voff) do { _Pragma("unroll") for (int _i = 0; _i < 2; ++_i) \
        __builtin_amdgcn_global_load_lds((const unsigned*)((const char*)(gbase) + (voff)[_i]), (LAS unsigned*)(lds + (bufoff) + ldsw + _i * 8192), 16, 0, 0); } while (0)
#define PG8_LDA(dst, b, h) do { _Pragma("unroll") for (int m = 0; m < 4; ++m) _Pragma("unroll") for (int k = 0; k < 2; ++k) dst[m][k] = *(const LAS bf16x8*)(lds + PG8_SA(b, h) + aoff + m * 2048 + k * 1024); } while (0)
#define PG8_LDB(dst, b, h) do { _Pragma("unroll") for (int n = 0; n < 2; ++n) _Pragma("unroll") for (int k = 0; k < 2; ++k) dst[n][k] = *(const LAS bf16x8*)(lds + PG8_SB(b, h) + boff + n * 2048 + k * 1024); } while (0)
#define PG8_MMA(ai, bj, At, Bt) do { __builtin_amdgcn_s_setprio(1); _Pragma("unroll") for (int m = 0; m < 4; ++m) _Pragma("unroll") for (int n = 0; n < 2; ++n) _Pragma("unroll") for (int k = 0; k < 2; ++k) \
        acc[ai][bj][m][n] = __builtin_amdgcn_mfma_f32_16x16x32_bf16(Bt[n][k], At[m][k], acc[ai][bj][m][n], 0, 0, 0); __builtin_amdgcn_s_setprio(0); } while (0)
#define PG8_WAIT_V(n) asm volatile("s_waitcnt vmcnt(" #n ")" ::: "memory")
#define PG8_WAIT_L(n) asm volatile("s_waitcnt lgkmcnt(" #n ")" ::: "memory")
#define PG8_BAR __builtin_amdgcn_s_barrier()
#define LDS_BAR() do { asm volatile("s_waitcnt lgkmcnt(0)" ::: "memory"); __builtin_amdgcn_s_barrier(); asm volatile("" ::: "memory"); } while (0)
#define PG8_SCHED __builtin_amdgcn_sched_barrier(0)
    Unit cur, nxt; int ui = 0;
    if (!S.unit(0, cur)) return;
    f32x4 acc[2][2][4][2];
#pragma unroll
    for (int a = 0; a < 2; ++a)
#pragma unroll
        for (int b = 0; b < 2; ++b)
#pragma unroll
            for (int m = 0; m < 4; ++m)
#pragma unroll
                for (int n = 0; n < 2; ++n) acc[a][b][m][n] = (f32x4){0.f, 0.f, 0.f, 0.f};
    bf16x8 At[4][2], B0[2][2], B1[2][2];
    const char* const Ab = S.abase();
    unsigned co[2][2];
    S.aoffs(cur, co);
    const char* cB = S.bptr(cur);
    PG8_STAGE(PG8_SB(0, 0), cB, voffB[0]); PG8_STAGE(PG8_SB(0, 1), cB, voffB[1]); PG8_STAGE(PG8_SA(0, 0), Ab, co[0]); PG8_STAGE(PG8_SA(0, 1), Ab, co[1]);
    if (wr == 1) PG8_BAR;
    PG8_WAIT_V(2); PG8_BAR;
    PG8_STAGE(PG8_SB(1, 0), cB + kstep, voffB[0]); PG8_STAGE(PG8_SA(1, 0), Ab + kstep, co[0]); PG8_STAGE(PG8_SB(1, 1), cB + kstep, voffB[1]);
    PG8_WAIT_V(6); PG8_BAR;
#pragma unroll 1
    for (;;) {
        const bool has_next = S.unit(ui + 1, nxt);
        const char* nB = cB;
        if (has_next) nB = S.bptr(nxt);
#pragma unroll 1
        for (int t = 0; t < nt; t += 2) {
            const bool last = (t == nt - 2);
            const char* a1 = Ab + (size_t)(t + 1) * kstep;
            const char* a2 = last ? Ab : Ab + (size_t)(t + 2) * kstep; const char* b2 = last ? nB : cB + (size_t)(t + 2) * kstep;
            const char* a3 = a2 + kstep; const char* b3 = b2 + kstep;
            PG8_LDB(B0, 0, 0); PG8_LDB(B1, 0, 1); PG8_SCHED; PG8_LDA(At, 0, 0); PG8_STAGE(PG8_SA(1, 1), a1, co[1]);
            PG8_WAIT_V(8); PG8_WAIT_L(0); PG8_BAR; PG8_MMA(0, 0, At, B0); PG8_MMA(0, 1, At, B1); PG8_BAR; PG8_SCHED;
            if (last && has_next) S.aoffs(nxt, co);
            PG8_LDA(At, 0, 1); PG8_STAGE(PG8_SB(0, 0), b2, voffB[0]); PG8_STAGE(PG8_SB(0, 1), b2, voffB[1]); PG8_STAGE(PG8_SA(0, 0), a2, co[0]);
            PG8_WAIT_V(8); PG8_WAIT_L(0); PG8_BAR; PG8_MMA(1, 0, At, B0); PG8_MMA(1, 1, At, B1); PG8_BAR; PG8_SCHED;
            PG8_LDB(B0, 1, 0); PG8_LDB(B1, 1, 1); PG8_SCHED; PG8_LDA(At, 1, 0); PG8_STAGE(PG8_SA(0, 1), a2, co[1]);
            PG8_WAIT_V(8); PG8_WAIT_L(0); PG8_BAR; PG8_MMA(0, 0, At, B0); PG8_MMA(0, 1, At, B1); PG8_BAR; PG8_SCHED;
            PG8_LDA(At, 1, 1); PG8_STAGE(PG8_SB(1, 0), b3, voffB[0]); PG8_STAGE(PG8_SB(1, 1), b3, voffB[1]); PG8_STAGE(PG8_SA(1, 0), a3, co[0]);
            PG8_WAIT_V(8); PG8_WAIT_L(0); PG8_BAR; PG8_MMA(1, 0, At, B0); PG8_MMA(1, 1, At, B1); PG8_BAR; PG8_SCHED;
        }
        if (wr == 0) PG8_BAR;
        S.epi(acc, cur, wr, wc, fr, fq);
        if (!has_next) break;
#pragma unroll
        for (int a = 0; a < 2; ++a)
#pragma unroll
            for (int b = 0; b < 2; ++b)
#pragma unroll
                for (int m = 0; m < 4; ++m)
#pragma unroll
                    for (int n = 0; n < 2; ++n) acc[a][b][m][n] = (f32x4){0.f, 0.f, 0.f, 0.f};
        cur = nxt; cB = nB; ++ui;
        if (wr == 1) PG8_BAR;
    }
    PG8_WAIT_V(0);
    PG8_BAR;
#undef PG8_SA
#undef PG8_SB
#undef PG8_STAGE
#undef PG8_LDA
#undef PG8_LDB
#undef PG8_MMA
#undef PG8_WAIT_V
#undef PG8_WAIT_L
#undef PG8_BAR
#undef PG8_SCHED
}
}
using pg8::Unit;


__device__ __forceinline__ u32x4 ror8_u32x4(u32x4 v) { u32x4 r;
    r.x = (unsigned)__builtin_amdgcn_update_dpp(0, (int)v.x, 0x128, 0xf, 0xf, false); r.y = (unsigned)__builtin_amdgcn_update_dpp(0, (int)v.y, 0x128, 0xf, 0xf, false);
    r.z = (unsigned)__builtin_amdgcn_update_dpp(0, (int)v.z, 0x128, 0xf, 0xf, false); r.w = (unsigned)__builtin_amdgcn_update_dpp(0, (int)v.w, 0x128, 0xf, 0xf, false); return r; }
__device__ __forceinline__ void store_rows_full(bf16_t* pa, bf16_t* pb, u32x4 w0, u32x4 w1, int fr, int fq) {
    const bool lo = fr < 8;
    const u32x4 send = lo ? w1 : w0, recv = ror8_u32x4(send);
    const u32x4 s1 = lo ? w0 : recv;
    const u32x4 s2 = lo ? recv : w1;
    const int co = (lo ? 0 : 32) + 8 * fq;
    if (pa) *(u32x4*)(pa + co) = s1;
    if (pb) *(u32x4*)(pb + co) = s2;
}

struct TaskIn {
    static constexpr int K = 1024; static constexpr bool PERM = true;
    static __device__ __forceinline__ int brow(int h, int R) { return (R >> 5) * 64 + 16 * ((R & 15) >> 2) + 8 * h + 4 * ((R >> 4) & 1) + (R & 3); }
    const char* A; const char* Bt; unsigned char* O; int G, c;
    __device__ __forceinline__ bool unit(int i, Unit& u) const { u.e = 0; u.slot = i; return pg8::static_order(NTOK / 256, INP / 256, G, c, i, u.rt, u.ct); }
    __device__ __forceinline__ const char* abase() const { return A; }
    __device__ __forceinline__ void aoffs(const Unit& u, unsigned (&o)[2][2]) const {
        int R[2], C[2];
        { const int t_ = opaque_tid();
#pragma unroll
        for (int i = 0; i < 2; ++i) pg8::stage_rc(t_ * 16 + i * 8192, R[i], C[i]); }
#pragma unroll
        for (int h = 0; h < 2; ++h)
#pragma unroll
            for (int i = 0; i < 2; ++i) o[h][i] = (unsigned)((u.rt * 256 + h * 128 + R[i]) * K + C[i]) * 2u;
    }
    __device__ __forceinline__ const char* bptr(const Unit& u) const { return Bt + (size_t)u.ct * 256 * K * 2; }
    __device__ __forceinline__ void epi(const f32x4 (&acc)[2][2][4][2], const Unit& u, int wr, int wc, int fr, int fq) const {
        const int row0 = u.rt * 256 + wr * 64 + fr, col0 = u.ct * 256 + wc * 64 + 16 * fq;
#pragma unroll
        for (int ai = 0; ai < 2; ++ai)
#pragma unroll
            for (int m = 0; m < 4; ++m) {
                const f32x4 a0 = acc[ai][0][m][0] * PSCALE, a1 = acc[ai][0][m][1] * PSCALE, b0 = acc[ai][1][m][0] * PSCALE, b1 = acc[ai][1][m][1] * PSCALE;
                u32x4 w; w.x = pack4f8(a0[0], a0[1], a0[2], a0[3]); w.y = pack4f8(a1[0], a1[1], a1[2], a1[3]); w.z = pack4f8(b0[0], b0[1], b0[2], b0[3]); w.w = pack4f8(b1[0], b1[1], b1[2], b1[3]);
                *(u32x4*)(O + (size_t)(row0 + ai * 128 + m * 16) * INP + col0) = w;
            }
    }
};

struct TaskOut {
    static constexpr int K = 1024; static constexpr bool PERM = true;
    static __device__ __forceinline__ int brow(int h, int R) { return (R >> 5) * 64 + h * 32 + pg8::perm32(R & 31); }
    const char* A; const char* Bt; const float* xf; bf16_t* xb; const float* gate;
    int G, c;
    __device__ __forceinline__ bool unit(int i, Unit& u) const { u.e = 0; u.slot = i; return pg8::static_order(NTOK / 256, D / 256, G, c, i, u.rt, u.ct); }
    __device__ __forceinline__ const char* abase() const { return A; }
    __device__ __forceinline__ void aoffs(const Unit& u, unsigned (&o)[2][2]) const {
        int R[2], C[2];
        { const int t_ = opaque_tid();
#pragma unroll
        for (int i = 0; i < 2; ++i) pg8::stage_rc(t_ * 16 + i * 8192, R[i], C[i]); }
#pragma unroll
        for (int h = 0; h < 2; ++h)
#pragma unroll
            for (int i = 0; i < 2; ++i) o[h][i] = (unsigned)((u.rt * 256 + h * 128 + R[i]) * K + C[i]) * 2u;
    }
    __device__ __forceinline__ const char* bptr(const Unit& u) const { return Bt + (size_t)u.ct * 256 * K * 2; }
    __device__ __forceinline__ void epi(const f32x4 (&acc)[2][2][4][2], const Unit& u, int wr, int wc, int fr, int fq) const {
        const int rowg = u.rt * 256 + wr * 64, colw = u.ct * 256 + wc * 64, b = (u.rt * 256) / SEQ;
        f32x4 gv[2][2];
#pragma unroll
        for (int bj = 0; bj < 2; ++bj)
#pragma unroll
            for (int n = 0; n < 2; ++n) gv[bj][n] = *(const f32x4*)(gate + (size_t)b * 6144 + colw + bj * 32 + 8 * fq + 4 * n);
#pragma unroll
        for (int ai = 0; ai < 2; ++ai)
#pragma unroll
            for (int m = 0; m < 4; ++m) {
                const size_t ro = (size_t)(rowg + ai * 128 + m * 16 + fr) * D + colw + 8 * fq;
                u32x4 w[2];
#pragma unroll
                for (int bj = 0; bj < 2; ++bj) {
                    float xv[8];
                    if (xf) { const f32x4 x0 = *(const f32x4*)(xf + ro + bj * 32), x1 = *(const f32x4*)(xf + ro + bj * 32 + 4);
#pragma unroll
                        for (int j = 0; j < 4; ++j) { xv[j] = x0[j]; xv[4 + j] = x1[j]; } }
                    else unpack8(*(const u32x4*)(xb + ro + bj * 32), xv);
                    float o[8];
#pragma unroll
                    for (int n = 0; n < 2; ++n)
#pragma unroll
                        for (int j = 0; j < 4; ++j) o[n * 4 + j] = xv[n * 4 + j] + gv[bj][n][j] * acc[ai][bj][m][n][j];
                    w[bj] = pack8(o);
                }
                bf16_t* pa = xb + (size_t)(rowg + ai * 128 + m * 16 + (fr & 7)) * D + colw;
                store_rows_full(pa, pa + (size_t)8 * D, w[0], w[1], fr, fq);
                asm volatile("" ::: "memory");
            }
    }
};

struct TaskGU {
    static constexpr int K = 1024; static constexpr bool PERM = true;
    static __device__ __forceinline__ int brow(int h, int R) { return h * 128 + (R & ~31) + pg8::perm32(R & 31); }
    const char* A;
    const char* W;
    const LAS int* ltok; const LAS float* lw; bf16_t* act; const LAS int* tilee;
    int hf, ntr, G, c;
    __device__ __forceinline__ bool unit(int i, Unit& u) const {
        const int uu = c + i * G; if (uu >= (ntr + 64) * 2) return false;
        u.rt = uu >> 1; u.ct = uu & 1; u.slot = i;
        if (u.rt < ntr) u.e = __builtin_amdgcn_readfirstlane(tilee[u.rt]); else u.e = 64;
        return true;
    }
    __device__ __forceinline__ const char* abase() const { return A; }
    __device__ __forceinline__ void aoffs(const Unit& u, unsigned (&o)[2][2]) const {
        int R[2], C[2];
        { const int t_ = opaque_tid();
#pragma unroll
        for (int i = 0; i < 2; ++i) pg8::stage_rc(t_ * 16 + i * 8192, R[i], C[i]); }
#pragma unroll
        for (int h = 0; h < 2; ++h)
#pragma unroll
            for (int i = 0; i < 2; ++i) {
                int tok;
                if (u.e < 64) tok = ltok[u.slot * 256 + h * 128 + R[i]]; else tok = hf * HT + (u.rt - ntr) * 256 + h * 128 + R[i];
                o[h][i] = (unsigned)(tok * K + C[i]) * 2u;
            }
    }
    __device__ __forceinline__ const char* bptr(const Unit& u) const { return W + ((size_t)u.e * 512 + (size_t)u.ct * 256) * K * 2; }
    __device__ __forceinline__ void epi(const f32x4 (&acc)[2][2][4][2], const Unit& u, int wr, int wc, int fr, int fq) const {
        const bool routed = u.e < 64;
        const int rin = u.rt * 256 + wr * 64 + fr;
        const int rout = routed ? rin : PMAXH + hf * HT + (u.rt - ntr) * 256 + wr * 64 + fr;
        const int col0 = u.ct * 128 + wc * 32 + 8 * fq;
#pragma unroll
        for (int ai = 0; ai < 2; ++ai)
#pragma unroll
            for (int m = 0; m < 4; ++m) {
                const float rw = routed ? lw[u.slot * 256 + wr * 64 + fr + ai * 128 + m * 16] : 1.0f;
                float o[8];
#pragma unroll
                for (int n = 0; n < 2; ++n)
#pragma unroll
                    for (int j = 0; j < 4; ++j) { const float g = acc[ai][0][m][n][j], up = acc[ai][1][m][n][j]; o[n * 4 + j] = g * sigmoidf_(g) * up * rw; }
                u32x4 w; w.x = cvt_pk_bf16(o[0], o[1]); w.y = cvt_pk_bf16(o[2], o[3]); w.z = cvt_pk_bf16(o[4], o[5]); w.w = cvt_pk_bf16(o[6], o[7]);
                *(u32x4*)(act + (size_t)(rout + ai * 128 + m * 16) * 256 + col0) = w;
            }
    }
};

struct TaskDown {
    static constexpr int K = 256; static constexpr bool PERM = true;
    static __device__ __forceinline__ int brow(int h, int R) { return (R >> 5) * 64 + 16 * ((R & 15) >> 2) + 8 * h + 4 * ((R >> 4) & 1) + (R & 3); }
    const char* A;
    const char* W;
    const LAS int* ldst; unsigned char* yb; const LAS int* tilee;
    int hf, ntr, G, c;
    __device__ __forceinline__ bool unit(int i, Unit& u) const {
        const int uu = c + i * G; if (uu >= (ntr + 64) * 4) return false;
        u.rt = uu >> 2; u.ct = uu & 3; u.slot = i;
        if (u.rt < ntr) u.e = __builtin_amdgcn_readfirstlane(tilee[u.rt]); else u.e = 64;
        return true;
    }
    __device__ __forceinline__ const char* abase() const { return A; }
    __device__ __forceinline__ void aoffs(const Unit& u, unsigned (&o)[2][2]) const {
        int R[2], C[2];
        { const int t_ = opaque_tid();
#pragma unroll
        for (int i = 0; i < 2; ++i) pg8::stage_rc(t_ * 16 + i * 8192, R[i], C[i]); }
        const int row0 = (u.e < 64) ? u.rt * 256 : PMAXH + hf * HT + (u.rt - ntr) * 256;
#pragma unroll
        for (int h = 0; h < 2; ++h)
#pragma unroll
            for (int i = 0; i < 2; ++i) o[h][i] = (unsigned)((row0 + h * 128 + R[i]) * K + C[i]) * 2u;
    }
    __device__ __forceinline__ const char* bptr(const Unit& u) const { return W + ((size_t)u.e * 1024 + (size_t)u.ct * 256) * K * 2; }
    __device__ __forceinline__ void epi(const f32x4 (&acc)[2][2][4][2], const Unit& u, int wr, int wc, int fr, int fq) const {
        const bool routed = u.e < 64;
        const int rin = u.rt * 256 + wr * 64 + fr, col0 = u.ct * 256 + wc * 64 + 16 * fq;
        const int sl = (u.rt - ntr) * 256 + wr * 64 + fr;
#pragma unroll
        for (int ai = 0; ai < 2; ++ai)
#pragma unroll
            for (int m = 0; m < 4; ++m) {
                const int dst = routed ? ldst[u.slot * 256 + wr * 64 + fr + ai * 128 + m * 16] : (sl + ai * 128 + m * 16) * 9 + 8;
                u32x4 w;
                { int d0 = 0, d1 = 0, d2 = 0, d3 = 0; const f32x4 a0 = acc[ai][0][m][0] * 64.0f, a1 = acc[ai][0][m][1] * 64.0f, b0 = acc[ai][1][m][0] * 64.0f, b1 = acc[ai][1][m][1] * 64.0f;
                  d0 = __builtin_amdgcn_cvt_pk_fp8_f32(a0[0], a0[1], d0, false); d0 = __builtin_amdgcn_cvt_pk_fp8_f32(a0[2], a0[3], d0, true);
                  d1 = __builtin_amdgcn_cvt_pk_fp8_f32(a1[0], a1[1], d1, false); d1 = __builtin_amdgcn_cvt_pk_fp8_f32(a1[2], a1[3], d1, true);
                  d2 = __builtin_amdgcn_cvt_pk_fp8_f32(b0[0], b0[1], d2, false); d2 = __builtin_amdgcn_cvt_pk_fp8_f32(b0[2], b0[3], d2, true);
                  d3 = __builtin_amdgcn_cvt_pk_fp8_f32(b1[0], b1[1], d3, false); d3 = __builtin_amdgcn_cvt_pk_fp8_f32(b1[2], b1[3], d3, true);
                  w.x = (unsigned)d0; w.y = (unsigned)d1; w.z = (unsigned)d2; w.w = (unsigned)d3; }
                if (dst >= 0) *(u32x4*)(yb + (size_t)dst * 1024 + col0) = w;
                asm volatile("" ::: "memory");
            }
    }
};

__device__ __forceinline__ void tr_tile(int tid, LAS float* T, const float* src, int ld_src, bf16_t* dst, int ld_dst, bf16_t* dst_lo) {
    { const int row = tid >> 4, c4 = tid & 15;
#pragma unroll
      for (int rr = 0; rr < 64; rr += 32) { const f32x4 v = *(const f32x4*)(src + (size_t)(row + rr) * ld_src + c4 * 4);
          LAS float* t = T + (row + rr) * 65 + c4 * 4; t[0] = v[0]; t[1] = v[1]; t[2] = v[2]; t[3] = v[3]; } }
    __syncthreads();
    { const int n = tid >> 3, kq = tid & 7; float v[8];
#pragma unroll
      for (int j = 0; j < 8; ++j) v[j] = T[(kq * 8 + j) * 65 + n];
      *(u32x4*)(dst + (size_t)n * ld_dst + kq * 8) = pack8(v);
      if (dst_lo) { float lo[8];
#pragma unroll
          for (int j = 0; j < 8; ++j) lo[j] = v[j] - bf2f(f2bf(v[j]));
          *(u32x4*)(dst_lo + (size_t)n * ld_dst + kq * 8) = pack8(lo); } }
    __syncthreads();
}

__device__ __forceinline__ void tr_tile_wave(int lane, LAS float* T, const float* src, int ld_src, bf16_t* dst, int ld_dst) {
    f32x4 v[16];
#pragma unroll
    for (int i = 0; i < 16; ++i) v[i] = *(const f32x4*)(src + (size_t)(i * 4 + (lane >> 4)) * ld_src + (lane & 15) * 4);
#pragma unroll
    for (int i = 0; i < 16; ++i) { LAS float* t = T + (i * 4 + (lane >> 4)) * 65 + (lane & 15) * 4; t[0] = v[i][0]; t[1] = v[i][1]; t[2] = v[i][2]; t[3] = v[i][3]; }
    __builtin_amdgcn_fence(__ATOMIC_RELEASE, "wavefront"); asm volatile("s_waitcnt lgkmcnt(0)" ::: "memory");
    const int kq = lane & 7;
#pragma unroll
    for (int q = 0; q < 8; ++q) { const int n = q * 8 + (lane >> 3); float o[8];
#pragma unroll
        for (int j = 0; j < 8; ++j) o[j] = T[(kq * 8 + j) * 65 + n];
        *(u32x4*)(dst + (size_t)n * ld_dst + kq * 8) = pack8(o); }
    asm volatile("s_waitcnt lgkmcnt(0)" ::: "memory");
}

__device__ __forceinline__ void phase_init(Frame& F) {
    const PP p = F.p; const int tid = F.tid;
    LAS float* T = (LAS float*)F.lds;
    LAS float* sc = (LAS float*)(F.lds + 32768);
    LAS float* red = (LAS float*)(F.lds + 98304);
    constexpr int PER_L = 800 + 256 + 6 + 6 + 12 + 4 + 16, NTR = NL * PER_L, I_ZERO = NTR, I_MOD = I_ZERO + NL, I_ROPE = I_MOD + 192, I_ZROW = I_ROPE + 128, N_ITEMS = I_ZROW + 1;
    bool sc_ready = false;
    for (int it = F.bid; it < N_ITEMS; it += F.G) {
        if (it < NTR) {
            const int l = it / PER_L; int j = it % PER_L;
            if (j < 800) { const int kt = j / 50, ntile = j % 50; tr_tile(F.tid, T, p->w_in + (size_t)l * 1024 * INC + (size_t)kt * 64 * INC + ntile * 64, INC, (bf16_t*)(F.ws + WS_WINT) + (size_t)l * INP * 1024 + (size_t)ntile * 64 * 1024 + kt * 64, 1024, nullptr); continue; }
            j -= 800;
            if (j < 256) { const int kt = j / 16, ntile = j % 16; tr_tile(F.tid, T, p->w_out + (size_t)l * 1024 * 1024 + (size_t)kt * 64 * 1024 + ntile * 64, 1024, (bf16_t*)(F.ws + WS_WOUTT) + (size_t)l * 1024 * 1024 + (size_t)ntile * 64 * 1024 + kt * 64, 1024, nullptr); continue; }
            j -= 256;
            if (j < 6) { tr_tile(F.tid, T, p->rwkv_w_up + (size_t)l * 64 * 384 + j * 64, 384, (bf16_t*)(F.ws + WS_WUPT) + (size_t)l * 384 * 64 + (size_t)j * 64 * 64, 64, nullptr); continue; }
            j -= 6;
            if (j < 6) { tr_tile(F.tid, T, p->rwkv_a_up + (size_t)l * 64 * 384 + j * 64, 384, (bf16_t*)(F.ws + WS_AUPT) + (size_t)l * 384 * 64 + (size_t)j * 64 * 64, 64, nullptr); continue; }
            j -= 6;
            if (j < 12) { const int kt = j / 6, ntile = j % 6; tr_tile(F.tid, T, p->rwkv_g_up + (size_t)l * 128 * 384 + (size_t)kt * 64 * 384 + ntile * 64, 384, (bf16_t*)(F.ws + WS_GUPT) + (size_t)l * 384 * 128 + (size_t)ntile * 64 * 128 + kt * 64, 128, nullptr); continue; }
            j -= 12;
            if (j < 4) { tr_tile(F.tid, T, p->pool_w + ((size_t)l * 4 + j) * 64 * 64, 64, (bf16_t*)(F.ws + WS_POOLWT) + ((size_t)l * 4 + j) * 64 * 64, 64, nullptr); continue; }
            j -= 4;
            { bf16_t* hi = (bf16_t*)(F.ws + WS_WRT) + (size_t)l * 2 * 64 * 1024; tr_tile(F.tid, T, p->w_router + (size_t)l * 1024 * 64 + (size_t)j * 64 * 64, 64, hi + j * 64, 1024, hi + 64 * 1024 + j * 64); continue; }
        } else if (it < I_MOD) {
            const int l = it - I_ZERO; u32x4* z = (u32x4*)((bf16_t*)(F.ws + WS_WINT) + (size_t)l * INP * 1024 + (size_t)INC * 1024);
            for (int i = tid; i < 128 * 1024 * 2 / 16; i += NTHREADS) z[i] = (u32x4){0u, 0u, 0u, 0u};
        } else if (it < I_ROPE) {
            if (!sc_ready) { for (int i = tid; i < 16 * 1024; i += NTHREADS) { const float v = p->c[i]; sc[i] = v / (1.0f + __expf(-v)); } sc_ready = true; __syncthreads(); }
            const int j = it - I_MOD, l = j / 96, cb = j % 96, ks = tid >> 6, cl = tid & 63, col = cb * 64 + cl;
            float acc[16];
#pragma unroll
            for (int b = 0; b < 16; ++b) acc[b] = 0.f;
            const float* wp = p->w_ada + (size_t)l * 1024 * 6144 + col;
            for (int k = ks * 128; k < ks * 128 + 128; k += 4) {
                const float w0 = wp[(size_t)k * 6144], w1 = wp[(size_t)(k + 1) * 6144], w2 = wp[(size_t)(k + 2) * 6144], w3 = wp[(size_t)(k + 3) * 6144];
#pragma unroll
                for (int b = 0; b < 16; ++b) { const f32x4 s = *(const LAS f32x4*)(sc + b * 1024 + k); acc[b] += s[0] * w0 + s[1] * w1 + s[2] * w2 + s[3] * w3; }
            }
#pragma unroll
            for (int b = 0; b < 16; ++b) red[(ks * 16 + b) * 64 + cl] = acc[b];
            __syncthreads();
            for (int o = tid; o < 1024; o += NTHREADS) { const int b = o >> 6, c2 = o & 63; float s = p->b_ada[(size_t)l * 6144 + cb * 64 + c2];
#pragma unroll
                for (int q = 0; q < 8; ++q) s += red[(q * 16 + b) * 64 + c2];
                ((float*)(F.ws + WS_MOD))[((size_t)l * 16 + b) * 6144 + cb * 64 + c2] = s; }
            __syncthreads();
        } else if (it < I_ZROW) {
            const int idx = (it - I_ROPE) * NTHREADS + tid, pos = idx >> 5, cc = idx & 31;
            const float invf = __expf(-((float)(2 * cc) * (1.0f / 64.0f)) * 9.210340371976184f);
            const double ang = (double)pos * (double)invf, nn = __builtin_rint(ang * 0.15915494309189535), r = ang - nn * 6.283185307179586, r2 = r * r;
            double sn = 0.0, cs = 0.0;
#pragma unroll
            for (int k = 14; k >= 1; --k) { sn = sn * r2 * (-1.0 / (double)((2 * k) * (2 * k + 1))) + 1.0; cs = cs * r2 * (-1.0 / (double)((2 * k - 1) * (2 * k))) + 1.0; }
            sn *= r;
            ((float*)(F.ws + WS_ROPE))[idx] = (float)cs; ((float*)(F.ws + WS_ROPE))[2048 * 32 + idx] = (float)sn;
        } else {
            u32x4* z = (u32x4*)((bf16_t*)(F.ws + WS_H) + (size_t)NTOK * 1024);
            if (tid < 128) z[tid] = (u32x4){0u, 0u, 0u, 0u};
        }
    }
}

__device__ __forceinline__ void phase_norm(Frame& F, const float* xin, const float* g, const float* mod_l, int shift_off, int scale_off) {
    bf16_t* H = (bf16_t*)(F.ws + WS_H);
    for (int row = F.bid * 8 + F.wave; row < NTOK; row += F.G * 8) {
        const int b = row / SEQ; const float* xr = xin + (size_t)row * D; f32x4 v[4]; float ss = 0.f;
#pragma unroll
        for (int i = 0; i < 4; ++i) { v[i] = *(const f32x4*)(xr + i * 256 + F.lane * 4); ss += v[i][0] * v[i][0] + v[i][1] * v[i][1] + v[i][2] * v[i][2] + v[i][3] * v[i][3]; }
        ss = wave_sum(ss, F.lane); const float rstd = rsqrtf(ss * (1.0f / D) + 1e-6f);
#pragma unroll
        for (int i = 0; i < 4; ++i) { const int c0 = i * 256 + F.lane * 4; const f32x4 gg = *(const f32x4*)(g + c0), sc = *(const f32x4*)(mod_l + (size_t)b * 6144 + scale_off + c0), sh = *(const f32x4*)(mod_l + (size_t)b * 6144 + shift_off + c0);
            float o[4];
#pragma unroll
            for (int j = 0; j < 4; ++j) o[j] = v[i][j] * rstd * gg[j] * (1.0f + sc[j]) + sh[j];
            u32x2 w; w.x = pack2(o[0], o[1]); w.y = pack2(o[2], o[3]); *(u32x2*)(H + (size_t)row * D + c0) = w; }
    }
}

__device__ __forceinline__ void phase_final(Frame& F) {
    float* X = F.p->out;
    for (int row = F.bid * 8 + F.wave; row < NTOK; row += F.G * 8) {
        float* xr = X + (size_t)row * D; f32x4 v[4]; float ss = 0.f;
#pragma unroll
        for (int i = 0; i < 4; ++i) { v[i] = *(const f32x4*)(xr + i * 256 + F.lane * 4); ss += v[i][0] * v[i][0] + v[i][1] * v[i][1] + v[i][2] * v[i][2] + v[i][3] * v[i][3]; }
        ss = wave_sum(ss, F.lane); const float rstd = rsqrtf(ss * (1.0f / D) + 1e-6f);
#pragma unroll
        for (int i = 0; i < 4; ++i) { const int c0 = i * 256 + F.lane * 4; const f32x4 gg = *(const f32x4*)(F.p->final_g + c0); *(f32x4*)(xr + c0) = v[i] * rstd * gg; }
    }
}

__device__ __forceinline__ void rwkv_prep_tile(Frame& F, int l, int item) {
    const PP p = F.p; const int tid = F.tid, lane = F.lane, fr = lane & 15, fq = lane >> 4;
    const bf16_t* P = (const bf16_t*)(F.ws + WS_P);
    const int row0 = item * 32, b = row0 / SEQ, t0 = row0 % SEQ;
    constexpr int PSS = 1416, XWS = 72, XGS = 136;
    LAS bf16_t* PS = (LAS bf16_t*)F.lds;
    LAS bf16_t* XW = (LAS bf16_t*)(F.lds + 90624);
    LAS bf16_t* XA = (LAS bf16_t*)(F.lds + 90624 + 4608);
    LAS bf16_t* XG = (LAS bf16_t*)(F.lds + 90624 + 9216);
#pragma unroll 1
    for (int ito_ = 0; ito_ < 3; ++ito_)
#pragma unroll
    for (int iti_ = 0; iti_ < 4; ++iti_) {
        const int idx = tid + (ito_ * 4 + iti_) * NTHREADS; if (idx >= 32 * 176) continue;
        const int i = idx / 176, q = idx % 176, c0 = q * 8;
        const u32x4 cu = *(const u32x4*)(P + (size_t)(row0 + i) * INP + c0);
        u32x4 pv = (u32x4){0u, 0u, 0u, 0u}; if (t0 + i > 0) pv = *(const u32x4*)(P + (size_t)(row0 + i - 1) * INP + c0);
        float cf[8], pf[8], s[8]; unpack8(cu, cf); unpack8(pv, pf);
        const f32x4 m0 = *(const f32x4*)(p->rwkv_mu + (size_t)l * RCOLS + c0), m1 = *(const f32x4*)(p->rwkv_mu + (size_t)l * RCOLS + c0 + 4);
#pragma unroll
        for (int j = 0; j < 4; ++j) { s[j] = cf[j] + (pf[j] - cf[j]) * m0[j]; s[4 + j] = cf[4 + j] + (pf[4 + j] - cf[4 + j]) * m1[j]; }
        if (c0 < 1152) *(LAS u32x4*)(PS + i * PSS + c0) = pack8(s);
        else if (c0 < 1216) {
#pragma unroll
            for (int j = 0; j < 8; ++j) s[j] = tanhf_(s[j]);
            *(LAS u32x4*)(XW + i * XWS + (c0 - 1152)) = pack8(s);
        } else if (c0 < 1280) *(LAS u32x4*)(XA + i * XWS + (c0 - 1216)) = pack8(s);
        else {
#pragma unroll
            for (int j = 0; j < 8; ++j) s[j] = sigmoidf_(s[j]);
            *(LAS u32x4*)(XG + i * XGS + (c0 - 1280)) = pack8(s);
        }
    }
    __syncthreads();
    if (F.wave < 6) {
        const int hd = F.wave;
        const bf16_t* WU = (const bf16_t*)(F.ws + WS_WUPT) + (size_t)l * 384 * 64, *AU = (const bf16_t*)(F.ws + WS_AUPT) + (size_t)l * 384 * 64, *GU = (const bf16_t*)(F.ws + WS_GUPT) + (size_t)l * 384 * 128;
        float* SWp = (float*)(F.ws + WS_SW); bf16_t* SAp = (bf16_t*)(F.ws + WS_SX); bf16_t* SBp = SAp + SARR / 2; bf16_t* SKp = SBp + SARR / 2; bf16_t* SRp = SKp + SARR / 2; bf16_t* SVp = SRp + SARR / 2;
        bf16_t* Gp = (bf16_t*)(F.ws + WS_G);
#pragma unroll 1
        for (int mt = 0; mt < 2; ++mt) {
            const int i = mt * 16 + fr;
            const size_t ob = (((size_t)b * RH + hd) * SEQ + t0 + i) * 64;
            {
                f32x4 ag[4];
#pragma unroll
                for (int nt = 0; nt < 4; ++nt) ag[nt] = (f32x4){0.f, 0.f, 0.f, 0.f};
#pragma unroll
                for (int ks = 0; ks < 4; ++ks) {
                    const bf16x8 xg = *(const LAS bf16x8*)(XG + i * XGS + ks * 32 + fq * 8);
#pragma unroll
                    for (int nt = 0; nt < 4; ++nt) { const bf16x8 gf = *(const bf16x8*)(GU + (size_t)(hd * 64 + nt * 16 + fr) * 128 + ks * 32 + fq * 8); ag[nt] = __builtin_amdgcn_mfma_f32_16x16x32_bf16(gf, xg, ag[nt], 0, 0, 0); }
                }
#pragma unroll
                for (int nt = 0; nt < 4; ++nt) { u32x2 gw; gw.x = pack2(ag[nt][0], ag[nt][1]); gw.y = pack2(ag[nt][2], ag[nt][3]); *(u32x2*)(Gp + (size_t)(row0 + i) * RW + hd * 64 + nt * 16 + fq * 4) = gw; }
            }
            f32x4 aw[4], aa[4];
#pragma unroll
            for (int nt = 0; nt < 4; ++nt) { aw[nt] = (f32x4){0.f, 0.f, 0.f, 0.f}; aa[nt] = (f32x4){0.f, 0.f, 0.f, 0.f}; }
#pragma unroll
            for (int ks = 0; ks < 2; ++ks) {
                const bf16x8 xw = *(const LAS bf16x8*)(XW + i * XWS + ks * 32 + fq * 8), xa = *(const LAS bf16x8*)(XA + i * XWS + ks * 32 + fq * 8);
#pragma unroll
                for (int nt = 0; nt < 4; ++nt) {
                    const bf16x8 wf = *(const bf16x8*)(WU + (size_t)(hd * 64 + nt * 16 + fr) * 64 + ks * 32 + fq * 8), af = *(const bf16x8*)(AU + (size_t)(hd * 64 + nt * 16 + fr) * 64 + ks * 32 + fq * 8);
                    aw[nt] = __builtin_amdgcn_mfma_f32_16x16x32_bf16(wf, xw, aw[nt], 0, 0, 0); aa[nt] = __builtin_amdgcn_mfma_f32_16x16x32_bf16(af, xa, aa[nt], 0, 0, 0);
                }
            }
            float ss = 0.f;
#pragma unroll
            for (int nt = 0; nt < 4; ++nt) {
                const int ch0 = hd * 64 + nt * 16 + fq * 4;
                const u32x2 r2 = *(const LAS u32x2*)(PS + i * PSS + ch0), k2 = *(const LAS u32x2*)(PS + i * PSS + 384 + ch0), v2 = *(const LAS u32x2*)(PS + i * PSS + 768 + ch0);
                const float kf[4] = {bf2f(k2.x & 0xffffu), __uint_as_float(k2.x & 0xffff0000u), bf2f(k2.y & 0xffffu), __uint_as_float(k2.y & 0xffff0000u)};
                const f32x4 w0 = *(const f32x4*)(p->rwkv_w0 + (size_t)l * RW + ch0), a0 = *(const f32x4*)(p->rwkv_a0 + (size_t)l * RW + ch0), kkp = *(const f32x4*)(p->rwkv_k_k + (size_t)l * RW + ch0), kap = *(const f32x4*)(p->rwkv_k_a + (size_t)l * RW + ch0);
                f32x4 wv; float kn[4];
#pragma unroll
                for (int j = 0; j < 4; ++j) {
                    const float z = w0[j] + aw[nt][j]; wv[j] = __expf(-0.6065306597126334f * sigmoidf_(z));
                    const float a = sigmoidf_(a0[j] + aa[nt][j]); aa[nt][j] = a;
                    const float kv = kf[j] * kkp[j]; aw[nt][j] = kv; ss += kv * kv;
                    kn[j] = kf[j] * (1.0f + (a - 1.0f) * kap[j]);
                }
                *(f32x4*)(SWp + ob + nt * 16 + fq * 4) = wv;
                u32x2 kw; kw.x = pack2(kn[0], kn[1]); kw.y = pack2(kn[2], kn[3]); *(u32x2*)(SKp + ob + nt * 16 + fq * 4) = kw;
                *(u32x2*)(SRp + ob + nt * 16 + fq * 4) = r2; *(u32x2*)(SVp + ob + nt * 16 + fq * 4) = v2;
            }
            ss += shx(ss, 16, lane); ss += shx(ss, 32, lane);
            const float inv = 1.0f / fmaxf(sqrtf(ss), 1e-12f);
#pragma unroll
            for (int nt = 0; nt < 4; ++nt) {
                float av[4], bv[4];
#pragma unroll
                for (int j = 0; j < 4; ++j) { const float kn = aw[nt][j] * inv; av[j] = -kn; bv[j] = kn * aa[nt][j]; }
                u32x2 aw2, bw2; aw2.x = pack2(av[0], av[1]); aw2.y = pack2(av[2], av[3]); bw2.x = pack2(bv[0], bv[1]); bw2.y = pack2(bv[2], bv[3]);
                *(u32x2*)(SAp + ob + nt * 16 + fq * 4) = aw2; *(u32x2*)(SBp + ob + nt * 16 + fq * 4) = bw2;
            }
        }
    }
    __syncthreads();
}

__device__ __forceinline__ void phase_prep_rwkv(Frame& F, int l) {
    const PP p = F.p; const int tid = F.tid, lane = F.lane, w = F.wave, fr = lane & 15, fq = lane >> 4;
    const unsigned char* P = (const unsigned char*)(F.ws + WS_P);
    constexpr int RAWB = 24576, PS_OFF = 2 * RAWB, PSS = 1416, XWS = 72, XGS = 136, XW_OFF = PS_OFF + 16 * PSS * 2, XA_OFF = XW_OFF + 16 * XWS * 2, XG_OFF = XA_OFF + 16 * XWS * 2;
    LAS unsigned char* RAW = F.lds;
    LAS bf16_t* PS = (LAS bf16_t*)(F.lds + PS_OFF); LAS bf16_t* XW = (LAS bf16_t*)(F.lds + XW_OFF); LAS bf16_t* XA = (LAS bf16_t*)(F.lds + XA_OFF); LAS bf16_t* XG = (LAS bf16_t*)(F.lds + XG_OFF);
#define PREP_DMA(tile, buf) do { for (int m_ = w; m_ < 24; m_ += 8) { const int f_ = m_ * 64 + lane; int r_ = f_ / 88, ch_ = f_ % 88; int row_ = (tile) * 16 - 1 + r_; \
        if (f_ >= 1496 || row_ < 0) { row_ = 0; ch_ = 0; } \
        __builtin_amdgcn_global_load_lds((const unsigned*)(P + (size_t)row_ * INP + ch_ * 16), (LAS unsigned*)(RAW + (buf) * RAWB + m_ * 1024), 16, 0, 0); } } while (0)
    const int hd = w;
    const int wrow = hd * 64 + fr;
    const bf16_t* WU = (const bf16_t*)(F.ws + WS_WUPT) + (size_t)l * 384 * 64, *AU = (const bf16_t*)(F.ws + WS_AUPT) + (size_t)l * 384 * 64, *GU = (const bf16_t*)(F.ws + WS_GUPT) + (size_t)l * 384 * 128;
    u32x4 res[32];
#define WREG(nt, ks) __builtin_bit_cast(bf16x8, res[(nt) * 2 + (ks)])
#define AREG(nt, ks) __builtin_bit_cast(bf16x8, res[8 + (nt) * 2 + (ks)])
#define PW0(nt) __builtin_bit_cast(f32x4, res[16 + (nt)])
#define PA0(nt) __builtin_bit_cast(f32x4, res[20 + (nt)])
#define PKK(nt) __builtin_bit_cast(f32x4, res[24 + (nt)])
#define PKA(nt) __builtin_bit_cast(f32x4, res[28 + (nt)])
#define GFR(hl, ks, nt) __builtin_bit_cast(bf16x8, res[(hl) * 16 + (ks) * 4 + (nt)])
    if (w < 6) {
#pragma unroll
        for (int nt = 0; nt < 4; ++nt) {
#pragma unroll
            for (int ks = 0; ks < 2; ++ks) { res[nt * 2 + ks] = *(const u32x4*)(WU + (size_t)(wrow + nt * 16) * 64 + ks * 32 + fq * 8); res[8 + nt * 2 + ks] = *(const u32x4*)(AU + (size_t)(wrow + nt * 16) * 64 + ks * 32 + fq * 8); }
            const int ch0 = hd * 64 + nt * 16 + fq * 4;
            res[16 + nt] = *(const u32x4*)(p->rwkv_w0 + (size_t)l * RW + ch0); res[20 + nt] = *(const u32x4*)(p->rwkv_a0 + (size_t)l * RW + ch0); res[24 + nt] = *(const u32x4*)(p->rwkv_k_k + (size_t)l * RW + ch0); res[28 + nt] = *(const u32x4*)(p->rwkv_k_a + (size_t)l * RW + ch0);
        }
    }
    else {
#pragma unroll
        for (int hl = 0; hl < 2; ++hl)
#pragma unroll
            for (int ks = 0; ks < 4; ++ks)
#pragma unroll
                for (int nt = 0; nt < 4; ++nt) res[hl * 16 + ks * 4 + nt] = *(const u32x4*)(GU + (size_t)(((w - 6) * 3 + hl) * 64 + fr + nt * 16) * 128 + ks * 32 + fq * 8);
    }
    float* SWp = (float*)(F.ws + WS_SW); bf16_t* SAp = (bf16_t*)(F.ws + WS_SX); bf16_t* SBp = SAp + SARR / 2; bf16_t* SKp = SBp + SARR / 2; bf16_t* SRp = SKp + SARR / 2; bf16_t* SVp = SRp + SARR / 2;
    bf16_t* Gp = (bf16_t*)(F.ws + WS_G);
    LAS float* MU = (LAS float*)(F.lds + 114688);
    for (int i_ = tid; i_ < RCOLS; i_ += NTHREADS) MU[i_] = p->rwkv_mu[(size_t)l * RCOLS + i_];
    int tile = F.bid;
    if (tile < 2048) PREP_DMA(tile, 0);
    if (tile + F.G < 2048) PREP_DMA(tile + F.G, 1);
    int buf = 0;
    __syncthreads();
#pragma unroll 1
    for (; tile < 2048; tile += F.G, buf ^= 1) {
        const int row0 = tile * 16, b = row0 / SEQ, t0 = row0 % SEQ;
        LDS_BAR();
        const LAS unsigned char* raw = RAW + buf * RAWB;
#pragma unroll 1
        for (int idx = tid; idx < 16 * 88; idx += NTHREADS) {
            const int i = idx / 88, q = idx % 88, c0 = q * 16;
            const u32x4 cu = *(const LAS u32x4*)(raw + (i + 1) * 1408 + q * 16);
            u32x4 pv = *(const LAS u32x4*)(raw + i * 1408 + q * 16); if (t0 + i == 0) pv = (u32x4){0u, 0u, 0u, 0u};
            float cf[16], pf[16], sv[16]; unpack16f8(cu, cf, PINV); unpack16f8(pv, pf, PINV);
#pragma unroll
            for (int g4 = 0; g4 < 4; ++g4) { const f32x4 m4 = *(const LAS f32x4*)(MU + c0 + g4 * 4);
#pragma unroll
                for (int j = 0; j < 4; ++j) sv[g4 * 4 + j] = cf[g4 * 4 + j] + (pf[g4 * 4 + j] - cf[g4 * 4 + j]) * m4[j]; }
            LAS bf16_t* dst;
            if (c0 < 1152) dst = PS + i * PSS + c0;
            else if (c0 < 1216) { dst = XW + i * XWS + (c0 - 1152);
#pragma unroll
                for (int j = 0; j < 16; ++j) sv[j] = tanhf_(sv[j]); }
            else if (c0 < 1280) dst = XA + i * XWS + (c0 - 1216);
            else { dst = XG + i * XGS + (c0 - 1280);
#pragma unroll
                for (int j = 0; j < 16; ++j) sv[j] = sigmoidf_(sv[j]); }
            u32x4 o0, o1; o0.x = pack2(sv[0], sv[1]); o0.y = pack2(sv[2], sv[3]); o0.z = pack2(sv[4], sv[5]); o0.w = pack2(sv[6], sv[7]); o1.x = pack2(sv[8], sv[9]); o1.y = pack2(sv[10], sv[11]); o1.z = pack2(sv[12], sv[13]); o1.w = pack2(sv[14], sv[15]);
            *(LAS u32x4*)dst = o0; *(LAS u32x4*)(dst + 8) = o1;
        }
        __syncthreads();
        if (tile + 2 * F.G < 2048) PREP_DMA(tile + 2 * F.G, buf);
        if (w < 6) {
            const int i = fr;
            const size_t ob0 = (((size_t)b * RH + hd) * SEQ + t0) * 64;
            LAS unsigned char* sb = F.lds + 120320 + w * 4352; u32x2 kwv[4];
            f32x4 aw[4], aa[4];
#pragma unroll
            for (int nt = 0; nt < 4; ++nt) { aw[nt] = (f32x4){0.f, 0.f, 0.f, 0.f}; aa[nt] = (f32x4){0.f, 0.f, 0.f, 0.f}; }
#pragma unroll
            for (int ks = 0; ks < 2; ++ks) {
                const bf16x8 xw = *(const LAS bf16x8*)(XW + i * XWS + ks * 32 + fq * 8), xa = *(const LAS bf16x8*)(XA + i * XWS + ks * 32 + fq * 8);
#pragma unroll
                for (int nt = 0; nt < 4; ++nt) { aw[nt] = __builtin_amdgcn_mfma_f32_16x16x32_bf16(WREG(nt, ks), xw, aw[nt], 0, 0, 0); aa[nt] = __builtin_amdgcn_mfma_f32_16x16x32_bf16(AREG(nt, ks), xa, aa[nt], 0, 0, 0); }
            }
            float ss = 0.f;
#pragma unroll
            for (int nt = 0; nt < 4; ++nt) {
                const int ch0 = hd * 64 + nt * 16 + fq * 4;
                const u32x2 r2 = *(const LAS u32x2*)(PS + i * PSS + ch0), k2 = *(const LAS u32x2*)(PS + i * PSS + 384 + ch0), v2 = *(const LAS u32x2*)(PS + i * PSS + 768 + ch0);
                const float kf[4] = {bf2f(k2.x & 0xffffu), __uint_as_float(k2.x & 0xffff0000u), bf2f(k2.y & 0xffffu), __uint_as_float(k2.y & 0xffff0000u)};
                f32x4 wv; float kn[4];
#pragma unroll
                for (int j = 0; j < 4; ++j) {
                    const float z = PW0(nt)[j] + aw[nt][j]; wv[j] = __expf(-0.6065306597126334f * sigmoidf_(z));
                    const float a = sigmoidf_(PA0(nt)[j] + aa[nt][j]); aa[nt][j] = a;
                    const float kv = kf[j] * PKK(nt)[j]; aw[nt][j] = kv; ss += kv * kv;
                    kn[j] = kf[j] * (1.0f + (a - 1.0f) * PKA(nt)[j]);
                }
                *(LAS f32x4*)(sb + i * 272 + (nt * 16 + fq * 4) * 4) = wv;
                kwv[nt].x = pack2(kn[0], kn[1]); kwv[nt].y = pack2(kn[2], kn[3]);
            }
            asm volatile("" ::: "memory");
#pragma unroll
            for (int m = 0; m < 4; ++m) { const f32x4 v_ = *(const LAS f32x4*)(sb + (m * 4 + (lane >> 4)) * 272 + (lane & 15) * 16); *(f32x4*)(SWp + ob0 + (m * 64 + lane) * 4) = v_; }
            asm volatile("" ::: "memory");
#pragma unroll
            for (int nt = 0; nt < 4; ++nt) *(LAS u32x2*)(sb + i * 136 + (nt * 16 + fq * 4) * 2) = kwv[nt];
            asm volatile("" ::: "memory");
#pragma unroll
            for (int m = 0; m < 2; ++m) { const int rw_ = m * 8 + (lane >> 3), cb_ = (lane & 7) * 8;
                const u32x4 kq_ = *(const LAS u32x4*)(sb + rw_ * 136 + cb_ * 2), rq_ = *(const LAS u32x4*)(PS + rw_ * PSS + hd * 64 + cb_), vq_ = *(const LAS u32x4*)(PS + rw_ * PSS + 768 + hd * 64 + cb_);
                *(u32x4*)(SKp + ob0 + (m * 64 + lane) * 8) = kq_; *(u32x4*)(SRp + ob0 + (m * 64 + lane) * 8) = rq_; *(u32x4*)(SVp + ob0 + (m * 64 + lane) * 8) = vq_; }
            asm volatile("" ::: "memory");
            ss += shx(ss, 16, lane); ss += shx(ss, 32, lane);
            const float inv = 1.0f / fmaxf(sqrtf(ss), 1e-12f);
#pragma unroll
            for (int nt = 0; nt < 4; ++nt) {
                float av[4], bv[4];
#pragma unroll
                for (int j = 0; j < 4; ++j) { const float kq = aw[nt][j] * inv; av[j] = -kq; bv[j] = kq * aa[nt][j]; }
                u32x2 aw2; aw2.x = pack2(av[0], av[1]); aw2.y = pack2(av[2], av[3]); kwv[nt].x = pack2(bv[0], bv[1]); kwv[nt].y = pack2(bv[2], bv[3]);
                *(LAS u32x2*)(sb + i * 136 + (nt * 16 + fq * 4) * 2) = aw2;
            }
            asm volatile("" ::: "memory");
#pragma unroll
            for (int m = 0; m < 2; ++m) { const u32x4 q_ = *(const LAS u32x4*)(sb + (m * 8 + (lane >> 3)) * 136 + (lane & 7) * 16); *(u32x4*)(SAp + ob0 + (m * 64 + lane) * 8) = q_; }
            asm volatile("" ::: "memory");
#pragma unroll
            for (int nt = 0; nt < 4; ++nt) *(LAS u32x2*)(sb + i * 136 + (nt * 16 + fq * 4) * 2) = kwv[nt];
            asm volatile("" ::: "memory");
#pragma unroll
            for (int m = 0; m < 2; ++m) { const u32x4 q_ = *(const LAS u32x4*)(sb + (m * 8 + (lane >> 3)) * 136 + (lane & 7) * 16); *(u32x4*)(SBp + ob0 + (m * 64 + lane) * 8) = q_; }
            asm volatile("" ::: "memory");
        } else {
            const int i = fr; LAS unsigned char* sbg = F.lds + 120320 + w * 4352;
            bf16x8 xg[4];
#pragma unroll
            for (int ks = 0; ks < 4; ++ks) xg[ks] = *(const LAS bf16x8*)(XG + i * XGS + ks * 32 + fq * 8);
#pragma unroll
            for (int hl = 0; hl < 3; ++hl) {
                f32x4 ag[4];
#pragma unroll
                for (int nt = 0; nt < 4; ++nt) ag[nt] = (f32x4){0.f, 0.f, 0.f, 0.f};
#pragma unroll
                for (int ks = 0; ks < 4; ++ks)
#pragma unroll
                    for (int nt = 0; nt < 4; ++nt) { const bf16x8 gf = (hl < 2) ? GFR(hl & 1, ks, nt) : *(const bf16x8*)(GU + (size_t)(((w - 6) * 3 + 2) * 64 + fr + nt * 16) * 128 + ks * 32 + fq * 8);
                        ag[nt] = __builtin_amdgcn_mfma_f32_16x16x32_bf16(gf, xg[ks], ag[nt], 0, 0, 0); }
#pragma unroll
                for (int nt = 0; nt < 4; ++nt) { u32x2 gw; gw.x = pack2(ag[nt][0], ag[nt][1]); gw.y = pack2(ag[nt][2], ag[nt][3]); *(LAS u32x2*)(sbg + i * 136 + (nt * 16 + fq * 4) * 2) = gw; }
                asm volatile("" ::: "memory");
#pragma unroll
                for (int m = 0; m < 2; ++m) { const int rw_ = m * 8 + (lane >> 3); const u32x4 q_ = *(const LAS u32x4*)(sbg + rw_ * 136 + (lane & 7) * 16);
                    *(u32x4*)(Gp + (size_t)(row0 + rw_) * RW + ((w - 6) * 3 + hl) * 64 + (lane & 7) * 8) = q_; }
                asm volatile("" ::: "memory");
            }
        }
    }
#undef WREG
#undef AREG
#undef PW0
#undef PA0
#undef PKK
#undef PKA
#undef GFR
#undef PREP_DMA
    __syncthreads();
}

__device__ __forceinline__ void pool_tile(Frame& F, int l, int item) {
    const PP p = F.p; const int tid = F.tid, lane = F.lane, fr = lane & 15, fq = lane >> 4;
    const unsigned char* P = (const unsigned char*)(F.ws + WS_P);
    const int row0 = item * 64, t0 = row0 % SEQ;
    constexpr int PLS = 264;
    LAS float* U = (LAS float*)F.lds;
    LAS bf16_t* PL = (LAS bf16_t*)(F.lds + 81920);
#pragma unroll
    for (int it_ = 0; it_ < 3; ++it_) {
        const int idx = tid + it_ * NTHREADS; if (idx >= 79 * 16) break;
        const int r = idx >> 4, q = idx & 15, t = t0 - 15 + r; float f[16];
        if (t >= 0) { const u32x4 v = *(const u32x4*)(P + (size_t)(row0 - 15 + r) * INP + POOL_OFF + q * 16); unpack16f8(v, f, PINV); }
        else {
#pragma unroll
            for (int j = 0; j < 16; ++j) f[j] = 0.f;
        }
#pragma unroll
        for (int g4 = 0; g4 < 4; ++g4) *(LAS f32x4*)(U + r * 256 + q * 16 + g4 * 4) = (f32x4){f[g4 * 4], f[g4 * 4 + 1], f[g4 * 4 + 2], f[g4 * 4 + 3]};
    }
    __syncthreads();
    {
        const int c4 = (tid & 63) * 4, g = c4 >> 6, win = 2 << g, i0 = (tid >> 6) * 8;
        f32x4 sm = (f32x4){0.f, 0.f, 0.f, 0.f};
        for (int q = 0; q < win; ++q) sm += *(const LAS f32x4*)(U + (15 + i0 - q) * 256 + c4);
#pragma unroll 1
        for (int k = 0; k < 8; ++k) {
            const int i = i0 + k, t = t0 + i;
            const f32x4 cur = *(const LAS f32x4*)(U + (15 + i) * 256 + c4);
            if (k > 0) sm += cur - *(const LAS f32x4*)(U + (15 + i - win) * 256 + c4);
            const int cnt = (t + 1 < win) ? t + 1 : win; const float ic = 1.0f / (float)cnt;
            u32x2 w; w.x = pack2(sm[0] * ic - cur[0], sm[1] * ic - cur[1]); w.y = pack2(sm[2] * ic - cur[2], sm[3] * ic - cur[3]);
            *(LAS u32x2*)(PL + i * PLS + c4) = w;
        }
    }
    __syncthreads();
    {
        const int g = F.wave >> 1; const bf16_t* PW = (const bf16_t*)(F.ws + WS_POOLWT) + ((size_t)l * 4 + g) * 64 * 64;
        bf16_t* MX = (bf16_t*)(F.ws + WS_H);
#pragma unroll
        for (int mq = 0; mq < 2; ++mq) {
            const int mt = (F.wave & 1) * 2 + mq;
            f32x4 acc[4];
#pragma unroll
            for (int nt = 0; nt < 4; ++nt) acc[nt] = (f32x4){0.f, 0.f, 0.f, 0.f};
#pragma unroll
            for (int ks = 0; ks < 2; ++ks) {
                const bf16x8 xf = *(const LAS bf16x8*)(PL + (mt * 16 + fr) * PLS + g * 64 + ks * 32 + fq * 8);
#pragma unroll
                for (int nt = 0; nt < 4; ++nt) { const bf16x8 wf = *(const bf16x8*)(PW + (size_t)(nt * 16 + fr) * 64 + ks * 32 + fq * 8); acc[nt] = __builtin_amdgcn_mfma_f32_16x16x32_bf16(wf, xf, acc[nt], 0, 0, 0); }
            }
            LAS unsigned char* sbp = F.lds + 120320 + F.wave * 4352;
#pragma unroll
            for (int nt = 0; nt < 4; ++nt) {
                const int d0 = nt * 16 + fq * 4; const f32x4 ps = *(const f32x4*)(p->pool_scale + (size_t)l * 256 + g * 64 + d0);
                u32x2 w; w.x = pack2(acc[nt][0] * ps[0], acc[nt][1] * ps[1]); w.y = pack2(acc[nt][2] * ps[2], acc[nt][3] * ps[3]);
                *(LAS u32x2*)(sbp + fr * 136 + d0 * 2) = w;
            }
            asm volatile("" ::: "memory");
#pragma unroll
            for (int m = 0; m < 2; ++m) { const int rw_ = m * 8 + (lane >> 3); const u32x4 q_ = *(const LAS u32x4*)(sbp + rw_ * 136 + (lane & 7) * 16);
                *(u32x4*)(MX + (size_t)(row0 + mt * 16 + rw_) * D + 768 + g * 64 + (lane & 7) * 8) = q_; }
            asm volatile("" ::: "memory");
        }
    }
    __syncthreads();
}

__device__ __forceinline__ void rwkv_scan_block(Frame& F, int blk) {
    const int tid = F.tid, lane = F.lane, w = F.wave, rs = lane >> 4, jg = lane & 15;
    const int bh = blk >> 1, half = blk & 1, b = bh / RH, h = bh % RH;
    const int rl = w * 4 + rs;
    const size_t base = (size_t)bh * SEQ * 64;
    const float* SWp = (const float*)(F.ws + WS_SW) + base;
    const unsigned char* SXp = F.ws + WS_SX + base * 2;
    float* YS = (float*)(F.ws + WS_YS);
    LAS unsigned char* opb = F.lds;
    LAS unsigned char* yb2 = F.lds + 98304;
    f32x4 pw; u32x4 pb[3];
    float S[4] = {0.f, 0.f, 0.f, 0.f};
#define SCAN_LOAD(c) do { pw = *(const f32x4*)(SWp + (size_t)(c) * 2048 + tid * 4); \
        _Pragma("unroll") for (int q = 0; q < 3; ++q) { const int idx = tid + NTHREADS * q; if (idx < 1280) { const int arr = idx >> 8, ch = idx & 255; \
            pb[q] = *(const u32x4*)(SXp + (size_t)arr * SARR + ((size_t)(c) * 2048 + ch * 8) * 2); } } } while (0)
#define SCAN_STORE(buf) do { *(LAS f32x4*)(opb + (buf) * 49152 + tid * 16) = pw; \
        _Pragma("unroll") for (int q = 0; q < 3; ++q) { const int idx = tid + NTHREADS * q; if (idx < 1280) { const int arr = idx >> 8, ch = idx & 255; float f[8]; unpack8(pb[q], f); \
            LAS unsigned char* d = opb + (buf) * 49152 + (1 + arr) * 8192 + ch * 32; *(LAS f32x4*)d = (f32x4){f[0], f[1], f[2], f[3]}; *(LAS f32x4*)(d + 16) = (f32x4){f[4], f[5], f[6], f[7]}; } } } while (0)
#define SCAN_OPS(st, W4, A4, B4, K4, R4, V1) do { W4 = *(const LAS f32x4*)(ob + (st) * 256); A4 = *(const LAS f32x4*)(ob + 8192 + (st) * 256); B4 = *(const LAS f32x4*)(ob + 16384 + (st) * 256); \
        K4 = *(const LAS f32x4*)(ob + 24576 + (st) * 256); R4 = *(const LAS f32x4*)(ob + 32768 + (st) * 256); V1 = *(const LAS float*)(vb + (st) * 256); } while (0)
    SCAN_LOAD(0); SCAN_STORE(0); __syncthreads();
#pragma unroll 1
    for (int c = 0; c < SEQ / 32; ++c) {
        const int buf = c & 1;
        if (c + 1 < SEQ / 32) SCAN_LOAD(c + 1);
        const LAS unsigned char* ob = opb + buf * 49152 + jg * 16;
        const LAS unsigned char* vb = opb + buf * 49152 + 5 * 8192 + (half * 32 + rl) * 4;
        float yk0 = 0.f, yk1 = 0.f;
        f32x4 cw, ca, cb, ck, cr; float cv;
        SCAN_OPS(0, cw, ca, cb, ck, cr, cv);
        float yp = 0.f;
#pragma unroll
        for (int st = 0; st < 32; ++st) {
            f32x4 nw = cw, na = ca, nb = cb, nk = ck, nr = cr; float nv = cv;
            if (st + 1 < 32) SCAN_OPS(st + 1, nw, na, nb, nk, nr, nv);
            float sa = S[0] * ca[0]; sa = __builtin_fmaf(S[1], ca[1], sa); sa = __builtin_fmaf(S[2], ca[2], sa); sa = __builtin_fmaf(S[3], ca[3], sa);
            sa += dpp_ror<8>(sa); yp += dpp_ror<8>(yp); sa += dpp_ror<4>(sa); yp += dpp_ror<4>(yp); sa += dpp_ror<2>(sa); yp += dpp_ror<2>(yp); sa += dpp_ror<1>(sa); yp += dpp_ror<1>(yp);
            if (st >= 1) { if (st - 1 < 16) yk0 = (jg == st - 1) ? yp : yk0; else yk1 = (jg == st - 17) ? yp : yk1; }
#pragma unroll
            for (int j = 0; j < 4; ++j) { float t_ = cv * ck[j]; t_ = __builtin_fmaf(sa, cb[j], t_); S[j] = __builtin_fmaf(S[j], cw[j], t_); asm volatile("" : "+v"(S[j])); }
            yp = S[0] * cr[0]; yp = __builtin_fmaf(S[1], cr[1], yp); yp = __builtin_fmaf(S[2], cr[2], yp); yp = __builtin_fmaf(S[3], cr[3], yp);
            cw = nw; ca = na; cb = nb; ck = nk; cr = nr; cv = nv;
        }
        yp = row16_sum(yp); yk1 = (jg == 15) ? yp : yk1;
        { LAS float* yo = (LAS float*)(yb2 + buf * 4096); yo[jg * 32 + rl] = yk0; yo[(16 + jg) * 32 + rl] = yk1; }
        if (c + 1 < SEQ / 32) SCAN_STORE(buf ^ 1);
        __syncthreads();
        if (tid < 256) { const int st = tid >> 3, c4 = tid & 7; const f32x4 yv = *(const LAS f32x4*)(yb2 + buf * 4096 + st * 128 + c4 * 16);
          *(f32x4*)(YS + ((size_t)b * SEQ + c * 32 + st) * RW + h * 64 + half * 32 + c4 * 4) = yv; }
    }
#undef SCAN_LOAD
#undef SCAN_STORE
#undef SCAN_OPS
    __syncthreads();
}

__device__ __forceinline__ void retention_item(Frame& F, int bh) {
    const int tid = F.tid, lane = F.lane, w = F.wave, fr = lane & 15, fq = lane >> 4;
    const int b = bh / RH, h = bh % RH;
    const unsigned char* P = (const unsigned char*)(F.ws + WS_P);
    const float* ROPE = (const float*)(F.ws + WS_ROPE);
    bf16_t* MX = (bf16_t*)(F.ws + WS_H);
    constexpr int QS = 72, TS = 136;
    LAS bf16_t* Qs = (LAS bf16_t*)F.lds;
    LAS bf16_t* Ks = (LAS bf16_t*)(F.lds + 18432);
    LAS bf16_t* KTs = (LAS bf16_t*)(F.lds + 36864);
    LAS bf16_t* VTs = (LAS bf16_t*)(F.lds + 54272);
    LAS bf16_t* Ps = (LAS bf16_t*)(F.lds + 71680);
    LAS bf16_t* RTs = (LAS bf16_t*)(F.lds + 106496);
    const float lg = log1pf(-exp2f(-5.0f - (float)h)), lg2 = lg * 1.4426950408889634f;
    const float cd = exp2f(lg2 * 128.0f);
    for (int i = tid; i < 64 * QS / 2; i += NTHREADS) ((LAS unsigned*)RTs)[i] = 0u;
    f32x4 Rreg[2] = {(f32x4){0.f, 0.f, 0.f, 0.f}, (f32x4){0.f, 0.f, 0.f, 0.f}};
    for (int n = 0; n < SEQ / 128; ++n) {
        const int tok0 = b * SEQ + n * 128;
        __syncthreads();
        {
            const int tk = tid >> 2, part = tid & 3, c0 = part * 8, pos = n * 128 + tk;
            const unsigned char* pb = P + (size_t)(tok0 + tk) * INP + RET_OFF + h * 64;
            float ql[8], qh[8], kl[8], kh[8], cs[8], sn[8];
            unpack8f8(*(const u32x2*)(pb + c0), ql, PINV); unpack8f8(*(const u32x2*)(pb + 32 + c0), qh, PINV);
            unpack8f8(*(const u32x2*)(pb + 384 + c0), kl, PINV); unpack8f8(*(const u32x2*)(pb + 384 + 32 + c0), kh, PINV);
            { const f32x4 c_0 = *(const f32x4*)(ROPE + pos * 32 + c0), c_1 = *(const f32x4*)(ROPE + pos * 32 + c0 + 4), s_0 = *(const f32x4*)(ROPE + 65536 + pos * 32 + c0), s_1 = *(const f32x4*)(ROPE + 65536 + pos * 32 + c0 + 4);
#pragma unroll
              for (int j = 0; j < 4; ++j) { cs[j] = c_0[j]; cs[4 + j] = c_1[j]; sn[j] = s_0[j]; sn[4 + j] = s_1[j]; } }
            float q1[8], q2[8], k1[8], k2[8];
#pragma unroll
            for (int j = 0; j < 8; ++j) { q1[j] = ql[j] * cs[j] - qh[j] * sn[j]; q2[j] = ql[j] * sn[j] + qh[j] * cs[j]; k1[j] = (kl[j] * cs[j] - kh[j] * sn[j]) * 0.125f; k2[j] = (kl[j] * sn[j] + kh[j] * cs[j]) * 0.125f; }
            *(LAS u32x4*)(Qs + tk * QS + c0) = pack8(q1); *(LAS u32x4*)(Qs + tk * QS + 32 + c0) = pack8(q2);
            *(LAS u32x4*)(Ks + tk * QS + c0) = pack8(k1); *(LAS u32x4*)(Ks + tk * QS + 32 + c0) = pack8(k2);
            const float zeta = exp2f(lg2 * (float)(127 - tk));
#pragma unroll
            for (int j = 0; j < 8; ++j) { KTs[(c0 + j) * TS + tk] = (bf16_t)f2bf(k1[j] * zeta); KTs[(32 + c0 + j) * TS + tk] = (bf16_t)f2bf(k2[j] * zeta); }
            { float vf[16]; unpack16f8(*(const u32x4*)(pb + 768 + part * 16), vf, PINV);
#pragma unroll
              for (int j = 0; j < 16; ++j) VTs[(part * 16 + j) * TS + tk] = (bf16_t)f2bf(vf[j]); }
        }
        __syncthreads();
        const int i0 = 16 * w;
        f32x4 yc[4];
        {
            bf16x8 qf[2];
#pragma unroll
            for (int ks = 0; ks < 2; ++ks) qf[ks] = *(const LAS bf16x8*)(Qs + (i0 + fr) * QS + ks * 32 + fq * 8);
            for (int jt = 0; jt <= w; ++jt) {
                f32x4 a = (f32x4){0.f, 0.f, 0.f, 0.f};
#pragma unroll
                for (int ks = 0; ks < 2; ++ks) { const bf16x8 kf = *(const LAS bf16x8*)(Ks + (jt * 16 + fr) * QS + ks * 32 + fq * 8); a = __builtin_amdgcn_mfma_f32_16x16x32_bf16(kf, qf[ks], a, 0, 0, 0); }
                const int i = i0 + fr, j0 = jt * 16 + fq * 4; float o[4];
#pragma unroll
                for (int r = 0; r < 4; ++r) { const int dd = i - (j0 + r); o[r] = (dd >= 0) ? a[r] * exp2f(lg2 * (float)dd) : 0.f; }
                u32x2 pw2; pw2.x = pack2(o[0], o[1]); pw2.y = pack2(o[2], o[3]); *(LAS u32x2*)(Ps + i * TS + j0) = pw2;
            }
            if ((w & 1) == 0) { *(LAS u32x2*)(Ps + (i0 + fr) * TS + (w + 1) * 16 + fq * 4) = (u32x2){0u, 0u}; }
#pragma unroll
            for (int et = 0; et < 4; ++et) { f32x4 a = (f32x4){0.f, 0.f, 0.f, 0.f};
#pragma unroll
                for (int ks = 0; ks < 2; ++ks) { const bf16x8 rf = *(const LAS bf16x8*)(RTs + (et * 16 + fr) * QS + ks * 32 + fq * 8); a = __builtin_amdgcn_mfma_f32_16x16x32_bf16(rf, qf[ks], a, 0, 0, 0); }
                yc[et] = a; }
        }
        __syncthreads();
        {
            f32x4 y[4];
#pragma unroll
            for (int et = 0; et < 4; ++et) y[et] = (f32x4){0.f, 0.f, 0.f, 0.f};
            const int kmax = (i0 + 15) >> 5;
            for (int ks = 0; ks <= kmax; ++ks) {
                const bf16x8 pf = *(const LAS bf16x8*)(Ps + (i0 + fr) * TS + ks * 32 + fq * 8);
#pragma unroll
                for (int et = 0; et < 4; ++et) { const bf16x8 vf = *(const LAS bf16x8*)(VTs + (et * 16 + fr) * TS + ks * 32 + fq * 8); y[et] = __builtin_amdgcn_mfma_f32_16x16x32_bf16(vf, pf, y[et], 0, 0, 0); }
            }
            const float xi = exp2f(lg2 * (float)(i0 + fr + 1)); float ss = 0.f;
#pragma unroll
            for (int et = 0; et < 4; ++et)
#pragma unroll
                for (int r = 0; r < 4; ++r) { const float v = y[et][r] + xi * yc[et][r]; y[et][r] = v; ss += v * v; }
            ss += shx(ss, 16, lane); ss += shx(ss, 32, lane);
            const float rn = rsqrtf(ss * (1.0f / 64.0f) + 1e-6f);
            const size_t row = (size_t)tok0 + i0 + fr;
#pragma unroll
            for (int et = 0; et < 4; ++et) {
                const int e0 = et * 16 + fq * 4; float gf[4]; unpack4f8(*(const unsigned*)(P + row * INP + RET_OFF + 1152 + h * 64 + e0), gf, PINV); float o[4];
#pragma unroll
                for (int r = 0; r < 4; ++r) o[r] = gf[r] * sigmoidf_(gf[r]) * y[et][r] * rn;
                u32x2 w2; w2.x = pack2(o[0], o[1]); w2.y = pack2(o[2], o[3]); *(u32x2*)(MX + row * D + 384 + h * 64 + e0) = w2;
            }
        }
        {
#pragma unroll
            for (int s = 0; s < 2; ++s) {
                const int tt = 2 * w + s, dt = tt >> 2, et = tt & 3; f32x4 a = (f32x4){0.f, 0.f, 0.f, 0.f};
#pragma unroll
                for (int ks = 0; ks < 4; ++ks) { const bf16x8 kf = *(const LAS bf16x8*)(KTs + (dt * 16 + fr) * TS + ks * 32 + fq * 8), vf = *(const LAS bf16x8*)(VTs + (et * 16 + fr) * TS + ks * 32 + fq * 8);
                    a = __builtin_amdgcn_mfma_f32_16x16x32_bf16(kf, vf, a, 0, 0, 0); }
                Rreg[s] = Rreg[s] * cd + a;
                u32x2 w2; w2.x = pack2(Rreg[s][0], Rreg[s][1]); w2.y = pack2(Rreg[s][2], Rreg[s][3]);
                *(LAS u32x2*)(RTs + (et * 16 + fr) * QS + dt * 16 + fq * 4) = w2;
            }
        }
    }
    __syncthreads();
}

typedef short bf16x4 __attribute__((ext_vector_type(4)));
__device__ __forceinline__ bf16x4 cvt4(const f32x4 v) { u32x2 w; w.x = pack2(v[0], v[1]); w.y = pack2(v[2], v[3]); return __builtin_bit_cast(bf16x4, w); }
__device__ __forceinline__ bf16x8 cvt8(const f32x4 a, const f32x4 b) { u32x4 w; w.x = pack2(a[0], a[1]); w.y = pack2(a[2], a[3]); w.z = pack2(b[0], b[1]); w.w = pack2(b[2], b[3]); return __builtin_bit_cast(bf16x8, w); }
__device__ __forceinline__ f32x4 mm4(const f32x4 fat, const f32x4 fb, f32x4 c) {
#pragma unroll
    for (int i = 0; i < 4; ++i) c = __builtin_amdgcn_mfma_f32_16x16x4f32(fat[i], fb[i], c, 0, 0, 0);
    return c;
}
constexpr int CK_IMG = 8 * 272;
constexpr int CK_AH = 0, CK_RH = CK_IMG, CK_T = 2 * CK_IMG, CK_ARB = CK_T + 512, CK_BT = CK_ARB + 512, CK_KT = CK_BT + 2048, CK_PL = CK_KT + 2048, CK_V = CK_PL + 256, CK_CAK = CK_V + 2048, CK_CRK = CK_CAK + 2048, CK_BYTES = CK_CRK + 2048;
constexpr int CK_STG = 8 * CK_BYTES;
static_assert(CK_STG + 8 * 2 * CK_IMG <= MISC_OFF, "chunk images exceed LDS");

struct ChunkRaw { float w[16]; unsigned a[16], b[16], k[16], r[16], v[16]; };
__device__ __forceinline__ void rwkv_chunk_load(ChunkRaw& R, const int lane, const float* SWp, const bf16_t* SXp, const int t0) {
    const float* wp = SWp + (size_t)t0 * 64 + lane;
    const bf16_t* ap = SXp + (size_t)t0 * 64 + lane, *bp = ap + SARR / 2, *kp = bp + SARR / 2, *rp = kp + SARR / 2, *vp = rp + SARR / 2;
#pragma unroll
    for (int t = 0; t < 16; ++t) { R.w[t] = wp[t * 64]; R.a[t] = ap[t * 64]; R.b[t] = bp[t * 64]; R.k[t] = kp[t * 64]; R.r[t] = rp[t * 64]; R.v[t] = vp[t * 64]; }
}
__device__ __forceinline__ void rwkv_chunk_prep(const ChunkRaw& R, const int lane, LAS unsigned char* pk, LAS unsigned char* stg) {
    const int c = lane, cp = c & 31;
    const int ahb = ((c >> 5) * 4 + ((cp & 15) >> 2)) * 272 + ((cp >> 4) * 4 + (cp & 3)) * 2;
    const int btb = ((c >> 4) * 64 + (c & 15)) * 8;
    float P[16];
    { float run = 1.0f;
#pragma unroll
      for (int t = 0; t < 16; ++t) { run *= R.w[t]; P[t] = run; } }
    const float PL = P[15];
    *(LAS float*)(pk + CK_PL + c * 4) = PL;
#pragma unroll
    for (int kg = 0; kg < 4; ++kg) {
        float btv[4], ktv[4], vv[4];
#pragma unroll
        for (int i2 = 0; i2 < 4; i2 += 2) {
            float ah[2], rh[2], bh[2], kh[2];
#pragma unroll
            for (int u = 0; u < 2; ++u) {
                const int i = i2 + u, t = kg * 4 + i;
                const float a = bf2f(R.a[t]), b = bf2f(R.b[t]), k = bf2f(R.k[t]), r = bf2f(R.r[t]);
                const float Pi = __builtin_amdgcn_rcpf(P[t]), Pm = (t == 0) ? 1.0f : P[t == 0 ? 0 : t - 1], Pe = PL * Pi;
                ah[u] = a * Pm; rh[u] = r * P[t]; bh[u] = b * Pi; kh[u] = k * Pi;
                btv[i] = b * Pe; ktv[i] = k * Pe; vv[i] = bf2f(R.v[t]);
            }
            const int t = kg * 4 + i2;
            const unsigned pa = pack2(ah[0], ah[1]), pr = pack2(rh[0], rh[1]), pb = pack2(bh[0], bh[1]), pkk = pack2(kh[0], kh[1]);
            *(LAS unsigned short*)(pk + CK_AH + ahb + t * 16) = (unsigned short)pa; *(LAS unsigned short*)(pk + CK_AH + ahb + t * 16 + 16) = (unsigned short)(pa >> 16);
            *(LAS unsigned short*)(pk + CK_RH + ahb + t * 16) = (unsigned short)pr; *(LAS unsigned short*)(pk + CK_RH + ahb + t * 16 + 16) = (unsigned short)(pr >> 16);
            *(LAS unsigned short*)(stg + ahb + t * 16) = (unsigned short)pb; *(LAS unsigned short*)(stg + ahb + t * 16 + 16) = (unsigned short)(pb >> 16);
            *(LAS unsigned short*)(stg + CK_IMG + ahb + t * 16) = (unsigned short)pkk; *(LAS unsigned short*)(stg + CK_IMG + ahb + t * 16 + 16) = (unsigned short)(pkk >> 16);
        }
        u32x2 w0, w1, w2; w0.x = pack2(btv[0], btv[1]); w0.y = pack2(btv[2], btv[3]); w1.x = pack2(ktv[0], ktv[1]); w1.y = pack2(ktv[2], ktv[3]); w2.x = pack2(vv[0], vv[1]); w2.y = pack2(vv[2], vv[3]);
        *(LAS u32x2*)(pk + CK_BT + btb + kg * 128) = w0; *(LAS u32x2*)(pk + CK_KT + btb + kg * 128) = w1; *(LAS u32x2*)(pk + CK_V + btb + kg * 128) = w2;
    }
    asm volatile("s_waitcnt lgkmcnt(0)" ::: "memory");
    const int n = lane & 15, kg4 = (lane >> 4) * 4;
    const f32x4 z4 = (f32x4){0.f, 0.f, 0.f, 0.f};
    f32x4 FN, FNT, FARB, FAAK, FARK;
    { bf16x8 ah[2], rh[2], bh[2], kh[2];
#pragma unroll
      for (int s_ = 0; s_ < 2; ++s_) { const int io = (s_ * 4 + (lane >> 4)) * 272 + (lane & 15) * 16;
          ah[s_] = *(const LAS bf16x8*)(pk + CK_AH + io); rh[s_] = *(const LAS bf16x8*)(pk + CK_RH + io);
          bh[s_] = *(const LAS bf16x8*)(stg + io); kh[s_] = *(const LAS bf16x8*)(stg + CK_IMG + io); }
      FN = z4; FNT = z4; FARB = z4; FAAK = z4; FARK = z4;
#pragma unroll
      for (int s_ = 0; s_ < 2; ++s_) {
          FN   = __builtin_amdgcn_mfma_f32_16x16x32_bf16(ah[s_], bh[s_], FN, 0, 0, 0);
          FNT  = __builtin_amdgcn_mfma_f32_16x16x32_bf16(bh[s_], ah[s_], FNT, 0, 0, 0);
          FARB = __builtin_amdgcn_mfma_f32_16x16x32_bf16(bh[s_], rh[s_], FARB, 0, 0, 0);
          FAAK = __builtin_amdgcn_mfma_f32_16x16x32_bf16(kh[s_], ah[s_], FAAK, 0, 0, 0);
          FARK = __builtin_amdgcn_mfma_f32_16x16x32_bf16(kh[s_], rh[s_], FARK, 0, 0, 0);
      } }
    f32x4 ID;
#pragma unroll
    for (int i = 0; i < 4; ++i) {
        const int m = kg4 + i;
        FN[i] = (n < m) ? FN[i] : 0.f;
        FNT[i] = (m < n) ? FNT[i] : 0.f; FAAK[i] = (m < n) ? FAAK[i] : 0.f;
        FARB[i] = (m <= n) ? FARB[i] : 0.f; FARK[i] = (m <= n) ? FARK[i] : 0.f;
        ID[i] = (m == n) ? 1.0f : 0.f;
    }
    const f32x4 FN2 = mm4(FNT, FN, z4), FN2T = mm4(FN, FNT, z4);
    const f32x4 FN4 = mm4(FN2T, FN2, z4), FN4T = mm4(FN2, FN2T, z4);
    const f32x4 FN8T = mm4(FN4, FN4T, z4);
    const f32x4 FQ1 = ID + FNT, FQ1T = ID + FN;
    const f32x4 FQ2 = mm4(FQ1T, FN2T, FQ1), FQ2T = mm4(FQ1, FN2, FQ1T);
    const f32x4 FQ3 = mm4(FQ2T, FN4T, FQ2), FQ3T = mm4(FQ2, FN4, FQ2T);
    const f32x4 FTT = mm4(FQ3T, FN8T, FQ3);
    *(LAS bf16x4*)(pk + CK_T + lane * 8) = cvt4(FTT);
    *(LAS bf16x4*)(pk + CK_ARB + lane * 8) = cvt4(FARB);
    const bf16x4 aak = cvt4(FAAK), ark = cvt4(FARK);
#pragma unroll
    for (int q = 0; q < 4; ++q) {
        const bf16x4 vq = *(const LAS bf16x4*)(pk + CK_V + (q * 64 + lane) * 8);
        const f32x4 cak = __builtin_amdgcn_mfma_f32_16x16x16bf16_1k(aak, vq, z4, 0, 0, 0), crk = __builtin_amdgcn_mfma_f32_16x16x16bf16_1k(ark, vq, z4, 0, 0, 0);
        *(LAS bf16x4*)(pk + CK_CAK + (q * 64 + lane) * 8) = cvt4(cak); *(LAS bf16x4*)(pk + CK_CRK + (q * 64 + lane) * 8) = cvt4(crk);
    }
}

struct ChunkEarly { bf16x8 ah0, ah1, rh0, rh1; bf16x4 top; u32x2 cak; };
struct ChunkLate { bf16x4 arb, vop, bt[4], kt[4]; f32x4 pl[4]; u32x2 crk; };
__device__ __forceinline__ void rwkv_chunk_early(ChunkEarly& O, const LAS unsigned char* pk, const int q, const int lane) {
    const int io = (lane >> 4) * 272 + (lane & 15) * 16;
    O.ah0 = *(const LAS bf16x8*)(pk + CK_AH + io); O.ah1 = *(const LAS bf16x8*)(pk + CK_AH + io + 4 * 272);
    O.rh0 = *(const LAS bf16x8*)(pk + CK_RH + io); O.rh1 = *(const LAS bf16x8*)(pk + CK_RH + io + 4 * 272);
    O.cak = *(const LAS u32x2*)(pk + CK_CAK + (q * 64 + lane) * 8); O.top = *(const LAS bf16x4*)(pk + CK_T + lane * 8);
}
__device__ __forceinline__ void rwkv_chunk_late(ChunkLate& O, const LAS unsigned char* pk, const int q, const int lane) {
    O.arb = *(const LAS bf16x4*)(pk + CK_ARB + lane * 8); O.vop = *(const LAS bf16x4*)(pk + CK_V + (q * 64 + lane) * 8);
    O.crk = *(const LAS u32x2*)(pk + CK_CRK + (q * 64 + lane) * 8);
#pragma unroll
    for (int mt = 0; mt < 4; ++mt) { O.pl[mt] = *(const LAS f32x4*)(pk + CK_PL + (mt * 16 + (lane >> 4) * 4) * 4);
        O.bt[mt] = *(const LAS bf16x4*)(pk + CK_BT + (mt * 64 + lane) * 8); O.kt[mt] = *(const LAS bf16x4*)(pk + CK_KT + (mt * 64 + lane) * 8); }
}

__device__ __forceinline__ void rwkv_chunk_block(Frame& F, int bh) {
    const int lane = F.lane, w = F.wave;
    const int b = bh / RH, h = bh % RH;
    const size_t base = (size_t)bh * SEQ * 64;
    const float* SWp = (const float*)(F.ws + WS_SW) + base;
    const bf16_t* SXp = (const bf16_t*)(F.ws + WS_SX) + base;
    float* YSp = (float*)(F.ws + WS_YS) + (size_t)b * SEQ * RW + h * 64 + w * 16 + (lane & 15);
    f32x4 Sacc[4];
#pragma unroll
    for (int mt = 0; mt < 4; ++mt) Sacc[mt] = (f32x4){0.f, 0.f, 0.f, 0.f};
    const f32x4 z4 = (f32x4){0.f, 0.f, 0.f, 0.f};
    ChunkRaw R; rwkv_chunk_load(R, lane, SWp, SXp, w * 16);
#pragma unroll 1
    for (int grp = 0; grp < SEQ / 128; ++grp) {
#pragma unroll
        for (int t = 0; t < 16; ++t) asm volatile("" : "+v"(R.v[t]));
        rwkv_chunk_prep(R, lane, F.lds + w * CK_BYTES, F.lds + CK_STG + w * 2 * CK_IMG);
        if (grp + 1 < SEQ / 128) rwkv_chunk_load(R, lane, SWp, SXp, (grp + 1) * 128 + w * 16);
        LDS_BAR();
        if (w < 4) {
            ChunkEarly C; rwkv_chunk_early(C, F.lds, w, lane);
#pragma unroll 1
            for (int g = 0; g < 8; ++g) {
                ChunkLate Lt; rwkv_chunk_late(Lt, F.lds + g * CK_BYTES, w, lane);
                ChunkEarly N = C;
                if (g + 1 < 8) rwkv_chunk_early(N, F.lds + (g + 1) * CK_BYTES, w, lane);
                const bf16x8 s0 = cvt8(Sacc[0], Sacc[1]), s1 = cvt8(Sacc[2], Sacc[3]);
                f32x4 W1 = __builtin_amdgcn_mfma_f32_16x16x32_bf16(C.ah0, s0, z4, 0, 0, 0); W1 = __builtin_amdgcn_mfma_f32_16x16x32_bf16(C.ah1, s1, W1, 0, 0, 0);
                f32x4 Y = __builtin_amdgcn_mfma_f32_16x16x32_bf16(C.rh0, s0, z4, 0, 0, 0); Y = __builtin_amdgcn_mfma_f32_16x16x32_bf16(C.rh1, s1, Y, 0, 0, 0);
                W1[0] += bf2f(C.cak.x & 0xffffu); W1[1] += __uint_as_float(C.cak.x & 0xffff0000u); W1[2] += bf2f(C.cak.y & 0xffffu); W1[3] += __uint_as_float(C.cak.y & 0xffff0000u);
                const f32x4 U = __builtin_amdgcn_mfma_f32_16x16x16bf16_1k(C.top, cvt4(W1), z4, 0, 0, 0);
                const bf16x4 uop = cvt4(U);
#pragma unroll
                for (int mt = 0; mt < 4; ++mt) {
                    f32x4 a_;
#pragma unroll
                    for (int i = 0; i < 4; ++i) { float v_ = Sacc[mt][i] * Lt.pl[mt][i]; asm volatile("" : "+v"(v_)); a_[i] = v_; }
                    a_ = __builtin_amdgcn_mfma_f32_16x16x16bf16_1k(Lt.kt[mt], Lt.vop, a_, 0, 0, 0);
                    a_ = __builtin_amdgcn_mfma_f32_16x16x16bf16_1k(Lt.bt[mt], uop, a_, 0, 0, 0);
                    Sacc[mt] = a_;
                }
                Y = __builtin_amdgcn_mfma_f32_16x16x16bf16_1k(Lt.arb, uop, Y, 0, 0, 0);
                Y[0] += bf2f(Lt.crk.x & 0xffffu); Y[1] += __uint_as_float(Lt.crk.x & 0xffff0000u); Y[2] += bf2f(Lt.crk.y & 0xffffu); Y[3] += __uint_as_float(Lt.crk.y & 0xffff0000u);
                { float* yo = YSp + (size_t)(grp * 128 + g * 16 + (lane >> 4) * 4) * RW;
#pragma unroll
                  for (int i = 0; i < 4; ++i) yo[(size_t)i * RW] = Y[i]; }
                C = N;
            }
        }
        LDS_BAR();
    }
}

__device__ __forceinline__ void phase_rwkv_post(Frame& F, int l) {
    const PP p = F.p; const int lane = F.lane;
    const float* YS = (const float*)(F.ws + WS_YS); const bf16_t* SKp = (const bf16_t*)(F.ws + WS_SX) + 2 * (SARR / 2); const bf16_t* SRp = SKp + SARR / 2; const bf16_t* SVp = SRp + SARR / 2;
    const bf16_t* Gp = (const bf16_t*)(F.ws + WS_G); bf16_t* MX = (bf16_t*)(F.ws + WS_H);
    const float lw_[6] = {p->rwkv_lnx_w[(size_t)l * RW + lane], p->rwkv_lnx_w[(size_t)l * RW + 64 + lane], p->rwkv_lnx_w[(size_t)l * RW + 128 + lane], p->rwkv_lnx_w[(size_t)l * RW + 192 + lane], p->rwkv_lnx_w[(size_t)l * RW + 256 + lane], p->rwkv_lnx_w[(size_t)l * RW + 320 + lane]};
    (void)lw_;
#pragma unroll 1
    for (int it0 = (F.bid * 8 + F.wave) * 4; it0 < NTOK * RH; it0 += F.G * 8 * 4) {
        float y[4], r[4], k[4], v[4], g[4], lw[4], lb[4], rk[4]; int tokv[4], chv[4];
#pragma unroll
        for (int q = 0; q < 4; ++q) {
            const int it = it0 + q, tok = it / RH, h = it % RH, b = tok / SEQ, t = tok % SEQ, ch = h * 64 + lane;
            const size_t so = (((size_t)b * RH + h) * SEQ + t) * 64 + lane;
            tokv[q] = tok; chv[q] = ch;
            y[q] = YS[(size_t)tok * RW + ch]; r[q] = bf2f(SRp[so]); k[q] = bf2f(SKp[so]); v[q] = bf2f(SVp[so]); g[q] = bf2f(Gp[(size_t)tok * RW + ch]);
            lw[q] = p->rwkv_lnx_w[(size_t)l * RW + ch]; lb[q] = p->rwkv_lnx_b[(size_t)l * RW + ch]; rk[q] = p->rwkv_r_k[(size_t)l * RW + ch];
        }
#pragma unroll
        for (int q = 0; q < 4; ++q) {
            const float mean = wave_sum(y[q], lane) * (1.0f / 64.0f); const float d = y[q] - mean; const float var = wave_sum(d * d, lane) * (1.0f / 64.0f);
            const float yn = d * rsqrtf(var + 64e-5f) * lw[q] + lb[q];
            const float bonus = wave_sum(r[q] * k[q] * rk[q], lane) * v[q];
            MX[(size_t)tokv[q] * D + chv[q]] = (bf16_t)f2bf((yn + bonus) * g[q]);
        }
    }
}

__device__ __forceinline__ void phase_norm2_router(Frame& F, int l, bool count) {
    const PP p = F.p; const int tid = F.tid, lane = F.lane, w = F.wave, fr = lane & 15, fq = lane >> 4;
    const bf16_t* XBp = (const bf16_t*)(F.ws + WS_XB); bf16_t* H = (bf16_t*)(F.ws + WS_H);
    const float* mod_l = (const float*)(F.ws + WS_MOD) + (size_t)l * 16 * 6144;
    constexpr int HS = 1032;
    LAS bf16_t* HI = (LAS bf16_t*)F.lds;
    LAS bf16_t* LO = (LAS bf16_t*)(F.lds + 66048);
    LAS float* PART = (LAS float*)F.lds;
    LAS float* LG = (LAS float*)(F.lds + 132096);
    LAS unsigned* HIST = (LAS unsigned*)(F.lds + 132096 + 8192);
    LAS float* TA = (LAS float*)(F.lds + 132096 + 8192 + 256);
    LAS float* TB = TA + 1024;
#define STAGE_MOD2(tile_) do { if (tid < 256 && (tile_) < 1024) { const int b_ = ((tile_) * 32) / SEQ, c_ = tid * 4; \
        const f32x4 gg = *(const f32x4*)(p->norm2_g + (size_t)l * D + c_), sc = *(const f32x4*)(mod_l + (size_t)b_ * 6144 + 4096 + c_), sh = *(const f32x4*)(mod_l + (size_t)b_ * 6144 + 3072 + c_); \
        *(LAS f32x4*)(TA + c_) = (f32x4){gg[0] * (1.0f + sc[0]), gg[1] * (1.0f + sc[1]), gg[2] * (1.0f + sc[2]), gg[3] * (1.0f + sc[3])}; *(LAS f32x4*)(TB + c_) = sh; } } while (0)
    bf16x8 bh[4][4], bl[4][4];
    { const bf16_t* WH = (const bf16_t*)(F.ws + WS_WRT) + (size_t)l * 2 * 64 * 1024, *WL = WH + 64 * 1024;
#pragma unroll
      for (int nt = 0; nt < 4; ++nt)
#pragma unroll
          for (int ks = 0; ks < 4; ++ks) { bh[nt][ks] = *(const bf16x8*)(WH + (size_t)(nt * 16 + fr) * 1024 + w * 128 + ks * 32 + fq * 8); bl[nt][ks] = *(const bf16x8*)(WL + (size_t)(nt * 16 + fr) * 1024 + w * 128 + ks * 32 + fq * 8); } }
    const float bias = p->router_bias[(size_t)l * NE + lane];
    STAGE_MOD2(F.bid);
    __syncthreads();
#pragma unroll 1
    for (int tile = F.bid; tile < 1024; tile += F.G) {
        const int row0 = tile * 32;
        GPTR wsg_ = (GPTR)F.ws; asm volatile("" : "+s"(wsg_)); unsigned char* wsl = (unsigned char*)wsg_;
        if (tid < 64) HIST[tid] = 0u;
#pragma unroll 1
        for (int qq = 0; qq < 4; qq += 2) {
            u32x2 xr[2][4];
#pragma unroll
            for (int q = 0; q < 2; ++q)
#pragma unroll
                for (int u = 0; u < 4; ++u) xr[q][u] = *(const u32x2*)(XBp + (size_t)(row0 + w * 4 + qq + q) * D + u * 256 + lane * 4);
#pragma unroll
            for (int q = 0; q < 2; ++q) {
                const int i = w * 4 + qq + q, row = row0 + i; float ss = 0.f;
#pragma unroll
                for (int u = 0; u < 4; ++u) { const float x0 = bf2f(xr[q][u].x & 0xffffu), x1 = __uint_as_float(xr[q][u].x & 0xffff0000u), x2 = bf2f(xr[q][u].y & 0xffffu), x3 = __uint_as_float(xr[q][u].y & 0xffff0000u); ss += x0 * x0 + x1 * x1 + x2 * x2 + x3 * x3; }
                ss = wave_sum(ss, lane); const float rstd = rsqrtf(ss * (1.0f / D) + 1e-6f);
#pragma unroll
                for (int u = 0; u < 4; ++u) { const int c0 = u * 256 + lane * 4; const f32x4 ta = *(const LAS f32x4*)(TA + c0), tb = *(const LAS f32x4*)(TB + c0);
                    const float xq[4] = {bf2f(xr[q][u].x & 0xffffu), __uint_as_float(xr[q][u].x & 0xffff0000u), bf2f(xr[q][u].y & 0xffffu), __uint_as_float(xr[q][u].y & 0xffff0000u)};
                    float o[4], lo[4]; unsigned hb[4];
#pragma unroll
                    for (int j = 0; j < 4; ++j) { o[j] = xq[j] * rstd * ta[j] + tb[j]; hb[j] = f2bf(o[j]); lo[j] = o[j] - bf2f(hb[j]); }
                    u32x2 wh; wh.x = hb[0] | (hb[1] << 16); wh.y = hb[2] | (hb[3] << 16); *(u32x2*)(H + (size_t)row * D + c0) = wh; *(LAS u32x2*)(HI + i * HS + c0) = wh;
                    u32x2 wl; wl.x = pack2(lo[0], lo[1]); wl.y = pack2(lo[2], lo[3]); *(LAS u32x2*)(LO + i * HS + c0) = wl; }
            }
        }
        __syncthreads();
        f32x4 acc[2][4];
#pragma unroll
        for (int mt = 0; mt < 2; ++mt) {
#pragma unroll
            for (int nt = 0; nt < 4; ++nt) acc[mt][nt] = (f32x4){0.f, 0.f, 0.f, 0.f};
#pragma unroll
            for (int ks = 0; ks < 4; ++ks) {
                const bf16x8 ah = *(const LAS bf16x8*)(HI + (mt * 16 + fr) * HS + w * 128 + ks * 32 + fq * 8), al = *(const LAS bf16x8*)(LO + (mt * 16 + fr) * HS + w * 128 + ks * 32 + fq * 8);
#pragma unroll
                for (int nt = 0; nt < 4; ++nt) {
                    acc[mt][nt] = __builtin_amdgcn_mfma_f32_16x16x32_bf16(ah, bh[nt][ks], acc[mt][nt], 0, 0, 0);
                    acc[mt][nt] = __builtin_amdgcn_mfma_f32_16x16x32_bf16(al, bh[nt][ks], acc[mt][nt], 0, 0, 0);
                    acc[mt][nt] = __builtin_amdgcn_mfma_f32_16x16x32_bf16(ah, bl[nt][ks], acc[mt][nt], 0, 0, 0);
                }
            }
        }
        __syncthreads();
#pragma unroll
        for (int mt = 0; mt < 2; ++mt)
#pragma unroll
            for (int nt = 0; nt < 4; ++nt)
#pragma unroll
                for (int r = 0; r < 4; ++r) PART[(w * 32 + mt * 16 + fq * 4 + r) * 64 + nt * 16 + fr] = acc[mt][nt][r];
        __syncthreads();
        for (int o = tid; o < 32 * 64; o += NTHREADS) { float sacc = 0.f;
#pragma unroll
            for (int q = 0; q < 8; ++q) sacc += PART[q * 2048 + o];
            LG[o] = sacc; }
        __syncthreads();
        {
            const int g = lane >> 3;
#pragma unroll 1
            for (int q = 0; q < 4; ++q) {
                const int i = w * 4 + q, row = row0 + i;
                const float sc = sigmoidf_(LG[i * 64 + lane]), c = sc + bias;
                const float m1 = gmax8(c);
                const unsigned long long eqm = __ballot(c == m1);
                const unsigned byte = (unsigned)(eqm >> (g * 8)) & 0xffu;
                const int first = __builtin_ctz(byte | 0x100u);
                const float c2 = ((lane & 7) == first) ? -INFINITY : c;
                const float gs = m1 + gmax8(c2);
                int rg = 0;
#pragma unroll
                for (int g2 = 0; g2 < 8; ++g2) { const float sg = __builtin_bit_cast(float, __builtin_amdgcn_readlane(__builtin_bit_cast(int, gs), g2 * 8)); rg += ((sg > gs) || (sg == gs && g2 < g)) ? 1 : 0; }
                const bool elig = rg < 4;
                unsigned u = __float_as_uint(c); u = (u & 0x80000000u) ? ~u : (u | 0x80000000u); u = (u & ~63u) | (unsigned)(63 - lane);
                const unsigned key = elig ? u : 0u;
                int rk = 0;
#pragma unroll
                for (int j = 0; j < 64; ++j) { const unsigned kj = (unsigned)__builtin_amdgcn_readlane((int)key, j); rk += (kj > key) ? 1 : 0; }
                const bool sel = elig && rk < 8;
                const float wsum = wave_sum(sel ? sc : 0.f, lane);
                if (sel) { ((int*)(wsl + WS_TOPI))[(size_t)row * 8 + rk] = lane; ((float*)(wsl + WS_TOPW))[(size_t)row * 8 + rk] = sc * 2.5f / wsum;
                    __hip_atomic_fetch_add(&HIST[lane], 1u, __ATOMIC_RELAXED, __HIP_MEMORY_SCOPE_WORKGROUP); }
            }
        }
        __syncthreads();
        if (tid < 64) { const unsigned c = HIST[tid]; ((unsigned*)(wsl + WS_TILECNT))[(size_t)tile * 64 + tid] = c;
            if (c && count) atomicAdd((unsigned*)(wsl + WS_CTL + CTL_TOTALS) + ((size_t)l * 2 + (tile >> 9)) * 64 + tid, c); }
        STAGE_MOD2(tile + F.G);
        __syncthreads();
    }
#undef STAGE_MOD2
}

__device__ __forceinline__ void expert_convert_wave(Frame& F, int l, int j) {
    const PP p = F.p; LAS float* T = (LAS float*)(F.lds + F.wave * 16640);
    const int e = j / 192, r = j % 192, kind = r / 64, q = r % 64;
    bf16_t* WGU = (bf16_t*)(F.ws + WS_WGU) + (size_t)e * 512 * 1024; bf16_t* WD = (bf16_t*)(F.ws + WS_WD) + (size_t)e * 1024 * 256;
    if (kind < 2) {
        const float* src = (e < 64) ? ((kind == 0 ? p->we_gate : p->we_up) + ((size_t)l * NE + e) * 1024 * 256) : ((kind == 0 ? p->ws_gate : p->ws_up) + (size_t)l * 1024 * 256);
        const int kt = q >> 2, ntile = q & 3, n0 = ntile * 64, drow = (n0 >> 7) * 256 + (n0 & 127) + kind * 128;
        tr_tile_wave(F.lane, T, src + (size_t)kt * 64 * 256 + n0, 256, WGU + (size_t)drow * 1024 + kt * 64, 1024);
    } else {
        const float* src = (e < 64) ? (p->we_down + ((size_t)l * NE + e) * 256 * 1024) : (p->ws_down + (size_t)l * 256 * 1024);
        const int kt = q >> 4, ntile = q & 15;
        tr_tile_wave(F.lane, T, src + (size_t)kt * 64 * 1024 + ntile * 64, 1024, WD + (size_t)ntile * 64 * 256 + kt * 64, 256);
    }
}

__device__ __forceinline__ void convert_queue(Frame& F, int l, int qi) {
    volatile LAS int* slot = (volatile LAS int*)(F.lds + MISC_OFF + 64);
    unsigned* ctr = (unsigned*)(F.ws + WS_CTL + CTL_QUEUE) + qi * 64;
#pragma unroll 1
    for (;;) {
        __syncthreads();
        if (F.tid == 0) *slot = (int)atomicAdd(ctr, 1u);
        __syncthreads();
        const int item = *slot;
        if (item >= 65 * 192 / 8) break;
        expert_convert_wave(F, l, item * 8 + F.wave);
    }
}

__device__ __forceinline__ void phase_route(Frame& F, int l) {
    const int tid = F.tid;
    LAS int* PST = (LAS int*)F.lds;
    LAS int* PEN = PST + 128;
    LAS int* CNT = PST + 256;
    LAS unsigned* PART = (LAS unsigned*)(PST + 384);
    LAS unsigned* BASE = PART + 512;
    LAS unsigned* LCNT = BASE + 64;
    const unsigned* totals = (const unsigned*)(F.ws + WS_CTL + CTL_TOTALS) + (size_t)l * 2 * 64;
    if (tid < 2) { int run = 0; for (int e = 0; e < 64; ++e) { const int c = (int)ld_u32_agent(totals + tid * 64 + e); CNT[tid * 64 + e] = c; PST[tid * 64 + e] = run; run += (c + 255) & ~255; PEN[tid * 64 + e] = run; } }
    __syncthreads();
    if (F.bid == 0 && tid < 128) ((int*)(F.ws + WS_PADEND))[tid] = PEN[tid];
    if (F.bid == 0) for (int t = tid; t < 2 * 576; t += NTHREADS) { const int hf2 = t / 576, rt = t % 576; int e = 0; while (e < 63 && rt * 256 >= PEN[hf2 * 64 + e]) ++e; ((int*)(F.ws + WS_TILEE))[t] = e; }
    const unsigned* tc = (const unsigned*)(F.ws + WS_TILECNT);
    int* rowtok = (int*)(F.ws + WS_ROWTOK); float* roww = (float*)(F.ws + WS_ROWW); int* rowdst = (int*)(F.ws + WS_ROWDST);
    for (int tile = F.bid; tile < 1024; tile += F.G) {
        const int hf = tile >> 9, e = tid & 63, part = tid >> 6; unsigned s = 0;
        for (int t2 = hf * 512 + part; t2 < tile; t2 += 8) s += tc[(size_t)t2 * 64 + e];
        PART[part * 64 + e] = s;
        __syncthreads();
        if (tid < 64) { unsigned b = (unsigned)PST[hf * 64 + tid];
#pragma unroll
            for (int q = 0; q < 8; ++q) b += PART[q * 64 + tid];
            BASE[tid] = b; LCNT[tid] = 0u; }
        __syncthreads();
        if (tid < 256) { const int i = tid >> 3, k = tid & 7, tok = tile * 32 + i; const int ex = ((const int*)(F.ws + WS_TOPI))[(size_t)tok * 8 + k]; const float wv = ((const float*)(F.ws + WS_TOPW))[(size_t)tok * 8 + k];
            const unsigned r = __hip_atomic_fetch_add(&LCNT[ex], 1u, __ATOMIC_RELAXED, __HIP_MEMORY_SCOPE_WORKGROUP); const size_t pos = (size_t)hf * PMAXH + BASE[ex] + r;
            rowtok[pos] = tok; roww[pos] = wv; rowdst[pos] = (tok - hf * HT) * 9 + k; }
        __syncthreads();
    }
    if (F.bid < 128) { const int hf = F.bid >> 6, e = F.bid & 63; const int s = PST[hf * 64 + e] + CNT[hf * 64 + e], en = PEN[hf * 64 + e];
        for (int pos = s + tid; pos < en; pos += NTHREADS) { rowtok[(size_t)hf * PMAXH + pos] = NTOK; roww[(size_t)hf * PMAXH + pos] = 0.f; rowdst[(size_t)hf * PMAXH + pos] = -1; } }
    __syncthreads();
}

__device__ __forceinline__ int load_padend(Frame& F, int hf) {
    LAS int* pe = (LAS int*)(F.lds + MISC_OFF + 256);
    __syncthreads();
    if (F.tid < 64) pe[F.tid] = (int)ld_u32_agent((const unsigned*)(F.ws + WS_PADEND) + hf * 64 + F.tid);
    { LAS int* te = (LAS int*)(F.lds + TILEE_OFF); for (int t = F.tid; t < 576; t += NTHREADS) te[t] = (int)ld_u32_agent((const unsigned*)(F.ws + WS_TILEE) + hf * 576 + t); }
    __syncthreads();
    return __builtin_amdgcn_readfirstlane(pe[63]) >> 8;
}
constexpr int ROWMETA_OFF = 131072;
__device__ __forceinline__ void run_gu(Frame& F, int hf) {
    const int ntr = load_padend(F, hf);
    LAS int* ltok = (LAS int*)(F.lds + ROWMETA_OFF); LAS float* lw = (LAS float*)(F.lds + ROWMETA_OFF + 8 * 1024);
    { const int* rowtok = (const int*)(F.ws + WS_ROWTOK) + (size_t)hf * PMAXH; const float* roww = (const float*)(F.ws + WS_ROWW) + (size_t)hf * PMAXH;
      for (int i = 0; i < 8; ++i) { const int uu = F.bid + i * F.G; if (uu >= (ntr + 64) * 2) break; const int rt = uu >> 1;
          if (rt < ntr && F.tid < 256) { ltok[i * 256 + F.tid] = rowtok[rt * 256 + F.tid]; lw[i * 256 + F.tid] = roww[rt * 256 + F.tid]; } }
      __syncthreads(); }
    TaskGU t; t.A = (const char*)(F.ws + WS_H); t.W = (const char*)(F.ws + WS_WGU); t.ltok = ltok; t.lw = lw;
    t.act = (bf16_t*)(F.ws + WS_ACT); t.tilee = (const LAS int*)(F.lds + TILEE_OFF); t.hf = hf; t.ntr = ntr; t.G = F.G; t.c = F.bid;
    pg8::gemm_run(F.lds, t);
}
__device__ __forceinline__ void run_down(Frame& F, int hf) {
    const int ntr = load_padend(F, hf);
    LAS int* ldst = (LAS int*)(F.lds + ROWMETA_OFF);
    { const int* rowdst = (const int*)(F.ws + WS_ROWDST) + (size_t)hf * PMAXH;
      for (int i = 0; i < 16; ++i) { const int uu = F.bid + i * F.G; if (uu >= (ntr + 64) * 4) break; const int rt = uu >> 2;
          if (rt < ntr && F.tid < 256) ldst[i * 256 + F.tid] = rowdst[rt * 256 + F.tid]; }
      __syncthreads(); }
    TaskDown t; t.A = (const char*)(F.ws + WS_ACT); t.W = (const char*)(F.ws + WS_WD); t.ldst = ldst; t.yb = (unsigned char*)(F.ws + WS_YB);
    t.tilee = (const LAS int*)(F.lds + TILEE_OFF); t.hf = hf; t.ntr = ntr; t.G = F.G; t.c = F.bid;
    pg8::gemm_run(F.lds, t);
}
__device__ __forceinline__ void phase_combine(Frame& F, int l, int hf) {
    typedef float f32x2v __attribute__((ext_vector_type(2)));
    const PP p = F.p; const int lane = F.lane;
    const unsigned char* YB = (const unsigned char*)(F.ws + WS_YB); float* X = p->out; bf16_t* XBp = (bf16_t*)(F.ws + WS_XB); bf16_t* H = (bf16_t*)(F.ws + WS_H);
    const float* mod_l = (const float*)(F.ws + WS_MOD) + (size_t)l * 16 * 6144;
    const float* mod_n = (const float*)(F.ws + WS_MOD) + (size_t)1 * 16 * 6144;
    const int c0 = lane * 16;
#pragma unroll 1
    for (int tl = F.bid * 8 + F.wave; tl < HT; tl += F.G * 8) {
        const int tok = hf * HT + tl, b = tok / SEQ;
        u32x4 yv[9];
#pragma unroll
        for (int k = 0; k < 9; ++k) yv[k] = *(const u32x4*)(YB + ((size_t)tl * 9 + k) * 1024 + c0);
        f32x4 xv[4], gv[4];
        { float xa[8], xc[8]; unpack8(*(const u32x4*)(XBp + (size_t)tok * D + c0), xa); unpack8(*(const u32x4*)(XBp + (size_t)tok * D + c0 + 8), xc);
          xv[0] = (f32x4){xa[0], xa[1], xa[2], xa[3]}; xv[1] = (f32x4){xa[4], xa[5], xa[6], xa[7]}; xv[2] = (f32x4){xc[0], xc[1], xc[2], xc[3]}; xv[3] = (f32x4){xc[4], xc[5], xc[6], xc[7]}; }
#pragma unroll
        for (int q = 0; q < 4; ++q) gv[q] = *(const f32x4*)(mod_l + (size_t)b * 6144 + 5120 + c0 + q * 4);
        float s[16];
#pragma unroll
        for (int j = 0; j < 16; ++j) s[j] = 0.f;
#pragma unroll
        for (int k = 0; k < 9; ++k) { const unsigned wd[4] = {yv[k].x, yv[k].y, yv[k].z, yv[k].w};
#pragma unroll
            for (int q = 0; q < 4; ++q) { const f32x2v lo = __builtin_amdgcn_cvt_pk_f32_fp8((int)wd[q], false), hi = __builtin_amdgcn_cvt_pk_f32_fp8((int)wd[q], true);
                s[q * 4 + 0] += lo.x; s[q * 4 + 1] += lo.y; s[q * 4 + 2] += hi.x; s[q * 4 + 3] += hi.y; } }
        float xn[16]; float ss = 0.f;
#pragma unroll
        for (int q = 0; q < 4; ++q)
#pragma unroll
            for (int j = 0; j < 4; ++j) { const float v = xv[q][j] + gv[q][j] * (s[q * 4 + j] * 0.015625f); xn[q * 4 + j] = v; ss += v * v; }
        ss = wave_sum(ss, lane); const float rstd = rsqrtf(ss * (1.0f / D) + 1e-6f);
        if (l == 0) {
            float o[16];
            { u32x4 x0, x1; x0.x = pack2(xn[0], xn[1]); x0.y = pack2(xn[2], xn[3]); x0.z = pack2(xn[4], xn[5]); x0.w = pack2(xn[6], xn[7]); x1.x = pack2(xn[8], xn[9]); x1.y = pack2(xn[10], xn[11]); x1.z = pack2(xn[12], xn[13]); x1.w = pack2(xn[14], xn[15]);
              *(u32x4*)(XBp + (size_t)tok * D + c0) = x0; *(u32x4*)(XBp + (size_t)tok * D + c0 + 8) = x1; }
#pragma unroll
            for (int q = 0; q < 4; ++q) {
                const f32x4 gg = *(const f32x4*)(p->norm1_g + (size_t)D + c0 + q * 4), sc = *(const f32x4*)(mod_n + (size_t)b * 6144 + 1024 + c0 + q * 4), sh = *(const f32x4*)(mod_n + (size_t)b * 6144 + c0 + q * 4);
#pragma unroll
                for (int j = 0; j < 4; ++j) o[q * 4 + j] = xn[q * 4 + j] * rstd * gg[j] * (1.0f + sc[j]) + sh[j]; }
            u32x4 h0, h1; h0.x = pack2(o[0], o[1]); h0.y = pack2(o[2], o[3]); h0.z = pack2(o[4], o[5]); h0.w = pack2(o[6], o[7]); h1.x = pack2(o[8], o[9]); h1.y = pack2(o[10], o[11]); h1.z = pack2(o[12], o[13]); h1.w = pack2(o[14], o[15]);
            *(u32x4*)(H + (size_t)tok * D + c0) = h0; *(u32x4*)(H + (size_t)tok * D + c0 + 8) = h1;
        } else {
#pragma unroll
            for (int q = 0; q < 4; ++q) { const f32x4 gg = *(const f32x4*)(p->final_g + c0 + q * 4);
                *(f32x4*)(X + (size_t)tok * D + c0 + q * 4) = (f32x4){xn[q * 4] * rstd * gg[0], xn[q * 4 + 1] * rstd * gg[1], xn[q * 4 + 2] * rstd * gg[2], xn[q * 4 + 3] * rstd * gg[3]}; }
        }
    }
}

#define LAUNDER() do { F.tid = opaque_tid(); F.lane = F.tid & 63; F.wave = __builtin_amdgcn_readfirstlane(F.tid >> 6); \
        { PP q_ = (PP)__builtin_amdgcn_kernarg_segment_ptr(); asm volatile("" : "+s"(q_)); F.p = q_; } \
        { GPTR w_ = (GPTR)F.p->ws; asm volatile("" : "+s"(w_)); F.ws = (unsigned char*)w_; } \
        { LAS unsigned char* l_ = (LAS unsigned char*)smem; asm volatile("" : "+s"(l_)); F.lds = l_; } \
        { int b_ = blockIdx.x; asm volatile("" : "+s"(b_)); F.bid = b_; } \
        { unsigned x_ = bar.x; asm volatile("" : "+s"(x_)); bar.x = x_; } } while (0)
#define PHASE(ph, ...) do { if (lo <= (ph) && (ph) < hi) { LAUNDER(); { __VA_ARGS__; } if ((ph) + 1 < hi) xcd_barrier(bar); } } while (0)
#define PHASE_R(ph, s, ...) do { PHASE(ph, __VA_ARGS__); if ((s) == REPEAT_STEP) PHASE(ph, __VA_ARGS__); } while (0)

__global__ void __launch_bounds__(NTHREADS, 2) mega(Params prm_unused) {
    extern __shared__ __attribute__((aligned(16))) unsigned char smem[];
    Frame F;
    F.p = (PP)__builtin_amdgcn_kernarg_segment_ptr();
    F.lds = (LAS unsigned char*)smem; F.ws = F.p->ws;
    F.tid = opaque_tid(); F.lane = F.tid & 63; F.wave = __builtin_amdgcn_readfirstlane(F.tid >> 6); F.G = gridDim.x; F.bid = blockIdx.x;
    volatile LAS unsigned* misc = (volatile LAS unsigned*)(F.lds + MISC_OFF);
    if (F.tid < 4) misc[F.tid] = 0u;
    __syncthreads();
    XcdBarrier bar; bar.bar = (unsigned*)(F.ws + WS_CTL); bar.x = 0; bar.st = misc;
    const int lo = F.p->ph_lo, hi = F.p->ph_hi;
    if (hi - lo > 1) bar = xcd_barrier_post((unsigned*)(F.ws + WS_CTL), misc);
#define MODP ((const float*)(F.ws + WS_MOD))
#define LAYER(l) \
    if ((l) == 0) PHASE_R(1 + 13 * (l) + 0, 0, phase_norm(F, F.p->x, F.p->norm1_g, MODP, 0, 1024)); \
    PHASE_R(1 + 13 * (l) + 1, 1, TaskIn t; t.A = (const char*)(F.ws + WS_H); t.Bt = (const char*)(F.ws + WS_WINT) + (size_t)(l) * INP * 1024 * 2; t.O = (unsigned char*)(F.ws + WS_P); t.G = F.G; t.c = F.bid; pg8::gemm_run(F.lds, t)); \
    PHASE_R(1 + 13 * (l) + 2, 2, phase_prep_rwkv(F, (l)); for (int it = F.bid; it < 512; it += F.G) pool_tile(F, (l), it)); \
    PHASE(1 + 13 * (l) + 3, if (F.bid < 96) rwkv_chunk_block(F, F.bid); else for (int it = F.bid - 96; it < 96; it += F.G - 96) retention_item(F, it); \
        F.tid = opaque_tid(); F.lane = F.tid & 63; F.wave = __builtin_amdgcn_readfirstlane(F.tid >> 6); convert_queue(F, (l), (l))); \
    if (3 == REPEAT_STEP) PHASE(1 + 13 * (l) + 3, if (F.bid < 96) rwkv_chunk_block(F, F.bid); else for (int it = F.bid - 96; it < 96; it += F.G - 96) retention_item(F, it); \
        F.tid = opaque_tid(); F.lane = F.tid & 63; F.wave = __builtin_amdgcn_readfirstlane(F.tid >> 6); convert_queue(F, (l), 2 + (l))); \
    if (33 == REPEAT_STEP) PHASE(1 + 13 * (l) + 3, convert_queue(F, (l), 2 + (l))); \
    if (31 == REPEAT_STEP) PHASE(1 + 13 * (l) + 3, if (F.bid < 96) rwkv_chunk_block(F, F.bid)); \
    if (32 == REPEAT_STEP) PHASE(1 + 13 * (l) + 3, if (F.bid >= 96) for (int it = F.bid - 96; it < 96; it += F.G - 96) retention_item(F, it)); \
    PHASE_R(1 + 13 * (l) + 4, 4, phase_rwkv_post(F, (l))); \
    PHASE(1 + 13 * (l) + 5, TaskOut t; t.A = (const char*)(F.ws + WS_H); t.Bt = (const char*)(F.ws + WS_WOUTT) + (size_t)(l) * 1024 * 1024 * 2; t.xf = (l) == 0 ? F.p->x : nullptr; t.xb = (bf16_t*)(F.ws + WS_XB); t.gate = MODP + (size_t)(l) * 16 * 6144 + 2048; t.G = F.G; t.c = F.bid; pg8::gemm_run(F.lds, t)); \
    PHASE(1 + 13 * (l) + 6, phase_norm2_router(F, (l), true)); \
    if (6 == REPEAT_STEP) PHASE(1 + 13 * (l) + 6, phase_norm2_router(F, (l), false)); \
    PHASE_R(1 + 13 * (l) + 7, 7, phase_route(F, (l))); \
    PHASE_R(1 + 13 * (l) + 8, 8, run_gu(F, 0)); \
    PHASE_R(1 + 13 * (l) + 9, 9, run_down(F, 0)); \
    PHASE(1 + 13 * (l) + 10, phase_combine(F, (l), 0); run_gu(F, 1)); \
    PHASE_R(1 + 13 * (l) + 11, 11, run_down(F, 1)); \
    PHASE(1 + 13 * (l) + 12, phase_combine(F, (l), 1));
    PHASE(0, phase_init(F));
    LAYER(0)
    LAYER(1)
}

extern "C" void kernel_launch(void* const* d_in, const int* in_sizes, int n_in, void* d_out, int out_size, void* d_ws, size_t ws_size, hipStream_t stream) {
    static int grid = 0;
    if (grid == 0) {
        if (n_in != 30 || out_size != NTOK * D || ws_size < WS_END) { fprintf(stderr, "kernel_launch: unexpected sizes: n_in %d out %d ws %zu (need %zu)\n", n_in, out_size, ws_size, (size_t)WS_END); grid = -1; return; }
        int dev = 0, cus = 0;
        if (hipGetDevice(&dev) != hipSuccess || hipDeviceGetAttribute(&cus, hipDeviceAttributeMultiprocessorCount, dev) != hipSuccess) { grid = -1; return; }
        if (hipFuncSetAttribute((const void*)mega, hipFuncAttributeMaxDynamicSharedMemorySize, LDS_BYTES) != hipSuccess) { fprintf(stderr, "kernel_launch: hipFuncSetAttribute failed\n"); grid = -1; return; }
        int per_cu = 0; (void)hipOccupancyMaxActiveBlocksPerMultiprocessor(&per_cu, (const void*)mega, NTHREADS, LDS_BYTES); (void)hipGetLastError();
        grid = cus;
        if (per_cu < 1) fprintf(stderr, "kernel_launch: occupancy query says %d blocks per CU\n", per_cu);
    }
    if (grid < 0) return;
    (void)hipMemsetAsync((char*)d_ws + WS_CTL, 0, CTL_BYTES, stream);
    Params p{};
    const float** f = (const float**)&p;
    for (int i = 0; i < 30; ++i) f[i] = (const float*)d_in[i];
    p.out = (float*)d_out; p.ws = (unsigned char*)d_ws;
#if N_LAUNCH_MODE == 0
    p.ph_lo = 0; p.ph_hi = LAST_PHASE + 1;
    hipLaunchKernelGGL(mega, dim3(grid), dim3(NTHREADS), LDS_BYTES, stream, p);
#else
    for (int ph = 0; ph <= LAST_PHASE; ++ph) { p.ph_lo = ph; p.ph_hi = ph + 1; hipLaunchKernelGGL(mega, dim3(grid), dim3(NTHREADS), LDS_BYTES, stream, p); }
#endif
}
```

```cpp
#include <hip/hip_runtime.h>
#include <cstdio>
#include <cstdint>

#ifndef N_LAUNCH_MODE
#define N_LAUNCH_MODE 0
#endif
#ifndef LAST_PHASE
#define LAST_PHASE 26
#endif
#ifndef STEP_MASK
#define STEP_MASK 0xFFFF
#endif
#define STEP_ON(s) ((STEP_MASK >> (s)) & 1)
#ifndef REPEAT_STEP
#define REPEAT_STEP -1
#endif

#define LAS __attribute__((address_space(3)))
typedef unsigned short bf16_t;
typedef short bf16x8 __attribute__((ext_vector_type(8)));
typedef float f32x4 __attribute__((ext_vector_type(4)));
typedef float f32x2 __attribute__((ext_vector_type(2)));
typedef unsigned u32x4 __attribute__((ext_vector_type(4)));
typedef unsigned u32x2 __attribute__((ext_vector_type(2)));
typedef __attribute__((address_space(1))) unsigned char* GPTR;

constexpr int D = 1024, NB = 16, SEQ = 2048, NTOK = NB * SEQ, NL = 2;
constexpr int RH = 6, RW = 384, RCOLS = 1408, INC = 3200, INP = 3328;
constexpr int RET_OFF = 1408, POOL_OFF = 2944;
constexpr int NE = 64, HT = 16384, PMAXH = 576 * 256, ACT_ROWS = PMAXH + 2 * HT;
constexpr int NTHREADS = 512;
constexpr int LDS_BYTES = 163840;
constexpr int MISC_OFF = LDS_BYTES - 1024;
constexpr int TILEE_OFF = LDS_BYTES - 4096;

constexpr size_t al256(size_t x) { return (x + 255) & ~(size_t)255; }
constexpr size_t WS_CTL = 0, CTL_BYTES = 65536;
constexpr size_t CTL_TOTALS = 16384;
constexpr size_t WS_MOD = WS_CTL + CTL_BYTES;
constexpr size_t WS_ROPE = WS_MOD + al256((size_t)NL * 16 * 6144 * 4);
constexpr size_t WS_WINT = WS_ROPE + (size_t)2 * 2048 * 32 * 4;
constexpr size_t WS_WOUTT = WS_WINT + (size_t)NL * INP * 1024 * 2;
constexpr size_t WS_WUPT = WS_WOUTT + (size_t)NL * 1024 * 1024 * 2;
constexpr size_t WS_AUPT = WS_WUPT + (size_t)NL * 384 * 64 * 2;
constexpr size_t WS_GUPT = WS_AUPT + (size_t)NL * 384 * 64 * 2;
constexpr size_t WS_POOLWT = WS_GUPT + (size_t)NL * 384 * 128 * 2;
constexpr size_t WS_WRT = WS_POOLWT + (size_t)NL * 4 * 64 * 64 * 2;
constexpr size_t WS_TOPI = WS_WRT + (size_t)NL * 2 * 64 * 1024 * 2;
constexpr size_t WS_TOPW = WS_TOPI + (size_t)NTOK * 8 * 4;
constexpr size_t WS_TILECNT = WS_TOPW + (size_t)NTOK * 8 * 4;
constexpr size_t WS_ROWTOK = WS_TILECNT + (size_t)1024 * 64 * 4;
constexpr size_t WS_ROWW = WS_ROWTOK + (size_t)2 * PMAXH * 4;
constexpr size_t WS_ROWDST = WS_ROWW + (size_t)2 * PMAXH * 4;
constexpr size_t WS_PADEND = WS_ROWDST + (size_t)2 * PMAXH * 4;
constexpr size_t WS_TILEE = WS_PADEND + 1024;
constexpr size_t WS_H = WS_TILEE + 2 * 576 * 4 + 512;
constexpr size_t WS_XB = WS_H + al256((size_t)(NTOK + 1) * 1024 * 2);
constexpr size_t WS_BIG = WS_XB + (size_t)NTOK * 1024 * 2;
constexpr size_t WS_P = WS_BIG;
constexpr size_t WS_SW = WS_P + (size_t)NTOK * INP;
constexpr size_t SARR = (size_t)NTOK * RW * 2;
constexpr size_t WS_SX = WS_SW + (size_t)NTOK * RW * 4;
constexpr size_t WS_YS = WS_SX + 5 * SARR;
constexpr size_t WS_G = WS_YS + (size_t)NTOK * RW * 4;
constexpr size_t WS_BON = WS_G + SARR;
constexpr size_t WS_END_MIX = WS_BON + (size_t)96 * SEQ * 4;
constexpr size_t WS_ACT = WS_BIG;
constexpr size_t WS_YB = WS_ACT + (size_t)ACT_ROWS * 256 * 2;
constexpr size_t WS_H8 = WS_YB + (size_t)HT * 9 * 1024;
constexpr size_t WS_END_MOE = WS_H8 + al256((size_t)(NTOK + 1) * 1024);
constexpr size_t WS_WGU = al256(WS_END_MIX > WS_END_MOE ? WS_END_MIX : WS_END_MOE);
constexpr size_t WS_WD = WS_WGU + (size_t)65 * 512 * 1024 * 2;
constexpr size_t WS_END = WS_WD + (size_t)65 * 1024 * 256 * 2;
constexpr size_t CTL_QUEUE = 32768;

struct Params {
    const float* x; const float* c; const float* norm1_g; const float* norm2_g; const float* w_ada; const float* b_ada; const float* w_in; const float* w_out;
    const float* rwkv_mu; const float* rwkv_w_up; const float* rwkv_w0; const float* rwkv_a_up; const float* rwkv_a0; const float* rwkv_g_up; const float* rwkv_k_k; const float* rwkv_k_a;
    const float* rwkv_r_k; const float* rwkv_lnx_w; const float* rwkv_lnx_b; const float* pool_w; const float* pool_scale; const float* w_router; const float* router_bias;
    const float* we_gate; const float* we_up; const float* we_down; const float* ws_gate; const float* ws_up; const float* ws_down; const float* final_g;
    float* out; unsigned char* ws;
    int ph_lo, ph_hi;
};

__device__ __forceinline__ float bf2f(unsigned b) { return __uint_as_float(b << 16); }
__device__ __forceinline__ unsigned f2bf(float f) { unsigned u = __float_as_uint(f); u += 0x7FFFu + ((u >> 16) & 1u); return u >> 16; }
typedef __bf16 bf16x2_t __attribute__((ext_vector_type(2)));
__device__ __forceinline__ unsigned cvt_pk_bf16(float lo, float hi) { const bf16x2_t v = {(__bf16)lo, (__bf16)hi}; return __builtin_bit_cast(unsigned, v); }
__device__ __forceinline__ unsigned pack2(float lo, float hi) { return cvt_pk_bf16(lo, hi); }
__device__ __forceinline__ float sigmoidf_(float x) { return __builtin_amdgcn_rcpf(1.0f + __expf(-x)); }
__device__ __forceinline__ float tanhf_(float x) { const float e = __expf(2.0f * x); return 1.0f - 2.0f * __builtin_amdgcn_rcpf(e + 1.0f); }
template <int N> __device__ __forceinline__ float dpp_ror(float x) { return __builtin_bit_cast(float, __builtin_amdgcn_update_dpp(0, __builtin_bit_cast(int, x), 0x120 + N, 0xf, 0xf, false)); }
__device__ __forceinline__ float row16_sum(float x) { x += dpp_ror<8>(x); x += dpp_ror<4>(x); x += dpp_ror<2>(x); x += dpp_ror<1>(x); return x; }
template <int CTRL> __device__ __forceinline__ float dpp_mov(float x) { return __builtin_bit_cast(float, __builtin_amdgcn_update_dpp(0, __builtin_bit_cast(int, x), CTRL, 0xf, 0xf, false)); }
__device__ __forceinline__ float gmax8(float x) { x = fmaxf(x, dpp_mov<0xB1>(x)); x = fmaxf(x, dpp_mov<0x4E>(x)); x = fmaxf(x, dpp_mov<0x141>(x)); return x; }
__device__ __forceinline__ float shx(float v, int m, int lane) { return __builtin_bit_cast(float, __builtin_amdgcn_ds_bpermute((lane ^ m) << 2, __builtin_bit_cast(int, v))); }
__device__ __forceinline__ float wave_sum(float v, int lane) { v = row16_sum(v); v += shx(v, 16, lane); v += shx(v, 32, lane); return v; }
__device__ __forceinline__ unsigned ld_u32_agent(const unsigned* p) { return __hip_atomic_load(p, __ATOMIC_RELAXED, __HIP_MEMORY_SCOPE_AGENT); }
__device__ __forceinline__ void unpack8(const u32x4 v, float (&f)[8]) {
    f[0] = bf2f(v.x & 0xffffu); f[1] = __uint_as_float(v.x & 0xffff0000u); f[2] = bf2f(v.y & 0xffffu); f[3] = __uint_as_float(v.y & 0xffff0000u);
    f[4] = bf2f(v.z & 0xffffu); f[5] = __uint_as_float(v.z & 0xffff0000u); f[6] = bf2f(v.w & 0xffffu); f[7] = __uint_as_float(v.w & 0xffff0000u);
}
__device__ __forceinline__ u32x4 pack8(const float (&f)[8]) { u32x4 w; w.x = pack2(f[0], f[1]); w.y = pack2(f[2], f[3]); w.z = pack2(f[4], f[5]); w.w = pack2(f[6], f[7]); return w; }

__device__ __forceinline__ int opaque_tid() { int t = threadIdx.x; asm volatile("" : "+v"(t)); return t; }
typedef float f32x2v_ __attribute__((ext_vector_type(2)));
__device__ __forceinline__ void unpack4f8(unsigned v, float* f, float sc) { const f32x2v_ lo = __builtin_amdgcn_cvt_pk_f32_fp8((int)v, false), hi = __builtin_amdgcn_cvt_pk_f32_fp8((int)v, true); f[0] = lo.x * sc; f[1] = lo.y * sc; f[2] = hi.x * sc; f[3] = hi.y * sc; }
__device__ __forceinline__ void unpack8f8(const u32x2 v, float (&f)[8], float sc) { unpack4f8(v.x, f, sc); unpack4f8(v.y, f + 4, sc); }
__device__ __forceinline__ void unpack16f8(const u32x4 v, float (&f)[16], float sc) { unpack4f8(v.x, f, sc); unpack4f8(v.y, f + 4, sc); unpack4f8(v.z, f + 8, sc); unpack4f8(v.w, f + 12, sc); }
__device__ __forceinline__ float clamp8(float x) { return __builtin_amdgcn_fmed3f(x, -448.0f, 448.0f); }
__device__ __forceinline__ unsigned pack4f8(float a, float b, float c, float d) { int w = 0; w = __builtin_amdgcn_cvt_pk_fp8_f32(a, b, w, false); w = __builtin_amdgcn_cvt_pk_fp8_f32(c, d, w, true); return (unsigned)w; }
constexpr float H8S = 16.0f, WG8S = 512.0f, GUINV = 1.0f / (H8S * WG8S);
constexpr float ACT8S = 16.0f, WD8S = 256.0f, DNSC = 64.0f / (ACT8S * WD8S);
constexpr float PSCALE = 16.0f, PINV = 1.0f / 16.0f;
#define XB_TMO      128
#define XB_XCNT(j)  (256  + 64 * (j))
#define XB_XSUB(j)  (1280 + 64 * (j))
#define XB_XGEN(j)  (2304 + 64 * (j))
#define XB_TOP      3328
#define XB_TOPGEN   3392
#define XCD_BAR_WORDS 3456
#define XB_SPIN_CAP (1u << 24)
__device__ __forceinline__ unsigned xb_ld(unsigned* p)              { return __hip_atomic_load(p, __ATOMIC_RELAXED, __HIP_MEMORY_SCOPE_AGENT); }
__device__ __forceinline__ unsigned xb_add(unsigned* p, unsigned v) { return __hip_atomic_fetch_add(p, v, __ATOMIC_RELAXED, __HIP_MEMORY_SCOPE_AGENT); }
__device__ __forceinline__ unsigned xb_xcc_id() { return (unsigned)__builtin_amdgcn_s_getreg((3 << 11) | 20) & 0xFu; }
#define XB_SPIN(cond, bar) do { unsigned _sp = 0; while (cond) { __builtin_amdgcn_s_sleep(1); \
    if ((++_sp & 255u) == 0u) { if (xb_ld(&(bar)[XB_TMO])) break; if (_sp > XB_SPIN_CAP) { atomicAdd(&(bar)[XB_TMO], 1u); break; } } } } while (0)
struct XcdBarrier { unsigned* bar; unsigned x; volatile LAS unsigned* st; };
__device__ __forceinline__ XcdBarrier xcd_barrier_post(unsigned* bar, volatile LAS unsigned* st) {
    XcdBarrier b; b.bar = bar; b.x = xb_xcc_id(); b.st = st;
    if (threadIdx.x == 0) (void)xb_add(&bar[XB_XCNT(b.x)], 1u);
    return b;
}
__device__ __forceinline__ void xcd_barrier_complete(unsigned* bar, unsigned x, unsigned& nloc, unsigned& nx) {
    const unsigned G = gridDim.x * gridDim.y * gridDim.z;
    unsigned sum, cnt, mine, sp = 0u;
    for (;;) {
        sum = 0u; cnt = 0u; mine = 0u;
#pragma unroll
        for (unsigned j = 0; j < 16; ++j) { const unsigned c = xb_ld(&bar[XB_XCNT(j)]); sum += c; cnt += (c > 0u) ? 1u : 0u; mine = (j == x) ? c : mine; }
        if (sum == G) break;
        __builtin_amdgcn_s_sleep(1);
        if ((++sp & 255u) == 0u) { if (xb_ld(&bar[XB_TMO])) break; if (sp > XB_SPIN_CAP) { atomicAdd(&bar[XB_TMO], 1u); break; } }
    }
    nloc = mine > 0u ? mine : 1u; nx = cnt > 0u ? cnt : 1u;
}
__device__ __forceinline__ void xcd_barrier(const XcdBarrier& b) {
    asm volatile("s_waitcnt vmcnt(0)" ::: "memory");
    __syncthreads();
    if (threadIdx.x == 0) {
        unsigned* bar = b.bar;
        __builtin_amdgcn_s_waitcnt(0);
        unsigned nloc = b.st[0], nx = b.st[1];
        if (nloc == 0u) { xcd_barrier_complete(bar, b.x, nloc, nx); b.st[0] = nloc; b.st[1] = nx; }
        const unsigned k = b.st[2];
        const unsigned old = xb_add(&bar[XB_XSUB(b.x)], 1u);
        const unsigned gen = old / nloc;
        if (old + 1u == (gen + 1u) * nloc) {
            __builtin_amdgcn_fence(__ATOMIC_RELEASE, "agent");
            asm volatile("s_waitcnt vmcnt(0)" ::: "memory");
            const unsigned og = xb_add(&bar[XB_TOP], 1u);
            if (og + 1u == (og / nx + 1u) * nx) xb_add(&bar[XB_TOPGEN], 1u);
        }
        XB_SPIN(xb_ld(&bar[XB_TOPGEN]) == k, bar);
        __builtin_amdgcn_fence(__ATOMIC_ACQUIRE, "agent");
        asm volatile("s_waitcnt vmcnt(0)" ::: "memory");
        b.st[2] = k + 1u;
    }
    __syncthreads();
}

typedef const __attribute__((address_space(4))) Params* PP;
struct Frame {
    PP p;
    LAS unsigned char* lds;
    unsigned char* ws;
    int tid, lane, wave, G, bid;
};

typedef int i32x8 __attribute__((ext_vector_type(8)));
__device__ __forceinline__ i32x8 cat8(const bf16x8 a, const bf16x8 b) { const u32x4 x = __builtin_bit_cast(u32x4, a), y = __builtin_bit_cast(u32x4, b); return (i32x8){(int)x.x, (int)x.y, (int)x.z, (int)x.w, (int)y.x, (int)y.y, (int)y.z, (int)y.w}; }
namespace pg8 {
constexpr int BM = 256, BK = 64, HALF = 128, HTB = HALF * BK * 2, STAGE_BYTES = 8 * HTB, NXCD = 8, WGM = 8;
__device__ __forceinline__ int lds_byte(int r, int c) { const int st = (r >> 4) * 2 + (c >> 5), rr = r & 15, cc = c & 31, ob = rr * 64 + cc * 2; return st * 1024 + (ob ^ (((ob >> 9) & 1) << 5)); }
__device__ __forceinline__ void stage_rc(int b, int& R, int& C) { const int st = b / 1024, sb = b % 1024, swz = sb ^ (((sb >> 9) & 1) << 5); R = (st >> 1) * 16 + swz / 64; C = (st & 1) * 32 + (swz % 64) / 2; }
constexpr __device__ __forceinline__ int perm32(int rho) { const int n = rho >> 4, i = rho & 15; return 8 * (i >> 2) + 4 * n + (i & 3); }

__device__ __forceinline__ bool static_order(int nM, int nN, int G, int c, int i, int& pm, int& pn) {
    const int nwg = nM * nN; const long L = (long)i * G + c; if (L >= nwg) return false;
    int wgid = (int)L; { const int q = nwg / NXCD, r = nwg % NXCD, xcd = wgid % NXCD, off = wgid / NXCD; wgid = (xcd < r ? xcd * (q + 1) : r * (q + 1) + (xcd - r) * q) + off; }
    const int nig = WGM * nN, gid = wgid / nig, fm = gid * WGM, gsz = (nM - fm) < WGM ? (nM - fm) : WGM;
    pm = fm + ((wgid % nig) % gsz); pn = (wgid % nig) / gsz; return true;
}

struct Unit { int rt, ct, e, slot; };

template <class Task>
__device__ __forceinline__ void gemm_run(LAS unsigned char* lds, const Task& S) {
    constexpr int KB = Task::KBYTES, nt = KB / (BK * 2);
    constexpr bool F8 = Task::FP8;
    constexpr bool QT = Task::QUARTER;
    constexpr int NN = QT ? 1 : 2;
    const int tid = opaque_tid(), wid = __builtin_amdgcn_readfirstlane(tid >> 6), lane = tid & 63, wr = wid >> 2, wc = wid & 3, fr = lane & 15, fq = lane >> 4;
    unsigned voffB[1][2];
    constexpr int DHB = (Task::brow(1, 0) - Task::brow(0, 0)) * KB;
#pragma unroll
    for (int i = 0; i < 2; ++i) { int R, C; stage_rc(tid * 16 + i * 8192, R, C); voffB[0][i] = (unsigned)(Task::brow(0, R) * KB + C * 2); }
    constexpr unsigned kstep = (unsigned)(BK * 2);
        const unsigned ldsw = (unsigned)wid * 1024u;
    const int aoff = lds_byte(wr * 64 + fr, fq * 8), boff = lds_byte(wc * 32 + fr, fq * 8);
#define PG8_SA(b, h) (((b) * 2 + (h)) * HTB)
#define PG8_SB(b, h) ((4 + (b) * 2 + (h)) * HTB)
#define PG8_STAGE(bufoff, rs, soff, voff) do { _Pragma("unroll") for (int _i = 0; _i < 2; ++_i) \
        __builtin_amdgcn_raw_ptr_buffer_load_lds(rs, (LAS void*)(lds + (bufoff) + ldsw + _i * 8192), 16, (int)(voff)[_i], (int)(soff), 0, 0); } while (0)
#define PG8_LDA(dst, b, h) do { if (!(QT && (h) == 1)) _Pragma("unroll") for (int m = 0; m < 4; ++m) { if (F8) dst##8[m] = cat8(*(const LAS bf16x8*)(lds + PG8_SA(b, h) + aoff + m * 2048), *(const LAS bf16x8*)(lds + PG8_SA(b, h) + aoff + m * 2048 + 1024)); \
        else { _Pragma("unroll") for (int k = 0; k < 2; ++k) dst[m][k] = *(const LAS bf16x8*)(lds + PG8_SA(b, h) + aoff + m * 2048 + k * 1024); } } } while (0)
#define PG8_LDB(dst, b, h) do { _Pragma("unroll") for (int n = 0; n < NN; ++n) { if (F8) dst##8[n] = cat8(*(const LAS bf16x8*)(lds + PG8_SB(b, h) + boff + n * 2048), *(const LAS bf16x8*)(lds + PG8_SB(b, h) + boff + n * 2048 + 1024)); \
        else { _Pragma("unroll") for (int k = 0; k < 2; ++k) dst[n][k] = *(const LAS bf16x8*)(lds + PG8_SB(b, h) + boff + n * 2048 + k * 1024); } } } while (0)
#define PG8_MMA(ai, bj, At, Bt) do { if (!(QT && (ai) == 1)) { __builtin_amdgcn_s_setprio(1); _Pragma("unroll") for (int m = 0; m < 4; ++m) _Pragma("unroll") for (int n = 0; n < NN; ++n) { \
        if (F8) { acc[ai][bj][m][n] = __builtin_amdgcn_mfma_scale_f32_16x16x128_f8f6f4(Bt##8[n], At##8[m], acc[ai][bj][m][n], 0, 0, 0, 0x7F7F7F7F, 0, 0x7F7F7F7F); } \
        else { _Pragma("unroll") for (int k = 0; k < 2; ++k) acc[ai][bj][m][n] = __builtin_amdgcn_mfma_f32_16x16x32_bf16(Bt[n][k], At[m][k], acc[ai][bj][m][n], 0, 0, 0); } } \
        __builtin_amdgcn_s_setprio(0); } } while (0)
#define PG8_WAIT_V(n) asm volatile("s_waitcnt vmcnt(" #n ")" ::: "memory")
#define PG8_WAIT_L(n) asm volatile("s_waitcnt lgkmcnt(" #n ")" ::: "memory")
#define PG8_BAR __builtin_amdgcn_s_barrier()
#define LDS_BAR() do { asm volatile("s_waitcnt lgkmcnt(0)" ::: "memory"); __builtin_amdgcn_s_barrier(); asm volatile("" ::: "memory"); } while (0)
#define PG8_SCHED __builtin_amdgcn_sched_barrier(0)
    Unit cur, nxt; int ui = 0;
    if (!S.unit(0, cur)) return;
    f32x4 acc[2][2][4][2];
#pragma unroll
    for (int a = 0; a < 2; ++a)
#pragma unroll
        for (int b = 0; b < 2; ++b)
#pragma unroll
            for (int m = 0; m < 4; ++m)
#pragma unroll
                for (int n = 0; n < 2; ++n) acc[a][b][m][n] = (f32x4){0.f, 0.f, 0.f, 0.f};
    bf16x8 At[4][2], B0[2][2], B1[2][2]; i32x8 At8[4], B08[2], B18[2];
    const __amdgpu_buffer_rsrc_t rsA = __builtin_amdgcn_make_buffer_rsrc((void*)S.abase(), 0, 0xFFFFFFFF, 0x00020000), rsB = __builtin_amdgcn_make_buffer_rsrc((void*)S.bbase(), 0, 0xFFFFFFFF, 0x00020000);
    unsigned co[2][2];
    S.aoffs(cur, co);
    unsigned cB = (unsigned)(S.bptr(cur) - S.bbase());
    PG8_STAGE(PG8_SB(0, 0), rsB, cB, voffB[0]); PG8_STAGE(PG8_SB(0, 1), rsB, cB + DHB, voffB[0]); PG8_STAGE(PG8_SA(0, 0), rsA, 0u, co[0]); PG8_STAGE(PG8_SA(0, 1), rsA, 0u, co[1]);
    if (wr == 1) PG8_BAR;
    PG8_WAIT_V(2); PG8_BAR;
    PG8_STAGE(PG8_SB(1, 0), rsB, cB + kstep, voffB[0]); PG8_STAGE(PG8_SA(1, 0), rsA, kstep, co[0]); PG8_STAGE(PG8_SB(1, 1), rsB, cB + kstep + DHB, voffB[0]);
    PG8_WAIT_V(6); PG8_BAR;
#pragma unroll 1
    for (;;) {
        const bool has_next = S.unit(ui + 1, nxt);
        unsigned nB = cB;
        if (has_next) nB = (unsigned)(S.bptr(nxt) - S.bbase());
#pragma unroll 1
        for (int t = 0; t < nt; t += 2) {
            const bool last = (t == nt - 2);
            const unsigned a1 = (unsigned)(t + 1) * kstep;
            const unsigned a2 = last ? 0u : (unsigned)(t + 2) * kstep, b2 = last ? nB : cB + (unsigned)(t + 2) * kstep;
            const unsigned a3 = a2 + kstep, b3 = b2 + kstep;
            PG8_LDB(B0, 0, 0); PG8_LDB(B1, 0, 1); PG8_SCHED; PG8_LDA(At, 0, 0); PG8_STAGE(PG8_SA(1, 1), rsA, a1, co[1]);
            PG8_WAIT_V(8); PG8_WAIT_L(0); PG8_BAR; PG8_MMA(0, 0, At, B0); PG8_MMA(0, 1, At, B1); PG8_BAR; PG8_SCHED;
            if (last && has_next) S.aoffs(nxt, co);
            PG8_LDA(At, 0, 1); PG8_STAGE(PG8_SB(0, 0), rsB, b2, voffB[0]); PG8_STAGE(PG8_SB(0, 1), rsB, b2 + DHB, voffB[0]); PG8_STAGE(PG8_SA(0, 0), rsA, a2, co[0]);
            PG8_WAIT_V(8); PG8_WAIT_L(0); PG8_BAR; PG8_MMA(1, 0, At, B0); PG8_MMA(1, 1, At, B1); PG8_BAR; PG8_SCHED;
            PG8_LDB(B0, 1, 0); PG8_LDB(B1, 1, 1); PG8_SCHED; PG8_LDA(At, 1, 0); PG8_STAGE(PG8_SA(0, 1), rsA, a2, co[1]);
            PG8_WAIT_V(8); PG8_WAIT_L(0); PG8_BAR; PG8_MMA(0, 0, At, B0); PG8_MMA(0, 1, At, B1); PG8_BAR; PG8_SCHED;
            PG8_LDA(At, 1, 1); PG8_STAGE(PG8_SB(1, 0), rsB, b3, voffB[0]); PG8_STAGE(PG8_SB(1, 1), rsB, b3 + DHB, voffB[0]); PG8_STAGE(PG8_SA(1, 0), rsA, a3, co[0]);
            PG8_WAIT_V(8); PG8_WAIT_L(0); PG8_BAR; PG8_MMA(1, 0, At, B0); PG8_MMA(1, 1, At, B1); PG8_BAR; PG8_SCHED;
        }
        if (wr == 0) PG8_BAR;
        S.epi(acc, cur, wr, wc, fr, fq);
        if (!has_next) break;
#pragma unroll
        for (int a = 0; a < 2; ++a)
#pragma unroll
            for (int b = 0; b < 2; ++b)
#pragma unroll
                for (int m = 0; m < 4; ++m)
#pragma unroll
                    for (int n = 0; n < 2; ++n) acc[a][b][m][n] = (f32x4){0.f, 0.f, 0.f, 0.f};
        cur = nxt; cB = nB; ++ui;
        if (wr == 1) PG8_BAR;
    }
    PG8_WAIT_V(0);
    PG8_BAR;
#undef PG8_SA
#undef PG8_SB
#undef PG8_STAGE
#undef PG8_LDA
#undef PG8_LDB
#undef PG8_MMA
#undef PG8_WAIT_V
#undef PG8_WAIT_L
#undef PG8_BAR
#undef PG8_SCHED
}
}
using pg8::Unit;


__device__ __forceinline__ u32x4 ror8_u32x4(u32x4 v) { u32x4 r;
    r.x = (unsigned)__builtin_amdgcn_update_dpp(0, (int)v.x, 0x128, 0xf, 0xf, false); r.y = (unsigned)__builtin_amdgcn_update_dpp(0, (int)v.y, 0x128, 0xf, 0xf, false);
    r.z = (unsigned)__builtin_amdgcn_update_dpp(0, (int)v.z, 0x128, 0xf, 0xf, false); r.w = (unsigned)__builtin_amdgcn_update_dpp(0, (int)v.w, 0x128, 0xf, 0xf, false); return r; }
__device__ __forceinline__ void store_rows_full(bf16_t* pa, bf16_t* pb, u32x4 w0, u32x4 w1, int fr, int fq) {
    const bool lo = fr < 8;
    const u32x4 send = lo ? w1 : w0, recv = ror8_u32x4(send);
    const u32x4 s1 = lo ? w0 : recv;
    const u32x4 s2 = lo ? recv : w1;
    const int co = (lo ? 0 : 32) + 8 * fq;
    if (pa) *(u32x4*)(pa + co) = s1;
    if (pb) *(u32x4*)(pb + co) = s2;
}

struct TaskIn {
    static constexpr int K = 1024, KBYTES = 1024 * 2; static constexpr bool PERM = true, FP8 = false, QUARTER = false;
    static constexpr __device__ __forceinline__ int brow(int h, int R) { return (R >> 5) * 64 + 16 * ((R & 15) >> 2) + 8 * h + 4 * ((R >> 4) & 1) + (R & 3); }
    const char* A; const char* Bt; unsigned char* O; int G, c;
    __device__ __forceinline__ bool unit(int i, Unit& u) const { u.e = 0; u.slot = i; return pg8::static_order(NTOK / 256, 12, G, c, i, u.rt, u.ct); }
    __device__ __forceinline__ const char* abase() const { return A; }
    __device__ __forceinline__ void aoffs(const Unit& u, unsigned (&o)[2][2]) const {
        int R[2], C[2];
        { const int t_ = opaque_tid();
#pragma unroll
        for (int i = 0; i < 2; ++i) pg8::stage_rc(t_ * 16 + i * 8192, R[i], C[i]); }
#pragma unroll
        for (int h = 0; h < 2; ++h)
#pragma unroll
            for (int i = 0; i < 2; ++i) o[h][i] = (unsigned)((u.rt * 256 + h * 128 + R[i]) * K + C[i]) * 2u;
    }
    __device__ __forceinline__ const char* bbase() const { return Bt; }
    __device__ __forceinline__ const char* bptr(const Unit& u) const { return Bt + (size_t)u.ct * 256 * K * 2; }
    __device__ __forceinline__ void epi(const f32x4 (&acc)[2][2][4][2], const Unit& u, int wr, int wc, int fr, int fq) const {
        const int row0 = u.rt * 256 + wr * 64 + fr, col0 = u.ct * 256 + wc * 64 + 16 * fq;
#pragma unroll
        for (int ai = 0; ai < 2; ++ai)
#pragma unroll
            for (int m = 0; m < 4; ++m) {
                f32x4 a0 = acc[ai][0][m][0] * PSCALE, a1 = acc[ai][0][m][1] * PSCALE, b0 = acc[ai][1][m][0] * PSCALE, b1 = acc[ai][1][m][1] * PSCALE;
#pragma unroll
                for (int j = 0; j < 4; ++j) { a0[j] = clamp8(a0[j]); a1[j] = clamp8(a1[j]); b0[j] = clamp8(b0[j]); b1[j] = clamp8(b1[j]); }
                u32x4 w; w.x = pack4f8(a0[0], a0[1], a0[2], a0[3]); w.y = pack4f8(a1[0], a1[1], a1[2], a1[3]); w.z = pack4f8(b0[0], b0[1], b0[2], b0[3]); w.w = pack4f8(b1[0], b1[1], b1[2], b1[3]);
                *(u32x4*)(O + (size_t)(row0 + ai * 128 + m * 16) * INP + col0) = w;
            }
    }
};

struct TaskInTail {
    static constexpr int K = 1024, KBYTES = 1024 * 2; static constexpr bool PERM = false, FP8 = false, QUARTER = true;
    static constexpr __device__ __forceinline__ int brow(int h, int R) { return 3072 + h * 64 + (R >> 5) * 16 + (R & 15); }
    const char* A; const char* Bt; unsigned char* O; int G, c;
    __device__ __forceinline__ bool unit(int i, Unit& u) const { const int q = c + i * G; u.e = 0; u.slot = i; u.rt = q >> 1; u.ct = q & 1; return q < 2 * (NTOK / 256); }
    __device__ __forceinline__ const char* abase() const { return A; }
    __device__ __forceinline__ void aoffs(const Unit& u, unsigned (&o)[2][2]) const {
        int R[2], C[2];
        { const int t_ = opaque_tid();
#pragma unroll
        for (int i = 0; i < 2; ++i) pg8::stage_rc(t_ * 16 + i * 8192, R[i], C[i]); }
#pragma unroll
        for (int h = 0; h < 2; ++h)
#pragma unroll
            for (int i = 0; i < 2; ++i) o[h][i] = (unsigned)((u.rt * 256 + u.ct * 128 + R[i]) * K + C[i]) * 2u;
    }
    __device__ __forceinline__ const char* bbase() const { return Bt; }
    __device__ __forceinline__ const char* bptr(const Unit& u) const { (void)u; return Bt; }
    __device__ __forceinline__ void epi(const f32x4 (&acc)[2][2][4][2], const Unit& u, int wr, int wc, int fr, int fq) const {
        const int row0 = u.rt * 256 + u.ct * 128 + wr * 64 + fr;
#pragma unroll
        for (int m = 0; m < 4; ++m)
#pragma unroll
            for (int bj = 0; bj < 2; ++bj) {
                const f32x4 a = acc[0][bj][m][0] * PSCALE;
                *(unsigned*)(O + (size_t)(row0 + m * 16) * INP + 3072 + bj * 64 + wc * 16 + fq * 4) = pack4f8(clamp8(a[0]), clamp8(a[1]), clamp8(a[2]), clamp8(a[3]));
            }
    }
};

struct TaskOut {
    static constexpr int K = 1024, KBYTES = 1024 * 2; static constexpr bool PERM = true, FP8 = false, QUARTER = false;
    static constexpr __device__ __forceinline__ int brow(int h, int R) { return (R >> 5) * 64 + h * 32 + pg8::perm32(R & 31); }
    const char* A; const char* Bt; const float* xf; bf16_t* xb; const float* gate;
    int G, c;
    __device__ __forceinline__ bool unit(int i, Unit& u) const { u.e = 0; u.slot = i; return pg8::static_order(NTOK / 256, D / 256, G, c, i, u.rt, u.ct); }
    __device__ __forceinline__ const char* abase() const { return A; }
    __device__ __forceinline__ void aoffs(const Unit& u, unsigned (&o)[2][2]) const {
        int R[2], C[2];
        { const int t_ = opaque_tid();
#pragma unroll
        for (int i = 0; i < 2; ++i) pg8::stage_rc(t_ * 16 + i * 8192, R[i], C[i]); }
#pragma unroll
        for (int h = 0; h < 2; ++h)
#pragma unroll
            for (int i = 0; i < 2; ++i) o[h][i] = (unsigned)((u.rt * 256 + h * 128 + R[i]) * K + C[i]) * 2u;
    }
    __device__ __forceinline__ const char* bbase() const { return Bt; }
    __device__ __forceinline__ const char* bptr(const Unit& u) const { return Bt + (size_t)u.ct * 256 * K * 2; }
    __device__ __forceinline__ void epi(const f32x4 (&acc)[2][2][4][2], const Unit& u, int wr, int wc, int fr, int fq) const {
        const int rowg = u.rt * 256 + wr * 64, colw = u.ct * 256 + wc * 64, b = (u.rt * 256) / SEQ;
        f32x4 gv[2][2];
#pragma unroll
        for (int bj = 0; bj < 2; ++bj)
#pragma unroll
            for (int n = 0; n < 2; ++n) gv[bj][n] = *(const f32x4*)(gate + (size_t)b * 6144 + colw + bj * 32 + 8 * fq + 4 * n);
#pragma unroll
        for (int ai = 0; ai < 2; ++ai)
#pragma unroll
            for (int m = 0; m < 4; ++m) {
                const size_t ro = (size_t)(rowg + ai * 128 + m * 16 + fr) * D + colw + 8 * fq;
                u32x4 w[2];
#pragma unroll
                for (int bj = 0; bj < 2; ++bj) {
                    float xv[8];
                    if (xf) { const f32x4 x0 = *(const f32x4*)(xf + ro + bj * 32), x1 = *(const f32x4*)(xf + ro + bj * 32 + 4);
#pragma unroll
                        for (int j = 0; j < 4; ++j) { xv[j] = x0[j]; xv[4 + j] = x1[j]; } }
                    else unpack8(*(const u32x4*)(xb + ro + bj * 32), xv);
                    float o[8];
#pragma unroll
                    for (int n = 0; n < 2; ++n)
#pragma unroll
                        for (int j = 0; j < 4; ++j) o[n * 4 + j] = xv[n * 4 + j] + gv[bj][n][j] * acc[ai][bj][m][n][j];
                    w[bj] = pack8(o);
                }
                bf16_t* pa = xb + (size_t)(rowg + ai * 128 + m * 16 + (fr & 7)) * D + colw;
                store_rows_full(pa, pa + (size_t)8 * D, w[0], w[1], fr, fq);
                asm volatile("" ::: "memory");
            }
    }
};

struct TaskGU {
    static constexpr int K = 1024, KBYTES = 1024; static constexpr bool PERM = true, FP8 = true, QUARTER = false;
    static constexpr __device__ __forceinline__ int brow(int h, int R) { return h * 128 + (R & ~31) + pg8::perm32(R & 31); }
    const char* A;
    const char* W;
    const LAS int* ltok; const LAS float* lw; unsigned char* act; const LAS int* tilee;
    int hf, ntr, G, c;
    __device__ __forceinline__ bool unit(int i, Unit& u) const {
        const int uu = c + i * G; if (uu >= (ntr + 64) * 2) return false;
        u.rt = uu >> 1; u.ct = uu & 1; u.slot = i;
        if (u.rt < ntr) u.e = __builtin_amdgcn_readfirstlane(tilee[u.rt]); else u.e = 64;
        return true;
    }
    __device__ __forceinline__ const char* abase() const { return A; }
    __device__ __forceinline__ void aoffs(const Unit& u, unsigned (&o)[2][2]) const {
        int R[2], C[2];
        { const int t_ = opaque_tid();
#pragma unroll
        for (int i = 0; i < 2; ++i) pg8::stage_rc(t_ * 16 + i * 8192, R[i], C[i]); }
#pragma unroll
        for (int h = 0; h < 2; ++h)
#pragma unroll
            for (int i = 0; i < 2; ++i) {
                int tok;
                if (u.e < 64) tok = ltok[u.slot * 256 + h * 128 + R[i]]; else tok = hf * HT + (u.rt - ntr) * 256 + h * 128 + R[i];
                o[h][i] = (unsigned)(tok * KBYTES + C[i] * 2);
            }
    }
    __device__ __forceinline__ const char* bbase() const { return W; }
    __device__ __forceinline__ const char* bptr(const Unit& u) const { return W + ((size_t)u.e * 512 + (size_t)u.ct * 256) * KBYTES; }
    __device__ __forceinline__ void epi(const f32x4 (&acc)[2][2][4][2], const Unit& u, int wr_, int wc_, int fr_, int fq_) const {
        const int t_ = opaque_tid(), fr = t_ & 15, fq = (t_ >> 4) & 3, wv_ = __builtin_amdgcn_readfirstlane(t_ >> 6), wr = wv_ >> 2, wc = wv_ & 3;
        (void)wr_; (void)wc_; (void)fr_; (void)fq_;
        const bool routed = u.e < 64;
        const int rin = u.rt * 256 + wr * 64 + fr;
        const int rout = routed ? rin : PMAXH + hf * HT + (u.rt - ntr) * 256 + wr * 64 + fr;
        const int col0 = u.ct * 128 + wc * 32 + 8 * fq;
#pragma unroll
        for (int ai = 0; ai < 2; ++ai)
#pragma unroll
            for (int m = 0; m < 4; ++m) {
                const float rw = routed ? lw[u.slot * 256 + wr * 64 + fr + ai * 128 + m * 16] : 1.0f;
                float o[8];
#pragma unroll
                for (int n = 0; n < 2; ++n)
#pragma unroll
                    for (int j = 0; j < 4; ++j) { const float g = acc[ai][0][m][n][j] * GUINV, up = acc[ai][1][m][n][j] * GUINV; o[n * 4 + j] = g * sigmoidf_(g) * up * rw; }
#pragma unroll
                for (int j = 0; j < 8; ++j) o[j] = __builtin_amdgcn_fmed3f(o[j] * ACT8S, -448.0f, 448.0f);
                u32x2 w; w.x = pack4f8(o[0], o[1], o[2], o[3]); w.y = pack4f8(o[4], o[5], o[6], o[7]);
                *(u32x2*)(act + (size_t)(rout + ai * 128 + m * 16) * 256 + col0) = w;
            }
    }
};

struct TaskDown {
    static constexpr int K = 256, KBYTES = 256; static constexpr bool PERM = true, FP8 = true, QUARTER = false;
    static constexpr __device__ __forceinline__ int brow(int h, int R) { return (R >> 5) * 64 + 16 * ((R & 15) >> 2) + 8 * h + 4 * ((R >> 4) & 1) + (R & 3); }
    const char* A;
    const char* W;
    const LAS int* ldst; unsigned char* yb; const LAS int* tilee;
    int hf, ntr, G, c;
    __device__ __forceinline__ bool unit(int i, Unit& u) const {
        const int uu = c + i * G; if (uu >= (ntr + 64) * 4) return false;
        u.rt = uu >> 2; u.ct = uu & 3; u.slot = i;
        if (u.rt < ntr) u.e = __builtin_amdgcn_readfirstlane(tilee[u.rt]); else u.e = 64;
        return true;
    }
    __device__ __forceinline__ const char* abase() const { return A; }
    __device__ __forceinline__ void aoffs(const Unit& u, unsigned (&o)[2][2]) const {
        int R[2], C[2];
        { const int t_ = opaque_tid();
#pragma unroll
        for (int i = 0; i < 2; ++i) pg8::stage_rc(t_ * 16 + i * 8192, R[i], C[i]); }
        const int row0 = (u.e < 64) ? u.rt * 256 : PMAXH + hf * HT + (u.rt - ntr) * 256;
#pragma unroll
        for (int h = 0; h < 2; ++h)
#pragma unroll
            for (int i = 0; i < 2; ++i) o[h][i] = (unsigned)((row0 + h * 128 + R[i]) * KBYTES + C[i] * 2);
    }
    __device__ __forceinline__ const char* bbase() const { return W; }
    __device__ __forceinline__ const char* bptr(const Unit& u) const { return W + ((size_t)u.e * 1024 + (size_t)u.ct * 256) * KBYTES; }
    __device__ __forceinline__ void epi(const f32x4 (&acc)[2][2][4][2], const Unit& u, int wr, int wc, int fr, int fq) const {
        const bool routed = u.e < 64;
        const int rin = u.rt * 256 + wr * 64 + fr, col0 = u.ct * 256 + wc * 64 + 16 * fq;
        const int sl = (u.rt - ntr) * 256 + wr * 64 + fr;
#pragma unroll
        for (int ai = 0; ai < 2; ++ai)
#pragma unroll
            for (int m = 0; m < 4; ++m) {
                const int dst = routed ? ldst[u.slot * 256 + wr * 64 + fr + ai * 128 + m * 16] : (sl + ai * 128 + m * 16) * 9 + 8;
                u32x4 w;
                { int d0 = 0, d1 = 0, d2 = 0, d3 = 0; f32x4 a0 = acc[ai][0][m][0] * DNSC, a1 = acc[ai][0][m][1] * DNSC, b0 = acc[ai][1][m][0] * DNSC, b1 = acc[ai][1][m][1] * DNSC;
#pragma unroll
                  for (int j = 0; j < 4; ++j) { a0[j] = clamp8(a0[j]); a1[j] = clamp8(a1[j]); b0[j] = clamp8(b0[j]); b1[j] = clamp8(b1[j]); }
                  d0 = __builtin_amdgcn_cvt_pk_fp8_f32(a0[0], a0[1], d0, false); d0 = __builtin_amdgcn_cvt_pk_fp8_f32(a0[2], a0[3], d0, true);
                  d1 = __builtin_amdgcn_cvt_pk_fp8_f32(a1[0], a1[1], d1, false); d1 = __builtin_amdgcn_cvt_pk_fp8_f32(a1[2], a1[3], d1, true);
                  d2 = __builtin_amdgcn_cvt_pk_fp8_f32(b0[0], b0[1], d2, false); d2 = __builtin_amdgcn_cvt_pk_fp8_f32(b0[2], b0[3], d2, true);
                  d3 = __builtin_amdgcn_cvt_pk_fp8_f32(b1[0], b1[1], d3, false); d3 = __builtin_amdgcn_cvt_pk_fp8_f32(b1[2], b1[3], d3, true);
                  w.x = (unsigned)d0; w.y = (unsigned)d1; w.z = (unsigned)d2; w.w = (unsigned)d3; }
                if (dst >= 0) *(u32x4*)(yb + (size_t)dst * 1024 + col0) = w;
                asm volatile("" ::: "memory");
            }
    }
};

__device__ __forceinline__ void tr_tile(int tid, LAS float* T, const float* src, int ld_src, bf16_t* dst, int ld_dst, bf16_t* dst_lo) {
    { const int row = tid >> 4, c4 = tid & 15;
#pragma unroll
      for (int rr = 0; rr < 64; rr += 32) { const f32x4 v = *(const f32x4*)(src + (size_t)(row + rr) * ld_src + c4 * 4);
          LAS float* t = T + (row + rr) * 65 + c4 * 4; t[0] = v[0]; t[1] = v[1]; t[2] = v[2]; t[3] = v[3]; } }
    __syncthreads();
    { const int n = tid >> 3, kq = tid & 7; float v[8];
#pragma unroll
      for (int j = 0; j < 8; ++j) v[j] = T[(kq * 8 + j) * 65 + n];
      *(u32x4*)(dst + (size_t)n * ld_dst + kq * 8) = pack8(v);
      if (dst_lo) { float lo[8];
#pragma unroll
          for (int j = 0; j < 8; ++j) lo[j] = v[j] - bf2f(f2bf(v[j]));
          *(u32x4*)(dst_lo + (size_t)n * ld_dst + kq * 8) = pack8(lo); } }
    __syncthreads();
}

__device__ __forceinline__ void tr_tile_wave(int lane, LAS float* T, const float* src, int ld_src, bf16_t* dst, int ld_dst, bf16_t* dst_lo = nullptr) {
    f32x4 v[16];
#pragma unroll
    for (int i = 0; i < 16; ++i) v[i] = *(const f32x4*)(src + (size_t)(i * 4 + (lane >> 4)) * ld_src + (lane & 15) * 4);
#pragma unroll
    for (int i = 0; i < 16; ++i) { LAS float* t = T + (i * 4 + (lane >> 4)) * 65 + (lane & 15) * 4; t[0] = v[i][0]; t[1] = v[i][1]; t[2] = v[i][2]; t[3] = v[i][3]; }
    __builtin_amdgcn_fence(__ATOMIC_RELEASE, "wavefront"); asm volatile("s_waitcnt lgkmcnt(0)" ::: "memory");
    const int kq = lane & 7;
#pragma unroll
    for (int q = 0; q < 8; ++q) { const int n = q * 8 + (lane >> 3); float o[8];
#pragma unroll
        for (int j = 0; j < 8; ++j) o[j] = T[(kq * 8 + j) * 65 + n];
        *(u32x4*)(dst + (size_t)n * ld_dst + kq * 8) = pack8(o);
        if (dst_lo) { float lo[8];
#pragma unroll
            for (int j = 0; j < 8; ++j) lo[j] = o[j] - bf2f(f2bf(o[j]));
            *(u32x4*)(dst_lo + (size_t)n * ld_dst + kq * 8) = pack8(lo); } }
    asm volatile("s_waitcnt lgkmcnt(0)" ::: "memory");
}
__device__ __forceinline__ void tr_tile_wave8(int lane, LAS float* T, const float* src, int ld_src, unsigned char* dst, int ld_dst, float sc) {
    f32x4 v[16];
#pragma unroll
    for (int i = 0; i < 16; ++i) v[i] = *(const f32x4*)(src + (size_t)(i * 4 + (lane >> 4)) * ld_src + (lane & 15) * 4);
#pragma unroll
    for (int i = 0; i < 16; ++i) { LAS float* t = T + (i * 4 + (lane >> 4)) * 65 + (lane & 15) * 4; t[0] = v[i][0]; t[1] = v[i][1]; t[2] = v[i][2]; t[3] = v[i][3]; }
    __builtin_amdgcn_fence(__ATOMIC_RELEASE, "wavefront"); asm volatile("s_waitcnt lgkmcnt(0)" ::: "memory");
    const int kq = lane & 3;
#pragma unroll
    for (int q = 0; q < 4; ++q) { const int n = q * 16 + (lane >> 2); float o[16];
#pragma unroll
        for (int j = 0; j < 16; ++j) o[j] = clamp8(T[(kq * 16 + j) * 65 + n] * sc);
        u32x4 w; w.x = pack4f8(o[0], o[1], o[2], o[3]); w.y = pack4f8(o[4], o[5], o[6], o[7]); w.z = pack4f8(o[8], o[9], o[10], o[11]); w.w = pack4f8(o[12], o[13], o[14], o[15]);
        *(u32x4*)(dst + (size_t)n * ld_dst + kq * 16) = w; }
    asm volatile("s_waitcnt lgkmcnt(0)" ::: "memory");
}

__device__ __forceinline__ void phase_init(Frame& F) {
    const PP p = F.p; const int tid = F.tid;
    LAS float* T = (LAS float*)F.lds;
    LAS float* sc = (LAS float*)(F.lds + 32768);
    LAS float* red = (LAS float*)(F.lds + 98304);
    constexpr int PER_L = 800 + 256 + 6 + 6 + 12 + 4 + 16, NTR = NL * PER_L, I_ZERO = NTR, I_MOD = I_ZERO + NL, I_ROPE = I_MOD + 192, I_ZROW = I_ROPE + 128, N_ITEMS = I_ZROW + 1;
    { LAS float* Tw = (LAS float*)(F.lds + F.wave * 16640); const int lane = F.lane;
#pragma unroll 1
      for (int it = F.bid * 8 + F.wave; it < NTR; it += F.G * 8) {
            const int l = it / PER_L; int j = it % PER_L;
            const float* src; int lds_; bf16_t* dst; int ldd_; bf16_t* dlo = nullptr;
            if (j < 800) { const int kt = j / 50, ntile = j % 50; src = p->w_in + (size_t)l * 1024 * INC + (size_t)kt * 64 * INC + ntile * 64; lds_ = INC; dst = (bf16_t*)(F.ws + WS_WINT) + (size_t)l * INP * 1024 + (size_t)ntile * 64 * 1024 + kt * 64; ldd_ = 1024; }
            else if ((j -= 800) < 256) { const int kt = j / 16, ntile = j % 16; src = p->w_out + (size_t)l * 1024 * 1024 + (size_t)kt * 64 * 1024 + ntile * 64; lds_ = 1024; dst = (bf16_t*)(F.ws + WS_WOUTT) + (size_t)l * 1024 * 1024 + (size_t)ntile * 64 * 1024 + kt * 64; ldd_ = 1024; }
            else if ((j -= 256) < 6) { src = p->rwkv_w_up + (size_t)l * 64 * 384 + j * 64; lds_ = 384; dst = (bf16_t*)(F.ws + WS_WUPT) + (size_t)l * 384 * 64 + (size_t)j * 64 * 64; ldd_ = 64; }
            else if ((j -= 6) < 6) { src = p->rwkv_a_up + (size_t)l * 64 * 384 + j * 64; lds_ = 384; dst = (bf16_t*)(F.ws + WS_AUPT) + (size_t)l * 384 * 64 + (size_t)j * 64 * 64; ldd_ = 64; }
            else if ((j -= 6) < 12) { const int kt = j / 6, ntile = j % 6; src = p->rwkv_g_up + (size_t)l * 128 * 384 + (size_t)kt * 64 * 384 + ntile * 64; lds_ = 384; dst = (bf16_t*)(F.ws + WS_GUPT) + (size_t)l * 384 * 128 + (size_t)ntile * 64 * 128 + kt * 64; ldd_ = 128; }
            else if ((j -= 12) < 4) { src = p->pool_w + ((size_t)l * 4 + j) * 64 * 64; lds_ = 64; dst = (bf16_t*)(F.ws + WS_POOLWT) + ((size_t)l * 4 + j) * 64 * 64; ldd_ = 64; }
            else { j -= 4; bf16_t* hi = (bf16_t*)(F.ws + WS_WRT) + (size_t)l * 2 * 64 * 1024; src = p->w_router + (size_t)l * 1024 * 64 + (size_t)j * 64 * 64; lds_ = 64; dst = hi + j * 64; ldd_ = 1024; dlo = hi + 64 * 1024 + j * 64; }
            tr_tile_wave(lane, Tw, src, lds_, dst, ldd_, dlo);
      } }
    __syncthreads();
    bool sc_ready = false;
    for (int it = NTR + F.bid; it < N_ITEMS; it += F.G) {
        if (it < I_MOD) {
            const int l = it - I_ZERO; u32x4* z = (u32x4*)((bf16_t*)(F.ws + WS_WINT) + (size_t)l * INP * 1024 + (size_t)INC * 1024);
            for (int i = tid; i < 128 * 1024 * 2 / 16; i += NTHREADS) z[i] = (u32x4){0u, 0u, 0u, 0u};
        } else if (it < I_ROPE) {
            if (!sc_ready) { for (int i = tid; i < 16 * 1024; i += NTHREADS) { const float v = p->c[i]; sc[i] = v / (1.0f + __expf(-v)); } sc_ready = true; __syncthreads(); }
            const int j = it - I_MOD, l = j / 96, cb = j % 96, ks = tid >> 6, cl = tid & 63, col = cb * 64 + cl;
            float acc[16];
#pragma unroll
            for (int b = 0; b < 16; ++b) acc[b] = 0.f;
            const float* wp = p->w_ada + (size_t)l * 1024 * 6144 + col;
            for (int k = ks * 128; k < ks * 128 + 128; k += 4) {
                const float w0 = wp[(size_t)k * 6144], w1 = wp[(size_t)(k + 1) * 6144], w2 = wp[(size_t)(k + 2) * 6144], w3 = wp[(size_t)(k + 3) * 6144];
#pragma unroll
                for (int b = 0; b < 16; ++b) { const f32x4 s = *(const LAS f32x4*)(sc + b * 1024 + k); acc[b] += s[0] * w0 + s[1] * w1 + s[2] * w2 + s[3] * w3; }
            }
#pragma unroll
            for (int b = 0; b < 16; ++b) red[(ks * 16 + b) * 64 + cl] = acc[b];
            __syncthreads();
            for (int o = tid; o < 1024; o += NTHREADS) { const int b = o >> 6, c2 = o & 63; float s = p->b_ada[(size_t)l * 6144 + cb * 64 + c2];
#pragma unroll
                for (int q = 0; q < 8; ++q) s += red[(q * 16 + b) * 64 + c2];
                ((float*)(F.ws + WS_MOD))[((size_t)l * 16 + b) * 6144 + cb * 64 + c2] = s; }
            __syncthreads();
        } else if (it < I_ZROW) {
            const int idx = (it - I_ROPE) * NTHREADS + tid, pos = idx >> 5, cc = idx & 31;
            const float invf = __expf(-((float)(2 * cc) * (1.0f / 64.0f)) * 9.210340371976184f);
            const double ang = (double)pos * (double)invf, nn = __builtin_rint(ang * 0.15915494309189535), r = ang - nn * 6.283185307179586, r2 = r * r;
            double sn = 0.0, cs = 0.0;
#pragma unroll
            for (int k = 14; k >= 1; --k) { sn = sn * r2 * (-1.0 / (double)((2 * k) * (2 * k + 1))) + 1.0; cs = cs * r2 * (-1.0 / (double)((2 * k - 1) * (2 * k))) + 1.0; }
            sn *= r;
            ((float*)(F.ws + WS_ROPE))[idx] = (float)cs; ((float*)(F.ws + WS_ROPE))[2048 * 32 + idx] = (float)sn;
        } else {
            u32x4* z = (u32x4*)((bf16_t*)(F.ws + WS_H) + (size_t)NTOK * 1024);
            if (tid < 128) z[tid] = (u32x4){0u, 0u, 0u, 0u};
        }
    }
}

__device__ __forceinline__ void phase_norm(Frame& F, const float* xin, const float* g, const float* mod_l, int shift_off, int scale_off) {
    bf16_t* H = (bf16_t*)(F.ws + WS_H);
    for (int row = F.bid * 8 + F.wave; row < NTOK; row += F.G * 8) {
        const int b = row / SEQ; const float* xr = xin + (size_t)row * D; f32x4 v[4]; float ss = 0.f;
#pragma unroll
        for (int i = 0; i < 4; ++i) { v[i] = *(const f32x4*)(xr + i * 256 + F.lane * 4); ss += v[i][0] * v[i][0] + v[i][1] * v[i][1] + v[i][2] * v[i][2] + v[i][3] * v[i][3]; }
        ss = wave_sum(ss, F.lane); const float rstd = rsqrtf(ss * (1.0f / D) + 1e-6f);
#pragma unroll
        for (int i = 0; i < 4; ++i) { const int c0 = i * 256 + F.lane * 4; const f32x4 gg = *(const f32x4*)(g + c0), sc = *(const f32x4*)(mod_l + (size_t)b * 6144 + scale_off + c0), sh = *(const f32x4*)(mod_l + (size_t)b * 6144 + shift_off + c0);
            float o[4];
#pragma unroll
            for (int j = 0; j < 4; ++j) o[j] = v[i][j] * rstd * gg[j] * (1.0f + sc[j]) + sh[j];
            u32x2 w; w.x = pack2(o[0], o[1]); w.y = pack2(o[2], o[3]); *(u32x2*)(H + (size_t)row * D + c0) = w; }
    }
}

__device__ __forceinline__ void phase_final(Frame& F) {
    float* X = F.p->out;
    for (int row = F.bid * 8 + F.wave; row < NTOK; row += F.G * 8) {
        float* xr = X + (size_t)row * D; f32x4 v[4]; float ss = 0.f;
#pragma unroll
        for (int i = 0; i < 4; ++i) { v[i] = *(const f32x4*)(xr + i * 256 + F.lane * 4); ss += v[i][0] * v[i][0] + v[i][1] * v[i][1] + v[i][2] * v[i][2] + v[i][3] * v[i][3]; }
        ss = wave_sum(ss, F.lane); const float rstd = rsqrtf(ss * (1.0f / D) + 1e-6f);
#pragma unroll
        for (int i = 0; i < 4; ++i) { const int c0 = i * 256 + F.lane * 4; const f32x4 gg = *(const f32x4*)(F.p->final_g + c0); *(f32x4*)(xr + c0) = v[i] * rstd * gg; }
    }
}

__device__ __forceinline__ void rwkv_prep_tile(Frame& F, int l, int item) {
    const PP p = F.p; const int tid = F.tid, lane = F.lane, fr = lane & 15, fq = lane >> 4;
    const bf16_t* P = (const bf16_t*)(F.ws + WS_P);
    const int row0 = item * 32, b = row0 / SEQ, t0 = row0 % SEQ;
    constexpr int PSS = 1416, XWS = 72, XGS = 136;
    LAS bf16_t* PS = (LAS bf16_t*)F.lds;
    LAS bf16_t* XW = (LAS bf16_t*)(F.lds + 90624);
    LAS bf16_t* XA = (LAS bf16_t*)(F.lds + 90624 + 4608);
    LAS bf16_t* XG = (LAS bf16_t*)(F.lds + 90624 + 9216);
#pragma unroll 1
    for (int ito_ = 0; ito_ < 3; ++ito_)
#pragma unroll
    for (int iti_ = 0; iti_ < 4; ++iti_) {
        const int idx = tid + (ito_ * 4 + iti_) * NTHREADS; if (idx >= 32 * 176) continue;
        const int i = idx / 176, q = idx % 176, c0 = q * 8;
        const u32x4 cu = *(const u32x4*)(P + (size_t)(row0 + i) * INP + c0);
        u32x4 pv = (u32x4){0u, 0u, 0u, 0u}; if (t0 + i > 0) pv = *(const u32x4*)(P + (size_t)(row0 + i - 1) * INP + c0);
        float cf[8], pf[8], s[8]; unpack8(cu, cf); unpack8(pv, pf);
        const f32x4 m0 = *(const f32x4*)(p->rwkv_mu + (size_t)l * RCOLS + c0), m1 = *(const f32x4*)(p->rwkv_mu + (size_t)l * RCOLS + c0 + 4);
#pragma unroll
        for (int j = 0; j < 4; ++j) { s[j] = cf[j] + (pf[j] - cf[j]) * m0[j]; s[4 + j] = cf[4 + j] + (pf[4 + j] - cf[4 + j]) * m1[j]; }
        if (c0 < 1152) *(LAS u32x4*)(PS + i * PSS + c0) = pack8(s);
        else if (c0 < 1216) {
#pragma unroll
            for (int j = 0; j < 8; ++j) s[j] = tanhf_(s[j]);
            *(LAS u32x4*)(XW + i * XWS + (c0 - 1152)) = pack8(s);
        } else if (c0 < 1280) *(LAS u32x4*)(XA + i * XWS + (c0 - 1216)) = pack8(s);
        else {
#pragma unroll
            for (int j = 0; j < 8; ++j) s[j] = sigmoidf_(s[j]);
            *(LAS u32x4*)(XG + i * XGS + (c0 - 1280)) = pack8(s);
        }
    }
    __syncthreads();
    if (F.wave < 6) {
        const int hd = F.wave;
        const bf16_t* WU = (const bf16_t*)(F.ws + WS_WUPT) + (size_t)l * 384 * 64, *AU = (const bf16_t*)(F.ws + WS_AUPT) + (size_t)l * 384 * 64, *GU = (const bf16_t*)(F.ws + WS_GUPT) + (size_t)l * 384 * 128;
        float* SWp = (float*)(F.ws + WS_SW); bf16_t* SAp = (bf16_t*)(F.ws + WS_SX); bf16_t* SBp = SAp + SARR / 2; bf16_t* SKp = SBp + SARR / 2; bf16_t* SRp = SKp + SARR / 2; bf16_t* SVp = SRp + SARR / 2;
        bf16_t* Gp = (bf16_t*)(F.ws + WS_G);
#pragma unroll 1
        for (int mt = 0; mt < 2; ++mt) {
            const int i = mt * 16 + fr;
            const size_t ob = (((size_t)b * RH + hd) * SEQ + t0 + i) * 64;
            {
                f32x4 ag[4];
#pragma unroll
                for (int nt = 0; nt < 4; ++nt) ag[nt] = (f32x4){0.f, 0.f, 0.f, 0.f};
#pragma unroll
                for (int ks = 0; ks < 4; ++ks) {
                    const bf16x8 xg = *(const LAS bf16x8*)(XG + i * XGS + ks * 32 + fq * 8);
#pragma unroll
                    for (int nt = 0; nt < 4; ++nt) { const bf16x8 gf = *(const bf16x8*)(GU + (size_t)(hd * 64 + nt * 16 + fr) * 128 + ks * 32 + fq * 8); ag[nt] = __builtin_amdgcn_mfma_f32_16x16x32_bf16(gf, xg, ag[nt], 0, 0, 0); }
                }
#pragma unroll
                for (int nt = 0; nt < 4; ++nt) { u32x2 gw; gw.x = pack2(ag[nt][0], ag[nt][1]); gw.y = pack2(ag[nt][2], ag[nt][3]); *(u32x2*)(Gp + (size_t)(row0 + i) * RW + hd * 64 + nt * 16 + fq * 4) = gw; }
            }
            f32x4 aw[4], aa[4];
#pragma unroll
            for (int nt = 0; nt < 4; ++nt) { aw[nt] = (f32x4){0.f, 0.f, 0.f, 0.f}; aa[nt] = (f32x4){0.f, 0.f, 0.f, 0.f}; }
#pragma unroll
            for (int ks = 0; ks < 2; ++ks) {
                const bf16x8 xw = *(const LAS bf16x8*)(XW + i * XWS + ks * 32 + fq * 8), xa = *(const LAS bf16x8*)(XA + i * XWS + ks * 32 + fq * 8);
#pragma unroll
                for (int nt = 0; nt < 4; ++nt) {
                    const bf16x8 wf = *(const bf16x8*)(WU + (size_t)(hd * 64 + nt * 16 + fr) * 64 + ks * 32 + fq * 8), af = *(const bf16x8*)(AU + (size_t)(hd * 64 + nt * 16 + fr) * 64 + ks * 32 + fq * 8);
                    aw[nt] = __builtin_amdgcn_mfma_f32_16x16x32_bf16(wf, xw, aw[nt], 0, 0, 0); aa[nt] = __builtin_amdgcn_mfma_f32_16x16x32_bf16(af, xa, aa[nt], 0, 0, 0);
                }
            }
            float ss = 0.f;
#pragma unroll
            for (int nt = 0; nt < 4; ++nt) {
                const int ch0 = hd * 64 + nt * 16 + fq * 4;
                const u32x2 r2 = *(const LAS u32x2*)(PS + i * PSS + ch0), k2 = *(const LAS u32x2*)(PS + i * PSS + 384 + ch0), v2 = *(const LAS u32x2*)(PS + i * PSS + 768 + ch0);
                const float kf[4] = {bf2f(k2.x & 0xffffu), __uint_as_float(k2.x & 0xffff0000u), bf2f(k2.y & 0xffffu), __uint_as_float(k2.y & 0xffff0000u)};
                const f32x4 w0 = *(const f32x4*)(p->rwkv_w0 + (size_t)l * RW + ch0), a0 = *(const f32x4*)(p->rwkv_a0 + (size_t)l * RW + ch0), kkp = *(const f32x4*)(p->rwkv_k_k + (size_t)l * RW + ch0), kap = *(const f32x4*)(p->rwkv_k_a + (size_t)l * RW + ch0);
                f32x4 wv; float kn[4];
#pragma unroll
                for (int j = 0; j < 4; ++j) {
                    const float z = w0[j] + aw[nt][j]; wv[j] = __expf(-0.6065306597126334f * sigmoidf_(z));
                    const float a = sigmoidf_(a0[j] + aa[nt][j]); aa[nt][j] = a;
                    const float kv = kf[j] * kkp[j]; aw[nt][j] = kv; ss += kv * kv;
                    kn[j] = kf[j] * (1.0f + (a - 1.0f) * kap[j]);
                }
                *(f32x4*)(SWp + ob + nt * 16 + fq * 4) = wv;
                u32x2 kw; kw.x = pack2(kn[0], kn[1]); kw.y = pack2(kn[2], kn[3]); *(u32x2*)(SKp + ob + nt * 16 + fq * 4) = kw;
                *(u32x2*)(SRp + ob + nt * 16 + fq * 4) = r2; *(u32x2*)(SVp + ob + nt * 16 + fq * 4) = v2;
            }
            ss += shx(ss, 16, lane); ss += shx(ss, 32, lane);
            const float inv = 1.0f / fmaxf(sqrtf(ss), 1e-12f);
#pragma unroll
            for (int nt = 0; nt < 4; ++nt) {
                float av[4], bv[4];
#pragma unroll
                for (int j = 0; j < 4; ++j) { const float kn = aw[nt][j] * inv; av[j] = -kn; bv[j] = kn * aa[nt][j]; }
                u32x2 aw2, bw2; aw2.x = pack2(av[0], av[1]); aw2.y = pack2(av[2], av[3]); bw2.x = pack2(bv[0], bv[1]); bw2.y = pack2(bv[2], bv[3]);
                *(u32x2*)(SAp + ob + nt * 16 + fq * 4) = aw2; *(u32x2*)(SBp + ob + nt * 16 + fq * 4) = bw2;
            }
        }
    }
    __syncthreads();
}

__device__ __forceinline__ void phase_prep_rwkv(Frame& F, int l) {
    const PP p = F.p; const int tid = F.tid, lane = F.lane, w = F.wave, fr = lane & 15, fq = lane >> 4;
    const unsigned char* P = (const unsigned char*)(F.ws + WS_P);
    constexpr int RAWB = 24576, PS_OFF = 2 * RAWB, PSS = 1416, XWS = 72, XGS = 136, XW_OFF = PS_OFF + 16 * PSS * 2, XA_OFF = XW_OFF + 16 * XWS * 2, XG_OFF = XA_OFF + 16 * XWS * 2;
    LAS unsigned char* RAW = F.lds;
    LAS bf16_t* PS = (LAS bf16_t*)(F.lds + PS_OFF); LAS bf16_t* XW = (LAS bf16_t*)(F.lds + XW_OFF); LAS bf16_t* XA = (LAS bf16_t*)(F.lds + XA_OFF); LAS bf16_t* XG = (LAS bf16_t*)(F.lds + XG_OFF);
#define PREP_DMA(tile, buf) do { for (int m_ = w; m_ < 24; m_ += 8) { const int f_ = m_ * 64 + lane; int r_ = f_ / 88, ch_ = f_ % 88; int row_ = (tile) * 16 - 1 + r_; \
        if (f_ >= 1496 || row_ < 0) { row_ = 0; ch_ = 0; } \
        __builtin_amdgcn_global_load_lds((const unsigned*)(P + (size_t)row_ * INP + ch_ * 16), (LAS unsigned*)(RAW + (buf) * RAWB + m_ * 1024), 16, 0, 0); } } while (0)
    const int hd = w;
    const int wrow = hd * 64 + fr;
    const bf16_t* WU = (const bf16_t*)(F.ws + WS_WUPT) + (size_t)l * 384 * 64, *AU = (const bf16_t*)(F.ws + WS_AUPT) + (size_t)l * 384 * 64, *GU = (const bf16_t*)(F.ws + WS_GUPT) + (size_t)l * 384 * 128;
    u32x4 res[32];
#define WREG(nt, ks) __builtin_bit_cast(bf16x8, res[(nt) * 2 + (ks)])
#define AREG(nt, ks) __builtin_bit_cast(bf16x8, res[8 + (nt) * 2 + (ks)])
#define PW0(nt) __builtin_bit_cast(f32x4, res[16 + (nt)])
#define PA0(nt) __builtin_bit_cast(f32x4, res[20 + (nt)])
#define PKK(nt) __builtin_bit_cast(f32x4, res[24 + (nt)])
#define PKA(nt) __builtin_bit_cast(f32x4, res[28 + (nt)])
#define GFR(hl, ks, nt) __builtin_bit_cast(bf16x8, res[(hl) * 16 + (ks) * 4 + (nt)])
    if (w < 6) {
#pragma unroll
        for (int nt = 0; nt < 4; ++nt) {
#pragma unroll
            for (int ks = 0; ks < 2; ++ks) { res[nt * 2 + ks] = *(const u32x4*)(WU + (size_t)(wrow + nt * 16) * 64 + ks * 32 + fq * 8); res[8 + nt * 2 + ks] = *(const u32x4*)(AU + (size_t)(wrow + nt * 16) * 64 + ks * 32 + fq * 8); }
            const int ch0 = hd * 64 + nt * 16 + fq * 4;
            res[16 + nt] = *(const u32x4*)(p->rwkv_w0 + (size_t)l * RW + ch0); res[20 + nt] = *(const u32x4*)(p->rwkv_a0 + (size_t)l * RW + ch0); res[24 + nt] = *(const u32x4*)(p->rwkv_k_k + (size_t)l * RW + ch0); res[28 + nt] = *(const u32x4*)(p->rwkv_k_a + (size_t)l * RW + ch0);
        }
    }
    else {
#pragma unroll
        for (int hl = 0; hl < 2; ++hl)
#pragma unroll
            for (int ks = 0; ks < 4; ++ks)
#pragma unroll
                for (int nt = 0; nt < 4; ++nt) res[hl * 16 + ks * 4 + nt] = *(const u32x4*)(GU + (size_t)(((w - 6) * 3 + hl) * 64 + fr + nt * 16) * 128 + ks * 32 + fq * 8);
    }
    bf16_t* SWp = (bf16_t*)(F.ws + WS_SW); bf16_t* SAp = (bf16_t*)(F.ws + WS_SX); bf16_t* SBp = SAp + SARR / 2; bf16_t* SKp = SBp + SARR / 2; bf16_t* SRp = SKp + SARR / 2; bf16_t* SVp = SRp + SARR / 2;
    bf16_t* Gp = (bf16_t*)(F.ws + WS_G);
    LAS float* MU = (LAS float*)(F.lds + 114688);
    for (int i_ = tid; i_ < RCOLS; i_ += NTHREADS) MU[i_] = p->rwkv_mu[(size_t)l * RCOLS + i_];
    LAS float* RKT = (LAS float*)(F.lds + 155136);
    if (tid < RW) RKT[tid] = p->rwkv_r_k[(size_t)l * RW + tid];
    int tile = F.bid;
    if (tile < 2048) PREP_DMA(tile, 0);
    if (tile + F.G < 2048) PREP_DMA(tile + F.G, 1);
    int buf = 0;
    __syncthreads();
#pragma unroll 1
    for (; tile < 2048; tile += F.G, buf ^= 1) {
        const int row0 = tile * 16, b = row0 / SEQ, t0 = row0 % SEQ;
        LDS_BAR();
        const LAS unsigned char* raw = RAW + buf * RAWB;
#pragma unroll 1
        for (int idx = tid; idx < 16 * 88; idx += NTHREADS) {
            const int i = idx / 88, q = idx % 88, c0 = q * 16;
            const u32x4 cu = *(const LAS u32x4*)(raw + (i + 1) * 1408 + q * 16);
            u32x4 pv = *(const LAS u32x4*)(raw + i * 1408 + q * 16); if (t0 + i == 0) pv = (u32x4){0u, 0u, 0u, 0u};
            float cf[16], pf[16], sv[16]; unpack16f8(cu, cf, PINV); unpack16f8(pv, pf, PINV);
#pragma unroll
            for (int g4 = 0; g4 < 4; ++g4) { const f32x4 m4 = *(const LAS f32x4*)(MU + c0 + g4 * 4);
#pragma unroll
                for (int j = 0; j < 4; ++j) sv[g4 * 4 + j] = cf[g4 * 4 + j] + (pf[g4 * 4 + j] - cf[g4 * 4 + j]) * m4[j]; }
            LAS bf16_t* dst;
            if (c0 < 1152) dst = PS + i * PSS + c0;
            else if (c0 < 1216) { dst = XW + i * XWS + (c0 - 1152);
#pragma unroll
                for (int j = 0; j < 16; ++j) sv[j] = tanhf_(sv[j]); }
            else if (c0 < 1280) dst = XA + i * XWS + (c0 - 1216);
            else { dst = XG + i * XGS + (c0 - 1280);
#pragma unroll
                for (int j = 0; j < 16; ++j) sv[j] = sigmoidf_(sv[j]); }
            u32x4 o0, o1; o0.x = pack2(sv[0], sv[1]); o0.y = pack2(sv[2], sv[3]); o0.z = pack2(sv[4], sv[5]); o0.w = pack2(sv[6], sv[7]); o1.x = pack2(sv[8], sv[9]); o1.y = pack2(sv[10], sv[11]); o1.z = pack2(sv[12], sv[13]); o1.w = pack2(sv[14], sv[15]);
            *(LAS u32x4*)dst = o0; *(LAS u32x4*)(dst + 8) = o1;
        }
        __syncthreads();
        if (tile + 2 * F.G < 2048) PREP_DMA(tile + 2 * F.G, buf);
        if (w < 6) {
            const int i = fr;
            const size_t ob0 = (((size_t)b * RH + hd) * SEQ + t0) * 64;
            LAS unsigned char* sb = F.lds + 120320 + w * 4352; u32x2 kwv[4];
            f32x4 aw[4], aa[4];
#pragma unroll
            for (int nt = 0; nt < 4; ++nt) { aw[nt] = (f32x4){0.f, 0.f, 0.f, 0.f}; aa[nt] = (f32x4){0.f, 0.f, 0.f, 0.f}; }
#pragma unroll
            for (int ks = 0; ks < 2; ++ks) {
                const bf16x8 xw = *(const LAS bf16x8*)(XW + i * XWS + ks * 32 + fq * 8), xa = *(const LAS bf16x8*)(XA + i * XWS + ks * 32 + fq * 8);
#pragma unroll
                for (int nt = 0; nt < 4; ++nt) { aw[nt] = __builtin_amdgcn_mfma_f32_16x16x32_bf16(WREG(nt, ks), xw, aw[nt], 0, 0, 0); aa[nt] = __builtin_amdgcn_mfma_f32_16x16x32_bf16(AREG(nt, ks), xa, aa[nt], 0, 0, 0); }
            }
            float ss = 0.f, bon = 0.f;
#pragma unroll
            for (int nt = 0; nt < 4; ++nt) {
                const int ch0 = hd * 64 + nt * 16 + fq * 4;
                const u32x2 r2 = *(const LAS u32x2*)(PS + i * PSS + ch0), k2 = *(const LAS u32x2*)(PS + i * PSS + 384 + ch0), v2 = *(const LAS u32x2*)(PS + i * PSS + 768 + ch0);
                const float kf[4] = {bf2f(k2.x & 0xffffu), __uint_as_float(k2.x & 0xffff0000u), bf2f(k2.y & 0xffffu), __uint_as_float(k2.y & 0xffff0000u)};
                float wv[4]; float kn[4];
#pragma unroll
                for (int j = 0; j < 4; ++j) {
                    const float z = PW0(nt)[j] + aw[nt][j]; wv[j] = -0.6065306597126334f * sigmoidf_(z);
                    const float a = sigmoidf_(PA0(nt)[j] + aa[nt][j]); aa[nt][j] = a;
                    const float kv = kf[j] * PKK(nt)[j]; aw[nt][j] = kv; ss += kv * kv;
                    kn[j] = kf[j] * (1.0f + (a - 1.0f) * PKA(nt)[j]);
                }
                { const f32x4 rk4 = *(const LAS f32x4*)(RKT + ch0);
                  bon += bf2f(r2.x & 0xffffu) * kn[0] * rk4[0] + __uint_as_float(r2.x & 0xffff0000u) * kn[1] * rk4[1] + bf2f(r2.y & 0xffffu) * kn[2] * rk4[2] + __uint_as_float(r2.y & 0xffff0000u) * kn[3] * rk4[3]; }
                { u32x2 ww; ww.x = pack2(wv[0], wv[1]); ww.y = pack2(wv[2], wv[3]); *(LAS u32x2*)(sb + i * 136 + (nt * 16 + fq * 4) * 2) = ww; }
                { u32x2 kw_; kw_.x = pack2(kn[0], kn[1]); kw_.y = pack2(kn[2], kn[3]); *(LAS u32x2*)(sb + 2176 + i * 136 + (nt * 16 + fq * 4) * 2) = kw_; }
            }
            asm volatile("" ::: "memory");
#pragma unroll
            for (int m = 0; m < 2; ++m) { const u32x4 q_ = *(const LAS u32x4*)(sb + (m * 8 + (lane >> 3)) * 136 + (lane & 7) * 16); *(u32x4*)(SWp + ob0 + (m * 64 + lane) * 8) = q_; }
            asm volatile("" ::: "memory");
#pragma unroll
            for (int m = 0; m < 2; ++m) { const int rw_ = m * 8 + (lane >> 3), cb_ = (lane & 7) * 8;
                const u32x4 kq_ = *(const LAS u32x4*)(sb + 2176 + rw_ * 136 + cb_ * 2), rq_ = *(const LAS u32x4*)(PS + rw_ * PSS + hd * 64 + cb_), vq_ = *(const LAS u32x4*)(PS + rw_ * PSS + 768 + hd * 64 + cb_);
                *(u32x4*)(SKp + ob0 + (m * 64 + lane) * 8) = kq_; *(u32x4*)(SRp + ob0 + (m * 64 + lane) * 8) = rq_; *(u32x4*)(SVp + ob0 + (m * 64 + lane) * 8) = vq_; }
            asm volatile("" ::: "memory");
            ss += shx(ss, 16, lane); ss += shx(ss, 32, lane);
            bon += shx(bon, 16, lane); bon += shx(bon, 32, lane);
            if (fq == 0) ((float*)(F.ws + WS_BON))[((size_t)b * RH + hd) * SEQ + t0 + i] = bon;
            const float inv = 1.0f / fmaxf(sqrtf(ss), 1e-12f);
#pragma unroll
            for (int nt = 0; nt < 4; ++nt) {
                float av[4], bv[4];
#pragma unroll
                for (int j = 0; j < 4; ++j) { const float kq = aw[nt][j] * inv; av[j] = -kq; bv[j] = kq * aa[nt][j]; }
                u32x2 aw2; aw2.x = pack2(av[0], av[1]); aw2.y = pack2(av[2], av[3]); kwv[nt].x = pack2(bv[0], bv[1]); kwv[nt].y = pack2(bv[2], bv[3]);
                *(LAS u32x2*)(sb + i * 136 + (nt * 16 + fq * 4) * 2) = aw2;
            }
            asm volatile("" ::: "memory");
#pragma unroll
            for (int m = 0; m < 2; ++m) { const u32x4 q_ = *(const LAS u32x4*)(sb + (m * 8 + (lane >> 3)) * 136 + (lane & 7) * 16); *(u32x4*)(SAp + ob0 + (m * 64 + lane) * 8) = q_; }
            asm volatile("" ::: "memory");
#pragma unroll
            for (int nt = 0; nt < 4; ++nt) *(LAS u32x2*)(sb + i * 136 + (nt * 16 + fq * 4) * 2) = kwv[nt];
            asm volatile("" ::: "memory");
#pragma unroll
            for (int m = 0; m < 2; ++m) { const u32x4 q_ = *(const LAS u32x4*)(sb + (m * 8 + (lane >> 3)) * 136 + (lane & 7) * 16); *(u32x4*)(SBp + ob0 + (m * 64 + lane) * 8) = q_; }
            asm volatile("" ::: "memory");
        } else {
            const int i = fr; LAS unsigned char* sbg = F.lds + 120320 + w * 4352;
            bf16x8 xg[4];
#pragma unroll
            for (int ks = 0; ks < 4; ++ks) xg[ks] = *(const LAS bf16x8*)(XG + i * XGS + ks * 32 + fq * 8);
#pragma unroll
            for (int hl = 0; hl < 3; ++hl) {
                f32x4 ag[4];
#pragma unroll
                for (int nt = 0; nt < 4; ++nt) ag[nt] = (f32x4){0.f, 0.f, 0.f, 0.f};
#pragma unroll
                for (int ks = 0; ks < 4; ++ks)
#pragma unroll
                    for (int nt = 0; nt < 4; ++nt) { const bf16x8 gf = (hl < 2) ? GFR(hl & 1, ks, nt) : *(const bf16x8*)(GU + (size_t)(((w - 6) * 3 + 2) * 64 + fr + nt * 16) * 128 + ks * 32 + fq * 8);
                        ag[nt] = __builtin_amdgcn_mfma_f32_16x16x32_bf16(gf, xg[ks], ag[nt], 0, 0, 0); }
#pragma unroll
                for (int nt = 0; nt < 4; ++nt) { u32x2 gw; gw.x = pack2(ag[nt][0], ag[nt][1]); gw.y = pack2(ag[nt][2], ag[nt][3]); *(LAS u32x2*)(sbg + i * 136 + (nt * 16 + fq * 4) * 2) = gw; }
                asm volatile("" ::: "memory");
#pragma unroll
                for (int m = 0; m < 2; ++m) { const int rw_ = m * 8 + (lane >> 3); const u32x4 q_ = *(const LAS u32x4*)(sbg + rw_ * 136 + (lane & 7) * 16);
                    *(u32x4*)(Gp + (size_t)(row0 + rw_) * RW + ((w - 6) * 3 + hl) * 64 + (lane & 7) * 8) = q_; }
                asm volatile("" ::: "memory");
            }
        }
    }
#undef WREG
#undef AREG
#undef PW0
#undef PA0
#undef PKK
#undef PKA
#undef GFR
#undef PREP_DMA
    __syncthreads();
}

__device__ __forceinline__ void pool_tile(Frame& F, int l, int item) {
    const PP p = F.p; const int tid = F.tid, lane = F.lane, fr = lane & 15, fq = lane >> 4;
    const unsigned char* P = (const unsigned char*)(F.ws + WS_P);
    const int row0 = item * 64, t0 = row0 % SEQ;
    constexpr int PLS = 264;
    LAS float* U = (LAS float*)F.lds;
    LAS bf16_t* PL = (LAS bf16_t*)(F.lds + 81920);
#pragma unroll
    for (int it_ = 0; it_ < 3; ++it_) {
        const int idx = tid + it_ * NTHREADS; if (idx >= 79 * 16) break;
        const int r = idx >> 4, q = idx & 15, t = t0 - 15 + r; float f[16];
        if (t >= 0) { const u32x4 v = *(const u32x4*)(P + (size_t)(row0 - 15 + r) * INP + POOL_OFF + q * 16); unpack16f8(v, f, PINV); }
        else {
#pragma unroll
            for (int j = 0; j < 16; ++j) f[j] = 0.f;
        }
#pragma unroll
        for (int g4 = 0; g4 < 4; ++g4) *(LAS f32x4*)(U + r * 256 + q * 16 + g4 * 4) = (f32x4){f[g4 * 4], f[g4 * 4 + 1], f[g4 * 4 + 2], f[g4 * 4 + 3]};
    }
    __syncthreads();
    {
        const int c4 = (tid & 63) * 4, g = c4 >> 6, win = 2 << g, i0 = (tid >> 6) * 8;
        f32x4 sm = (f32x4){0.f, 0.f, 0.f, 0.f};
        for (int q = 0; q < win; ++q) sm += *(const LAS f32x4*)(U + (15 + i0 - q) * 256 + c4);
#pragma unroll 1
        for (int k = 0; k < 8; ++k) {
            const int i = i0 + k, t = t0 + i;
            const f32x4 cur = *(const LAS f32x4*)(U + (15 + i) * 256 + c4);
            if (k > 0) sm += cur - *(const LAS f32x4*)(U + (15 + i - win) * 256 + c4);
            const int cnt = (t + 1 < win) ? t + 1 : win; const float ic = 1.0f / (float)cnt;
            u32x2 w; w.x = pack2(sm[0] * ic - cur[0], sm[1] * ic - cur[1]); w.y = pack2(sm[2] * ic - cur[2], sm[3] * ic - cur[3]);
            *(LAS u32x2*)(PL + i * PLS + c4) = w;
        }
    }
    __syncthreads();
    {
        const int g = F.wave >> 1; const bf16_t* PW = (const bf16_t*)(F.ws + WS_POOLWT) + ((size_t)l * 4 + g) * 64 * 64;
        bf16_t* MX = (bf16_t*)(F.ws + WS_H);
#pragma unroll
        for (int mq = 0; mq < 2; ++mq) {
            const int mt = (F.wave & 1) * 2 + mq;
            f32x4 acc[4];
#pragma unroll
            for (int nt = 0; nt < 4; ++nt) acc[nt] = (f32x4){0.f, 0.f, 0.f, 0.f};
#pragma unroll
            for (int ks = 0; ks < 2; ++ks) {
                const bf16x8 xf = *(const LAS bf16x8*)(PL + (mt * 16 + fr) * PLS + g * 64 + ks * 32 + fq * 8);
#pragma unroll
                for (int nt = 0; nt < 4; ++nt) { const bf16x8 wf = *(const bf16x8*)(PW + (size_t)(nt * 16 + fr) * 64 + ks * 32 + fq * 8); acc[nt] = __builtin_amdgcn_mfma_f32_16x16x32_bf16(wf, xf, acc[nt], 0, 0, 0); }
            }
            LAS unsigned char* sbp = F.lds + 120320 + F.wave * 4352;
#pragma unroll
            for (int nt = 0; nt < 4; ++nt) {
                const int d0 = nt * 16 + fq * 4; const f32x4 ps = *(const f32x4*)(p->pool_scale + (size_t)l * 256 + g * 64 + d0);
                u32x2 w; w.x = pack2(acc[nt][0] * ps[0], acc[nt][1] * ps[1]); w.y = pack2(acc[nt][2] * ps[2], acc[nt][3] * ps[3]);
                *(LAS u32x2*)(sbp + fr * 136 + d0 * 2) = w;
            }
            asm volatile("" ::: "memory");
#pragma unroll
            for (int m = 0; m < 2; ++m) { const int rw_ = m * 8 + (lane >> 3); const u32x4 q_ = *(const LAS u32x4*)(sbp + rw_ * 136 + (lane & 7) * 16);
                *(u32x4*)(MX + (size_t)(row0 + mt * 16 + rw_) * D + 768 + g * 64 + (lane & 7) * 8) = q_; }
            asm volatile("" ::: "memory");
        }
    }
    __syncthreads();
}

__device__ __forceinline__ void rwkv_scan_block(Frame& F, int blk) {
    const int tid = F.tid, lane = F.lane, w = F.wave, rs = lane >> 4, jg = lane & 15;
    const int bh = blk >> 1, half = blk & 1, b = bh / RH, h = bh % RH;
    const int rl = w * 4 + rs;
    const size_t base = (size_t)bh * SEQ * 64;
    const float* SWp = (const float*)(F.ws + WS_SW) + base;
    const unsigned char* SXp = F.ws + WS_SX + base * 2;
    float* YS = (float*)(F.ws + WS_YS);
    LAS unsigned char* opb = F.lds;
    LAS unsigned char* yb2 = F.lds + 98304;
    f32x4 pw; u32x4 pb[3];
    float S[4] = {0.f, 0.f, 0.f, 0.f};
#define SCAN_LOAD(c) do { pw = *(const f32x4*)(SWp + (size_t)(c) * 2048 + tid * 4); \
        _Pragma("unroll") for (int q = 0; q < 3; ++q) { const int idx = tid + NTHREADS * q; if (idx < 1280) { const int arr = idx >> 8, ch = idx & 255; \
            pb[q] = *(const u32x4*)(SXp + (size_t)arr * SARR + ((size_t)(c) * 2048 + ch * 8) * 2); } } } while (0)
#define SCAN_STORE(buf) do { *(LAS f32x4*)(opb + (buf) * 49152 + tid * 16) = pw; \
        _Pragma("unroll") for (int q = 0; q < 3; ++q) { const int idx = tid + NTHREADS * q; if (idx < 1280) { const int arr = idx >> 8, ch = idx & 255; float f[8]; unpack8(pb[q], f); \
            LAS unsigned char* d = opb + (buf) * 49152 + (1 + arr) * 8192 + ch * 32; *(LAS f32x4*)d = (f32x4){f[0], f[1], f[2], f[3]}; *(LAS f32x4*)(d + 16) = (f32x4){f[4], f[5], f[6], f[7]}; } } } while (0)
#define SCAN_OPS(st, W4, A4, B4, K4, R4, V1) do { W4 = *(const LAS f32x4*)(ob + (st) * 256); A4 = *(const LAS f32x4*)(ob + 8192 + (st) * 256); B4 = *(const LAS f32x4*)(ob + 16384 + (st) * 256); \
        K4 = *(const LAS f32x4*)(ob + 24576 + (st) * 256); R4 = *(const LAS f32x4*)(ob + 32768 + (st) * 256); V1 = *(const LAS float*)(vb + (st) * 256); } while (0)
    SCAN_LOAD(0); SCAN_STORE(0); __syncthreads();
#pragma unroll 1
    for (int c = 0; c < SEQ / 32; ++c) {
        const int buf = c & 1;
        if (c + 1 < SEQ / 32) SCAN_LOAD(c + 1);
        const LAS unsigned char* ob = opb + buf * 49152 + jg * 16;
        const LAS unsigned char* vb = opb + buf * 49152 + 5 * 8192 + (half * 32 + rl) * 4;
        float yk0 = 0.f, yk1 = 0.f;
        f32x4 cw, ca, cb, ck, cr; float cv;
        SCAN_OPS(0, cw, ca, cb, ck, cr, cv);
        float yp = 0.f;
#pragma unroll
        for (int st = 0; st < 32; ++st) {
            f32x4 nw = cw, na = ca, nb = cb, nk = ck, nr = cr; float nv = cv;
            if (st + 1 < 32) SCAN_OPS(st + 1, nw, na, nb, nk, nr, nv);
            float sa = S[0] * ca[0]; sa = __builtin_fmaf(S[1], ca[1], sa); sa = __builtin_fmaf(S[2], ca[2], sa); sa = __builtin_fmaf(S[3], ca[3], sa);
            sa += dpp_ror<8>(sa); yp += dpp_ror<8>(yp); sa += dpp_ror<4>(sa); yp += dpp_ror<4>(yp); sa += dpp_ror<2>(sa); yp += dpp_ror<2>(yp); sa += dpp_ror<1>(sa); yp += dpp_ror<1>(yp);
            if (st >= 1) { if (st - 1 < 16) yk0 = (jg == st - 1) ? yp : yk0; else yk1 = (jg == st - 17) ? yp : yk1; }
#pragma unroll
            for (int j = 0; j < 4; ++j) { float t_ = cv * ck[j]; t_ = __builtin_fmaf(sa, cb[j], t_); S[j] = __builtin_fmaf(S[j], cw[j], t_); asm volatile("" : "+v"(S[j])); }
            yp = S[0] * cr[0]; yp = __builtin_fmaf(S[1], cr[1], yp); yp = __builtin_fmaf(S[2], cr[2], yp); yp = __builtin_fmaf(S[3], cr[3], yp);
            cw = nw; ca = na; cb = nb; ck = nk; cr = nr; cv = nv;
        }
        yp = row16_sum(yp); yk1 = (jg == 15) ? yp : yk1;
        { LAS float* yo = (LAS float*)(yb2 + buf * 4096); yo[jg * 32 + rl] = yk0; yo[(16 + jg) * 32 + rl] = yk1; }
        if (c + 1 < SEQ / 32) SCAN_STORE(buf ^ 1);
        __syncthreads();
        if (tid < 256) { const int st = tid >> 3, c4 = tid & 7; const f32x4 yv = *(const LAS f32x4*)(yb2 + buf * 4096 + st * 128 + c4 * 16);
          *(f32x4*)(YS + ((size_t)b * SEQ + c * 32 + st) * RW + h * 64 + half * 32 + c4 * 4) = yv; }
    }
#undef SCAN_LOAD
#undef SCAN_STORE
#undef SCAN_OPS
    __syncthreads();
}

__device__ __forceinline__ void retention_item(Frame& F, int bh) {
    const int tid = F.tid, lane = F.lane, w = F.wave, fr = lane & 15, fq = lane >> 4;
    const int b = bh / RH, h = bh % RH;
    const unsigned char* P = (const unsigned char*)(F.ws + WS_P);
    const float* ROPE = (const float*)(F.ws + WS_ROPE);
    bf16_t* MX = (bf16_t*)(F.ws + WS_H);
    constexpr int QS = 72, TS = 136;
    LAS bf16_t* Qs = (LAS bf16_t*)F.lds;
    LAS bf16_t* Ks = (LAS bf16_t*)(F.lds + 18432);
    LAS bf16_t* KTs = (LAS bf16_t*)(F.lds + 36864);
    LAS bf16_t* VTs = (LAS bf16_t*)(F.lds + 54272);
    LAS bf16_t* Ps = (LAS bf16_t*)(F.lds + 71680);
    LAS bf16_t* RTs = (LAS bf16_t*)(F.lds + 106496);
    const float lg = log1pf(-exp2f(-5.0f - (float)h)), lg2 = lg * 1.4426950408889634f;
    const float cd = exp2f(lg2 * 128.0f);
    for (int i = tid; i < 64 * QS / 2; i += NTHREADS) ((LAS unsigned*)RTs)[i] = 0u;
    f32x4 Rreg[2] = {(f32x4){0.f, 0.f, 0.f, 0.f}, (f32x4){0.f, 0.f, 0.f, 0.f}};
    u32x2 rq0, rq1, rk0, rk1; u32x4 rvv; f32x4 rc0, rc1, rs0, rs1;
#define RET_LOAD(n_) do { const int tk_ = tid >> 2, c0_ = (tid & 3) * 8, pos_ = (n_) * 128 + tk_; const unsigned char* pb_ = P + (size_t)(b * SEQ + pos_) * INP + RET_OFF + h * 64; \
        rq0 = *(const u32x2*)(pb_ + c0_); rq1 = *(const u32x2*)(pb_ + 32 + c0_); rk0 = *(const u32x2*)(pb_ + 384 + c0_); rk1 = *(const u32x2*)(pb_ + 384 + 32 + c0_); rvv = *(const u32x4*)(pb_ + 768 + (tid & 3) * 16); \
        rc0 = *(const f32x4*)(ROPE + pos_ * 32 + c0_); rc1 = *(const f32x4*)(ROPE + pos_ * 32 + c0_ + 4); rs0 = *(const f32x4*)(ROPE + 65536 + pos_ * 32 + c0_); rs1 = *(const f32x4*)(ROPE + 65536 + pos_ * 32 + c0_ + 4); } while (0)
    RET_LOAD(0);
    for (int n = 0; n < SEQ / 128; ++n) {
        const int tok0 = b * SEQ + n * 128;
        LDS_BAR();
        {
            const int tk = tid >> 2, part = tid & 3, c0 = part * 8;
            float ql[8], qh[8], kl[8], kh[8], cs[8], sn[8];
            unpack8f8(rq0, ql, PINV); unpack8f8(rq1, qh, PINV);
            unpack8f8(rk0, kl, PINV); unpack8f8(rk1, kh, PINV);
            { const f32x4 c_0 = rc0, c_1 = rc1, s_0 = rs0, s_1 = rs1;
#pragma unroll
              for (int j = 0; j < 4; ++j) { cs[j] = c_0[j]; cs[4 + j] = c_1[j]; sn[j] = s_0[j]; sn[4 + j] = s_1[j]; } }
            float q1[8], q2[8], k1[8], k2[8];
#pragma unroll
            for (int j = 0; j < 8; ++j) { q1[j] = ql[j] * cs[j] - qh[j] * sn[j]; q2[j] = ql[j] * sn[j] + qh[j] * cs[j]; k1[j] = (kl[j] * cs[j] - kh[j] * sn[j]) * 0.125f; k2[j] = (kl[j] * sn[j] + kh[j] * cs[j]) * 0.125f; }
            *(LAS u32x4*)(Qs + tk * QS + c0) = pack8(q1); *(LAS u32x4*)(Qs + tk * QS + 32 + c0) = pack8(q2);
            *(LAS u32x4*)(Ks + tk * QS + c0) = pack8(k1); *(LAS u32x4*)(Ks + tk * QS + 32 + c0) = pack8(k2);
            const float zeta = exp2f(lg2 * (float)(127 - tk));
#pragma unroll
            for (int j = 0; j < 8; ++j) { KTs[(c0 + j) * TS + tk] = (bf16_t)f2bf(k1[j] * zeta); KTs[(32 + c0 + j) * TS + tk] = (bf16_t)f2bf(k2[j] * zeta); }
            { float vf[16]; unpack16f8(rvv, vf, PINV);
#pragma unroll
              for (int j = 0; j < 16; ++j) VTs[(part * 16 + j) * TS + tk] = (bf16_t)f2bf(vf[j]); }
        }
        if (n + 1 < SEQ / 128) RET_LOAD(n + 1);
        LDS_BAR();
        const int i0 = 16 * w;
        f32x4 yc[4];
        unsigned gq[4];
#pragma unroll
        for (int et = 0; et < 4; ++et) gq[et] = *(const unsigned*)(P + ((size_t)tok0 + i0 + fr) * INP + RET_OFF + 1152 + h * 64 + et * 16 + fq * 4);
        {
            bf16x8 qf[2];
#pragma unroll
            for (int ks = 0; ks < 2; ++ks) qf[ks] = *(const LAS bf16x8*)(Qs + (i0 + fr) * QS + ks * 32 + fq * 8);
            for (int jt = 0; jt <= w; ++jt) {
                f32x4 a = (f32x4){0.f, 0.f, 0.f, 0.f};
#pragma unroll
                for (int ks = 0; ks < 2; ++ks) { const bf16x8 kf = *(const LAS bf16x8*)(Ks + (jt * 16 + fr) * QS + ks * 32 + fq * 8); a = __builtin_amdgcn_mfma_f32_16x16x32_bf16(kf, qf[ks], a, 0, 0, 0); }
                const int i = i0 + fr, j0 = jt * 16 + fq * 4; float o[4];
#pragma unroll
                for (int r = 0; r < 4; ++r) { const int dd = i - (j0 + r); o[r] = (dd >= 0) ? a[r] * exp2f(lg2 * (float)dd) : 0.f; }
                u32x2 pw2; pw2.x = pack2(o[0], o[1]); pw2.y = pack2(o[2], o[3]); *(LAS u32x2*)(Ps + i * TS + j0) = pw2;
            }
            if ((w & 1) == 0) { *(LAS u32x2*)(Ps + (i0 + fr) * TS + (w + 1) * 16 + fq * 4) = (u32x2){0u, 0u}; }
#pragma unroll
            for (int et = 0; et < 4; ++et) { f32x4 a = (f32x4){0.f, 0.f, 0.f, 0.f};
#pragma unroll
                for (int ks = 0; ks < 2; ++ks) { const bf16x8 rf = *(const LAS bf16x8*)(RTs + (et * 16 + fr) * QS + ks * 32 + fq * 8); a = __builtin_amdgcn_mfma_f32_16x16x32_bf16(rf, qf[ks], a, 0, 0, 0); }
                yc[et] = a; }
        }
        LDS_BAR();
        {
            f32x4 y[4];
#pragma unroll
            for (int et = 0; et < 4; ++et) y[et] = (f32x4){0.f, 0.f, 0.f, 0.f};
            const int kmax = (i0 + 15) >> 5;
            for (int ks = 0; ks <= kmax; ++ks) {
                const bf16x8 pf = *(const LAS bf16x8*)(Ps + (i0 + fr) * TS + ks * 32 + fq * 8);
#pragma unroll
                for (int et = 0; et < 4; ++et) { const bf16x8 vf = *(const LAS bf16x8*)(VTs + (et * 16 + fr) * TS + ks * 32 + fq * 8); y[et] = __builtin_amdgcn_mfma_f32_16x16x32_bf16(vf, pf, y[et], 0, 0, 0); }
            }
            const float xi = exp2f(lg2 * (float)(i0 + fr + 1)); float ss = 0.f;
#pragma unroll
            for (int et = 0; et < 4; ++et)
#pragma unroll
                for (int r = 0; r < 4; ++r) { const float v = y[et][r] + xi * yc[et][r]; y[et][r] = v; ss += v * v; }
            ss += shx(ss, 16, lane); ss += shx(ss, 32, lane);
            const float rn = rsqrtf(ss * (1.0f / 64.0f) + 1e-6f);
            const size_t row = (size_t)tok0 + i0 + fr;
#pragma unroll
            for (int et = 0; et < 4; ++et) {
                const int e0 = et * 16 + fq * 4; float gf[4]; unpack4f8(gq[et], gf, PINV); float o[4];
#pragma unroll
                for (int r = 0; r < 4; ++r) o[r] = gf[r] * sigmoidf_(gf[r]) * y[et][r] * rn;
                u32x2 w2; w2.x = pack2(o[0], o[1]); w2.y = pack2(o[2], o[3]); *(u32x2*)(MX + row * D + 384 + h * 64 + e0) = w2;
            }
        }
        {
#pragma unroll
            for (int s = 0; s < 2; ++s) {
                const int tt = 2 * w + s, dt = tt >> 2, et = tt & 3; f32x4 a = (f32x4){0.f, 0.f, 0.f, 0.f};
#pragma unroll
                for (int ks = 0; ks < 4; ++ks) { const bf16x8 kf = *(const LAS bf16x8*)(KTs + (dt * 16 + fr) * TS + ks * 32 + fq * 8), vf = *(const LAS bf16x8*)(VTs + (et * 16 + fr) * TS + ks * 32 + fq * 8);
                    a = __builtin_amdgcn_mfma_f32_16x16x32_bf16(kf, vf, a, 0, 0, 0); }
                Rreg[s] = Rreg[s] * cd + a;
                u32x2 w2; w2.x = pack2(Rreg[s][0], Rreg[s][1]); w2.y = pack2(Rreg[s][2], Rreg[s][3]);
                *(LAS u32x2*)(RTs + (et * 16 + fr) * QS + dt * 16 + fq * 4) = w2;
            }
        }
    }
    __syncthreads();
}
#undef RET_LOAD


typedef short bf16x4 __attribute__((ext_vector_type(4)));
__device__ __forceinline__ bf16x4 cvt4(const f32x4 v) { u32x2 w; w.x = pack2(v[0], v[1]); w.y = pack2(v[2], v[3]); return __builtin_bit_cast(bf16x4, w); }
__device__ __forceinline__ bf16x8 cvt8(const f32x4 a, const f32x4 b) { u32x4 w; w.x = pack2(a[0], a[1]); w.y = pack2(a[2], a[3]); w.z = pack2(b[0], b[1]); w.w = pack2(b[2], b[3]); return __builtin_bit_cast(bf16x8, w); }
__device__ __forceinline__ f32x4 mm4(const f32x4 fat, const f32x4 fb, f32x4 c) {
#pragma unroll
    for (int i = 0; i < 4; ++i) c = __builtin_amdgcn_mfma_f32_16x16x4f32(fat[i], fb[i], c, 0, 0, 0);
    return c;
}
constexpr int CK_IMG = 8 * 272;
constexpr int CK_AH = 0, CK_RH = CK_IMG, CK_T = 2 * CK_IMG, CK_ARB = CK_T + 512, CK_BT = CK_ARB + 512, CK_KT = CK_BT + 2048, CK_PL = CK_KT + 2048, CK_V = CK_PL + 256, CK_CAK = CK_V + 2048, CK_CRK = CK_CAK + 2048, CK_BYTES = CK_CRK + 2048;
constexpr int CK_STG = 8 * CK_BYTES;
static_assert(CK_STG + 8 * 2 * CK_IMG <= MISC_OFF, "chunk images exceed LDS");

struct ChunkRaw { unsigned w[16], a[16], b[16], k[16], r[16], v[16];
    __device__ __forceinline__ float fw(int t) const { return bf2f(w[t]); } __device__ __forceinline__ float fa(int t) const { return bf2f(a[t]); } __device__ __forceinline__ float fb(int t) const { return bf2f(b[t]); }
    __device__ __forceinline__ float fk(int t) const { return bf2f(k[t]); } __device__ __forceinline__ float fr(int t) const { return bf2f(r[t]); } __device__ __forceinline__ float fv(int t) const { return bf2f(v[t]); } };
struct ChunkPacked { unsigned p[48];
    __device__ __forceinline__ float g(int base, int t) const { return (t & 1) ? __uint_as_float(p[base + (t >> 1)] & 0xffff0000u) : __uint_as_float(p[base + (t >> 1)] << 16); }
    __device__ __forceinline__ float fw(int t) const { return g(0, t); } __device__ __forceinline__ float fa(int t) const { return g(8, t); } __device__ __forceinline__ float fb(int t) const { return g(16, t); }
    __device__ __forceinline__ float fk(int t) const { return g(24, t); } __device__ __forceinline__ float fr(int t) const { return g(32, t); } __device__ __forceinline__ float fv(int t) const { return g(40, t); } };
__device__ __forceinline__ void rwkv_chunk_load(ChunkRaw& R, const int lane, const bf16_t* SWp, const bf16_t* SXp, const int t0) {
    unsigned off = (unsigned)(t0 * 64 + lane) * 2u; asm volatile("" : "+v"(off));
    const char* wp = (const char*)SWp + off;
    const char* ap = (const char*)SXp + off, *bp = (const char*)(SXp + SARR / 2) + off, *kp = (const char*)(SXp + 2 * (SARR / 2)) + off, *rp = (const char*)(SXp + 3 * (SARR / 2)) + off, *vp = (const char*)(SXp + 4 * (SARR / 2)) + off;
#pragma unroll
    for (int t = 0; t < 16; ++t) { R.w[t] = *(const bf16_t*)(wp + t * 128); R.a[t] = *(const bf16_t*)(ap + t * 128); R.b[t] = *(const bf16_t*)(bp + t * 128); R.k[t] = *(const bf16_t*)(kp + t * 128); R.r[t] = *(const bf16_t*)(rp + t * 128); R.v[t] = *(const bf16_t*)(vp + t * 128); }
}
template <class RAW> __device__ __forceinline__ void rwkv_chunk_prep(const RAW& R, const int lane_, LAS unsigned char* pk, LAS unsigned char* stg) {
    int lane = lane_; asm volatile("" : "+v"(lane));
    const int c = lane, cp = c & 31;
    const int ahb = ((c >> 5) * 4 + ((cp & 15) >> 2)) * 272 + ((cp >> 4) * 4 + (cp & 3)) * 2;
    const int btb = ((c >> 4) * 64 + (c & 15)) * 8;
    float P[16];
    { float run = 0.f;
#pragma unroll
      for (int t = 0; t < 16; ++t) { run += R.fw(t); P[t] = __expf(run); } }
    const float PL = P[15];
    *(LAS float*)(pk + CK_PL + c * 4) = PL;
#pragma unroll
    for (int kg = 0; kg < 4; ++kg) {
        float btv[4], ktv[4], vv[4];
#pragma unroll
        for (int i2 = 0; i2 < 4; i2 += 2) {
            float ah[2], rh[2], bh[2], kh[2];
#pragma unroll
            for (int u = 0; u < 2; ++u) {
                const int i = i2 + u, t = kg * 4 + i;
                const float a = R.fa(t), b = R.fb(t), k = R.fk(t), r = R.fr(t);
                const float Pi = __builtin_amdgcn_rcpf(P[t]), Pm = (t == 0) ? 1.0f : P[t == 0 ? 0 : t - 1], Pe = PL * Pi;
                ah[u] = a * Pm; rh[u] = r * P[t]; bh[u] = b * Pi; kh[u] = k * Pi;
                btv[i] = b * Pe; ktv[i] = k * Pe; vv[i] = R.fv(t);
            }
            const int t = kg * 4 + i2;
            const unsigned pa = pack2(ah[0], ah[1]), pr = pack2(rh[0], rh[1]), pb = pack2(bh[0], bh[1]), pkk = pack2(kh[0], kh[1]);
            *(LAS unsigned short*)(pk + CK_AH + ahb + t * 16) = (unsigned short)pa; *(LAS unsigned short*)(pk + CK_AH + ahb + t * 16 + 16) = (unsigned short)(pa >> 16);
            *(LAS unsigned short*)(pk + CK_RH + ahb + t * 16) = (unsigned short)pr; *(LAS unsigned short*)(pk + CK_RH + ahb + t * 16 + 16) = (unsigned short)(pr >> 16);
            *(LAS unsigned short*)(stg + ahb + t * 16) = (unsigned short)pb; *(LAS unsigned short*)(stg + ahb + t * 16 + 16) = (unsigned short)(pb >> 16);
            *(LAS unsigned short*)(stg + CK_IMG + ahb + t * 16) = (unsigned short)pkk; *(LAS unsigned short*)(stg + CK_IMG + ahb + t * 16 + 16) = (unsigned short)(pkk >> 16);
        }
        u32x2 w0, w1, w2; w0.x = pack2(btv[0], btv[1]); w0.y = pack2(btv[2], btv[3]); w1.x = pack2(ktv[0], ktv[1]); w1.y = pack2(ktv[2], ktv[3]); w2.x = pack2(vv[0], vv[1]); w2.y = pack2(vv[2], vv[3]);
        *(LAS u32x2*)(pk + CK_BT + btb + kg * 128) = w0; *(LAS u32x2*)(pk + CK_KT + btb + kg * 128) = w1; *(LAS u32x2*)(pk + CK_V + btb + kg * 128) = w2;
    }
    asm volatile("s_waitcnt lgkmcnt(0)" ::: "memory");
    const int n = lane & 15, kg4 = (lane >> 4) * 4;
    const f32x4 z4 = (f32x4){0.f, 0.f, 0.f, 0.f};
    f32x4 FN, FNT, FARB, FAAK, FARK;
    { bf16x8 ah[2], rh[2], bh[2], kh[2];
#pragma unroll
      for (int s_ = 0; s_ < 2; ++s_) { const int io = (s_ * 4 + (lane >> 4)) * 272 + (lane & 15) * 16;
          ah[s_] = *(const LAS bf16x8*)(pk + CK_AH + io); rh[s_] = *(const LAS bf16x8*)(pk + CK_RH + io);
          bh[s_] = *(const LAS bf16x8*)(stg + io); kh[s_] = *(const LAS bf16x8*)(stg + CK_IMG + io); }
      FN = z4; FNT = z4; FARB = z4; FAAK = z4; FARK = z4;
#pragma unroll
      for (int s_ = 0; s_ < 2; ++s_) {
          FN   = __builtin_amdgcn_mfma_f32_16x16x32_bf16(ah[s_], bh[s_], FN, 0, 0, 0);
          FNT  = __builtin_amdgcn_mfma_f32_16x16x32_bf16(bh[s_], ah[s_], FNT, 0, 0, 0);
          FARB = __builtin_amdgcn_mfma_f32_16x16x32_bf16(bh[s_], rh[s_], FARB, 0, 0, 0);
          FAAK = __builtin_amdgcn_mfma_f32_16x16x32_bf16(kh[s_], ah[s_], FAAK, 0, 0, 0);
          FARK = __builtin_amdgcn_mfma_f32_16x16x32_bf16(kh[s_], rh[s_], FARK, 0, 0, 0);
      } }
    f32x4 ID;
#pragma unroll
    for (int i = 0; i < 4; ++i) {
        const int m = kg4 + i;
        FN[i] = (n < m) ? FN[i] : 0.f;
        FNT[i] = (m < n) ? FNT[i] : 0.f; FAAK[i] = (m < n) ? FAAK[i] : 0.f;
        FARB[i] = (m <= n) ? FARB[i] : 0.f; FARK[i] = (m <= n) ? FARK[i] : 0.f;
        ID[i] = (m == n) ? 1.0f : 0.f;
    }
#define MMB(fat, fb, c) __builtin_amdgcn_mfma_f32_16x16x16bf16_1k(fat, fb, c, 0, 0, 0)
    const bf16x4 bN = cvt4(FN), bNT = cvt4(FNT);
    const f32x4 FN2 = MMB(bNT, bN, z4), FN2T = MMB(bN, bNT, z4);
    const bf16x4 bN2 = cvt4(FN2), bN2T = cvt4(FN2T);
    const f32x4 FN4 = MMB(bN2T, bN2, z4), FN4T = MMB(bN2, bN2T, z4);
    const bf16x4 bN4 = cvt4(FN4), bN4T = cvt4(FN4T);
    const f32x4 FN8T = MMB(bN4, bN4T, z4);
    const f32x4 FQ1 = ID + FNT, FQ1T = ID + FN;
    const bf16x4 bQ1 = cvt4(FQ1), bQ1T = cvt4(FQ1T);
    const f32x4 FQ2 = MMB(bQ1T, bN2T, FQ1), FQ2T = MMB(bQ1, bN2, FQ1T);
    const f32x4 FQ3 = MMB(cvt4(FQ2T), bN4T, FQ2), FQ3T = MMB(cvt4(FQ2), bN4, FQ2T);
    const f32x4 FTT = MMB(cvt4(FQ3T), cvt4(FN8T), FQ3);
#undef MMB
    *(LAS bf16x4*)(pk + CK_T + lane * 8) = cvt4(FTT);
    *(LAS bf16x4*)(pk + CK_ARB + lane * 8) = cvt4(FARB);
    const bf16x4 aak = cvt4(FAAK), ark = cvt4(FARK);
#pragma unroll
    for (int q = 0; q < 4; ++q) {
        const bf16x4 vq = *(const LAS bf16x4*)(pk + CK_V + (q * 64 + lane) * 8);
        const f32x4 cak = __builtin_amdgcn_mfma_f32_16x16x16bf16_1k(aak, vq, z4, 0, 0, 0), crk = __builtin_amdgcn_mfma_f32_16x16x16bf16_1k(ark, vq, z4, 0, 0, 0);
        *(LAS bf16x4*)(pk + CK_CAK + (q * 64 + lane) * 8) = cvt4(cak); *(LAS bf16x4*)(pk + CK_CRK + (q * 64 + lane) * 8) = cvt4(crk);
    }
}

struct ChunkEarly { bf16x8 ah0, ah1, rh0, rh1; bf16x4 top; u32x2 cak; };
struct ChunkLate { bf16x4 arb, vop, bt[4], kt[4]; f32x4 pl[4]; u32x2 crk; };
__device__ __forceinline__ void rwkv_chunk_early(ChunkEarly& O, const LAS unsigned char* pk, const int q, const int lane) {
    const int io = (lane >> 4) * 272 + (lane & 15) * 16;
    O.ah0 = *(const LAS bf16x8*)(pk + CK_AH + io); O.ah1 = *(const LAS bf16x8*)(pk + CK_AH + io + 4 * 272);
    O.rh0 = *(const LAS bf16x8*)(pk + CK_RH + io); O.rh1 = *(const LAS bf16x8*)(pk + CK_RH + io + 4 * 272);
    O.cak = *(const LAS u32x2*)(pk + CK_CAK + (q * 64 + lane) * 8); O.top = *(const LAS bf16x4*)(pk + CK_T + lane * 8);
}
__device__ __forceinline__ void rwkv_chunk_late(ChunkLate& O, const LAS unsigned char* pk, const int q, const int lane) {
    O.arb = *(const LAS bf16x4*)(pk + CK_ARB + lane * 8); O.vop = *(const LAS bf16x4*)(pk + CK_V + (q * 64 + lane) * 8);
    O.crk = *(const LAS u32x2*)(pk + CK_CRK + (q * 64 + lane) * 8);
#pragma unroll
    for (int mt = 0; mt < 4; ++mt) { O.pl[mt] = *(const LAS f32x4*)(pk + CK_PL + (mt * 16 + (lane >> 4) * 4) * 4);
        O.bt[mt] = *(const LAS bf16x4*)(pk + CK_BT + (mt * 64 + lane) * 8); O.kt[mt] = *(const LAS bf16x4*)(pk + CK_KT + (mt * 64 + lane) * 8); }
}

struct FlushOps { u32x4 v0, v1, g0, g1; float bn; };
__device__ __forceinline__ void rwkv_flush_load(FlushOps& O, const int lane, const bf16_t* SVp, const bf16_t* Gp, const float* BON, const int tok0, const int t0, const int h) {
    int ln = lane; asm volatile("" : "+v"(ln));
    const int t = t0 + (ln >> 2), q = ln & 3;
    unsigned ov = (unsigned)(t * 64 + q * 16) * 2u, og = (unsigned)((tok0 + t) * RW + h * 64 + q * 16) * 2u;
    asm volatile("" : "+v"(ov), "+v"(og));
    O.v0 = *(const u32x4*)((const char*)SVp + ov); O.v1 = *(const u32x4*)((const char*)SVp + ov + 16);
    O.g0 = *(const u32x4*)((const char*)Gp + og); O.g1 = *(const u32x4*)((const char*)Gp + og + 16);
    O.bn = *(const float*)((const char*)BON + (ov >> 5 & ~3u));
}

__device__ __forceinline__ void rwkv_chunk_pack(ChunkPacked& Q, const ChunkRaw& R) {
#pragma unroll
    for (int i = 0; i < 8; ++i) { Q.p[i] = R.w[2 * i] | (R.w[2 * i + 1] << 16); Q.p[8 + i] = R.a[2 * i] | (R.a[2 * i + 1] << 16); Q.p[16 + i] = R.b[2 * i] | (R.b[2 * i + 1] << 16);
                                  Q.p[24 + i] = R.k[2 * i] | (R.k[2 * i + 1] << 16); Q.p[32 + i] = R.r[2 * i] | (R.r[2 * i + 1] << 16); Q.p[40 + i] = R.v[2 * i] | (R.v[2 * i + 1] << 16); }
}
__device__ __forceinline__ void rwkv_flush_undef(FlushOps& O) {
    asm volatile("" : "=v"(O.v0.x), "=v"(O.v0.y), "=v"(O.v0.z), "=v"(O.v0.w), "=v"(O.v1.x), "=v"(O.v1.y), "=v"(O.v1.z), "=v"(O.v1.w));
    asm volatile("" : "=v"(O.g0.x), "=v"(O.g0.y), "=v"(O.g0.z), "=v"(O.g0.w), "=v"(O.g1.x), "=v"(O.g1.y), "=v"(O.g1.z), "=v"(O.g1.w), "=v"(O.bn));
}
__device__ __forceinline__ void rwkv_flush(const FlushOps& O, const int lane, const LAS unsigned char* ytile, const LAS float* LWT, bf16_t* MXh, const int row0) {
    int ln = lane; asm volatile("" : "+v"(ln));
    const int t = ln >> 2, q = ln & 3;
    const LAS unsigned char* yp = ytile + q * 512 + t * 32;
    const u32x4 ya = *(const LAS u32x4*)yp, yb = *(const LAS u32x4*)(yp + 16);
    const unsigned yw[8] = {ya.x, ya.y, ya.z, ya.w, yb.x, yb.y, yb.z, yb.w};
    float s1 = 0.f, s2 = 0.f;
#pragma unroll
    for (int j = 0; j < 8; ++j) { const float lo = __uint_as_float(yw[j] << 16), hi = __uint_as_float(yw[j] & 0xffff0000u); s1 += lo + hi; s2 += lo * lo + hi * hi; }
    s1 += dpp_mov<0xB1>(s1); s2 += dpp_mov<0xB1>(s2); s1 += dpp_mov<0x4E>(s1); s2 += dpp_mov<0x4E>(s2);
    const float mean = s1 * (1.0f / 64.0f), var = fmaxf(s2 * (1.0f / 64.0f) - mean * mean, 0.f), rstd = rsqrtf(var + 64e-5f);
    const unsigned vw[8] = {O.v0.x, O.v0.y, O.v0.z, O.v0.w, O.v1.x, O.v1.y, O.v1.z, O.v1.w}, gw[8] = {O.g0.x, O.g0.y, O.g0.z, O.g0.w, O.g1.x, O.g1.y, O.g1.z, O.g1.w};
    unsigned ow[8];
#pragma unroll
    for (int k = 0; k < 4; ++k) { const f32x4 lw = *(const LAS f32x4*)(LWT + q * 16 + k * 4), lb = *(const LAS f32x4*)(LWT + 64 + q * 16 + k * 4);
#pragma unroll
        for (int e = 0; e < 2; ++e) { const int j = k * 2 + e;
            const float ylo = __uint_as_float(yw[j] << 16), yhi = __uint_as_float(yw[j] & 0xffff0000u), vlo = __uint_as_float(vw[j] << 16), vhi = __uint_as_float(vw[j] & 0xffff0000u), glo = __uint_as_float(gw[j] << 16), ghi = __uint_as_float(gw[j] & 0xffff0000u);
            ow[j] = pack2(((ylo - mean) * rstd * lw[2 * e] + lb[2 * e] + O.bn * vlo) * glo, ((yhi - mean) * rstd * lw[2 * e + 1] + lb[2 * e + 1] + O.bn * vhi) * ghi); }
        __builtin_amdgcn_sched_barrier(0); }
    u32x4 w0, w1; w0.x = ow[0]; w0.y = ow[1]; w0.z = ow[2]; w0.w = ow[3]; w1.x = ow[4]; w1.y = ow[5]; w1.z = ow[6]; w1.w = ow[7];
    unsigned om = (unsigned)(row0 + t) * (D * 2) + q * 32; asm volatile("" : "+v"(om));
    *(u32x4*)((char*)MXh + om) = w0; *(u32x4*)((char*)MXh + om + 16) = w1;
}

__device__ __forceinline__ void rwkv_chunk_block(Frame& F, int bh, int l) {
    const PP p = F.p; const int lane = F.lane, w = F.wave;
    const int b = bh / RH, h = bh % RH;
    const size_t base = (size_t)bh * SEQ * 64;
    const bf16_t* SWp = (const bf16_t*)(F.ws + WS_SW) + base;
    const bf16_t* SXp = (const bf16_t*)(F.ws + WS_SX) + base;
    const bf16_t* SVp = SXp + 4 * (SARR / 2); const bf16_t* Gp = (const bf16_t*)(F.ws + WS_G); const float* BON = (const float*)(F.ws + WS_BON) + (size_t)bh * SEQ;
    bf16_t* MXh = (bf16_t*)(F.ws + WS_H) + (size_t)b * SEQ * D + h * 64;
    LAS float* LWT = (LAS float*)(F.lds + MISC_OFF + 512);
    if (F.tid < 64) { LWT[F.tid] = p->rwkv_lnx_w[(size_t)l * RW + h * 64 + F.tid]; LWT[64 + F.tid] = p->rwkv_lnx_b[(size_t)l * RW + h * 64 + F.tid]; }
    f32x4 Sacc[4];
#pragma unroll
    for (int mt = 0; mt < 4; ++mt) Sacc[mt] = (f32x4){0.f, 0.f, 0.f, 0.f};
    const f32x4 z4 = (f32x4){0.f, 0.f, 0.f, 0.f};
    ChunkRaw R; rwkv_chunk_load(R, lane, SWp, SXp, w * 16);
    if (w < 4) {
#pragma unroll 1
        for (int grp = 0; grp < SEQ / 128; ++grp) {
#pragma unroll
            for (int t = 0; t < 16; ++t) asm volatile("" : "+v"(R.v[t]));
            __syncthreads();
            rwkv_chunk_prep(R, lane, F.lds + w * CK_BYTES, F.lds + CK_STG + w * 2 * CK_IMG);
            if (grp + 1 < SEQ / 128) rwkv_chunk_load(R, lane, SWp, SXp, (grp + 1) * 128 + w * 16);
            LDS_BAR();
            ChunkEarly C; rwkv_chunk_early(C, F.lds, w, lane);
#pragma unroll 1
            for (int g = 0; g < 8; ++g) {
                ChunkLate Lt; rwkv_chunk_late(Lt, F.lds + g * CK_BYTES, w, lane);
                ChunkEarly N = C;
                if (g + 1 < 8) rwkv_chunk_early(N, F.lds + (g + 1) * CK_BYTES, w, lane);
                const bf16x8 s0 = cvt8(Sacc[0], Sacc[1]), s1 = cvt8(Sacc[2], Sacc[3]);
                f32x4 W1 = __builtin_amdgcn_mfma_f32_16x16x32_bf16(C.ah0, s0, z4, 0, 0, 0); W1 = __builtin_amdgcn_mfma_f32_16x16x32_bf16(C.ah1, s1, W1, 0, 0, 0);
                f32x4 Y = __builtin_amdgcn_mfma_f32_16x16x32_bf16(C.rh0, s0, z4, 0, 0, 0); Y = __builtin_amdgcn_mfma_f32_16x16x32_bf16(C.rh1, s1, Y, 0, 0, 0);
                W1[0] += bf2f(C.cak.x & 0xffffu); W1[1] += __uint_as_float(C.cak.x & 0xffff0000u); W1[2] += bf2f(C.cak.y & 0xffffu); W1[3] += __uint_as_float(C.cak.y & 0xffff0000u);
                const f32x4 U = __builtin_amdgcn_mfma_f32_16x16x16bf16_1k(C.top, cvt4(W1), z4, 0, 0, 0);
                const bf16x4 uop = cvt4(U);
#pragma unroll
                for (int mt = 0; mt < 4; ++mt) {
                    f32x4 a_;
#pragma unroll
                    for (int i = 0; i < 4; ++i) { float v_ = Sacc[mt][i] * Lt.pl[mt][i]; asm volatile("" : "+v"(v_)); a_[i] = v_; }
                    a_ = __builtin_amdgcn_mfma_f32_16x16x16bf16_1k(Lt.kt[mt], Lt.vop, a_, 0, 0, 0);
                    a_ = __builtin_amdgcn_mfma_f32_16x16x16bf16_1k(Lt.bt[mt], uop, a_, 0, 0, 0);
                    Sacc[mt] = a_;
                }
                Y = __builtin_amdgcn_mfma_f32_16x16x16bf16_1k(Lt.arb, uop, Y, 0, 0, 0);
                Y[0] += bf2f(Lt.crk.x & 0xffffu); Y[1] += __uint_as_float(Lt.crk.x & 0xffff0000u); Y[2] += bf2f(Lt.crk.y & 0xffffu); Y[3] += __uint_as_float(Lt.crk.y & 0xffff0000u);
                {
                    LAS unsigned char* yt = F.lds + CK_STG + (4 + (g & 3)) * 2 * CK_IMG + (g >> 2) * 2048 + w * 512 + ((lane >> 4) * 4) * 32 + (lane & 15) * 2;
#pragma unroll
                    for (int i = 0; i < 4; ++i) *(LAS unsigned short*)(yt + i * 32) = (unsigned short)f2bf(Y[i]); }
                C = N;
            }
            LDS_BAR();
        }
    } else {
        FlushOps FO0, FO1; LAS unsigned char* myst = F.lds + CK_STG + w * 2 * CK_IMG;
        ChunkPacked Q; rwkv_chunk_pack(Q, R);
#pragma unroll 1
        for (int grp = 0; grp < SEQ / 128; ++grp) {
#pragma unroll
            for (int i = 0; i < 48; ++i) asm volatile("" : "+v"(Q.p[i]));
            if (grp > 0) { rwkv_flush(FO0, lane, myst, LWT, MXh, (grp - 1) * 128 + (w - 4) * 16); rwkv_flush(FO1, lane, myst + 2048, LWT, MXh, (grp - 1) * 128 + w * 16); __builtin_amdgcn_sched_barrier(0); }
            __syncthreads();
            rwkv_chunk_prep(Q, lane, F.lds + w * CK_BYTES, myst);
            LDS_BAR();
            rwkv_flush_load(FO0, lane, SVp, Gp, BON, b * SEQ, grp * 128 + (w - 4) * 16, h); rwkv_flush_load(FO1, lane, SVp, Gp, BON, b * SEQ, grp * 128 + w * 16, h);
            if (grp + 1 < SEQ / 128) { ChunkRaw Rn; rwkv_chunk_load(Rn, lane, SWp, SXp, (grp + 1) * 128 + w * 16); rwkv_chunk_pack(Q, Rn); }
            LDS_BAR();
        }
        rwkv_flush(FO0, lane, myst, LWT, MXh, (SEQ / 128 - 1) * 128 + (w - 4) * 16); rwkv_flush(FO1, lane, myst + 2048, LWT, MXh, (SEQ / 128 - 1) * 128 + w * 16);
    }
}
__device__ __forceinline__ void phase_rwkv_post(Frame& F, int l) {
    const PP p = F.p; const int lane = F.lane;
    const float* YS = (const float*)(F.ws + WS_YS); const bf16_t* SKp = (const bf16_t*)(F.ws + WS_SX) + 2 * (SARR / 2); const bf16_t* SRp = SKp + SARR / 2; const bf16_t* SVp = SRp + SARR / 2;
    const bf16_t* Gp = (const bf16_t*)(F.ws + WS_G); bf16_t* MX = (bf16_t*)(F.ws + WS_H);
    const float* BON = (const float*)(F.ws + WS_BON);
    float lw[6], lb[6];
#pragma unroll
    for (int h = 0; h < 6; ++h) { lw[h] = p->rwkv_lnx_w[(size_t)l * RW + h * 64 + lane]; lb[h] = p->rwkv_lnx_b[(size_t)l * RW + h * 64 + lane]; }
#pragma unroll 1
    for (int tok0 = (F.bid * 8 + F.wave) * 2; tok0 < NTOK; tok0 += F.G * 8 * 2) {
        float y[12], bn[12], v[12], g[12];
#pragma unroll
        for (int q = 0; q < 12; ++q) {
            const int tok = tok0 + q / 6, h = q % 6, b = tok / SEQ, t = tok % SEQ, ch = h * 64 + lane;
            const size_t so = (((size_t)b * RH + h) * SEQ + t) * 64 + lane;
            y[q] = YS[(size_t)tok * RW + ch]; bn[q] = BON[((size_t)b * RH + h) * SEQ + t]; v[q] = bf2f(SVp[so]); g[q] = bf2f(Gp[(size_t)tok * RW + ch]);
        }
#pragma unroll
        for (int q = 0; q < 12; ++q) {
            const int tok = tok0 + q / 6, h = q % 6;
            float s1 = y[q], s2 = y[q] * y[q];
            s1 += dpp_ror<8>(s1); s2 += dpp_ror<8>(s2); s1 += dpp_ror<4>(s1); s2 += dpp_ror<4>(s2); s1 += dpp_ror<2>(s1); s2 += dpp_ror<2>(s2); s1 += dpp_ror<1>(s1); s2 += dpp_ror<1>(s2);
            s1 += shx(s1, 16, lane); s2 += shx(s2, 16, lane); s1 += shx(s1, 32, lane); s2 += shx(s2, 32, lane);
            const float mean = s1 * (1.0f / 64.0f); const float d = y[q] - mean; const float var = fmaxf(s2 * (1.0f / 64.0f) - mean * mean, 0.f);
            const float yn = d * rsqrtf(var + 64e-5f) * lw[h] + lb[h];
            const float bonus = bn[q] * v[q];
            MX[(size_t)tok * D + h * 64 + lane] = (bf16_t)f2bf((yn + bonus) * g[q]);
        }
    }
}

__device__ __forceinline__ void phase_norm2_router(Frame& F, int l, bool count) {
    const PP p = F.p; const int tid = F.tid, lane = F.lane, w = F.wave, fr = lane & 15, fq = lane >> 4;
    const bf16_t* XBp = (const bf16_t*)(F.ws + WS_XB); unsigned char* H8 = F.ws + WS_H8;
    const float* mod_l = (const float*)(F.ws + WS_MOD) + (size_t)l * 16 * 6144;
    if (F.bid == 0 && tid < 64) *(u32x4*)(H8 + (size_t)NTOK * D + tid * 16) = (u32x4){0u, 0u, 0u, 0u};
    constexpr int HS = 1032;
    LAS bf16_t* HI = (LAS bf16_t*)F.lds;
    LAS bf16_t* LO = (LAS bf16_t*)(F.lds + 66048);
    LAS float* PART = (LAS float*)F.lds;
    LAS float* LG = (LAS float*)(F.lds + 132096);
    LAS unsigned* HIST = (LAS unsigned*)(F.lds + 132096 + 8192);
    LAS float* TA = (LAS float*)(F.lds + 132096 + 8192 + 256);
    LAS float* TB = TA + 1024;
#define STAGE_MOD2(tile_) do { if (tid < 256 && (tile_) < 1024) { const int b_ = ((tile_) * 32) / SEQ, c_ = tid * 4; \
        const f32x4 gg = *(const f32x4*)(p->norm2_g + (size_t)l * D + c_), sc = *(const f32x4*)(mod_l + (size_t)b_ * 6144 + 4096 + c_), sh = *(const f32x4*)(mod_l + (size_t)b_ * 6144 + 3072 + c_); \
        *(LAS f32x4*)(TA + c_) = (f32x4){gg[0] * (1.0f + sc[0]), gg[1] * (1.0f + sc[1]), gg[2] * (1.0f + sc[2]), gg[3] * (1.0f + sc[3])}; *(LAS f32x4*)(TB + c_) = sh; } } while (0)
    bf16x8 bh[4][4], bl[4][4];
    { const bf16_t* WH = (const bf16_t*)(F.ws + WS_WRT) + (size_t)l * 2 * 64 * 1024, *WL = WH + 64 * 1024;
#pragma unroll
      for (int nt = 0; nt < 4; ++nt)
#pragma unroll
          for (int ks = 0; ks < 4; ++ks) { bh[nt][ks] = *(const bf16x8*)(WH + (size_t)(nt * 16 + fr) * 1024 + w * 128 + ks * 32 + fq * 8); bl[nt][ks] = *(const bf16x8*)(WL + (size_t)(nt * 16 + fr) * 1024 + w * 128 + ks * 32 + fq * 8); } }
    const float bias = p->router_bias[(size_t)l * NE + lane];
    STAGE_MOD2(F.bid);
    __syncthreads();
#pragma unroll 1
    for (int tile = F.bid; tile < 1024; tile += F.G) {
        const int row0 = tile * 32;
        GPTR wsg_ = (GPTR)F.ws; asm volatile("" : "+s"(wsg_)); unsigned char* wsl = (unsigned char*)wsg_;
        if (tid < 64) HIST[tid] = 0u;
#pragma unroll 1
        for (int qq = 0; qq < 4; qq += 2) {
            u32x2 xr[2][4];
#pragma unroll
            for (int q = 0; q < 2; ++q)
#pragma unroll
                for (int u = 0; u < 4; ++u) xr[q][u] = *(const u32x2*)(XBp + (size_t)(row0 + w * 4 + qq + q) * D + u * 256 + lane * 4);
#pragma unroll
            for (int q = 0; q < 2; ++q) {
                const int i = w * 4 + qq + q, row = row0 + i; float ss = 0.f;
#pragma unroll
                for (int u = 0; u < 4; ++u) { const float x0 = bf2f(xr[q][u].x & 0xffffu), x1 = __uint_as_float(xr[q][u].x & 0xffff0000u), x2 = bf2f(xr[q][u].y & 0xffffu), x3 = __uint_as_float(xr[q][u].y & 0xffff0000u); ss += x0 * x0 + x1 * x1 + x2 * x2 + x3 * x3; }
                ss = wave_sum(ss, lane); const float rstd = rsqrtf(ss * (1.0f / D) + 1e-6f);
#pragma unroll
                for (int u = 0; u < 4; ++u) { const int c0 = u * 256 + lane * 4; const f32x4 ta = *(const LAS f32x4*)(TA + c0), tb = *(const LAS f32x4*)(TB + c0);
                    const float xq[4] = {bf2f(xr[q][u].x & 0xffffu), __uint_as_float(xr[q][u].x & 0xffff0000u), bf2f(xr[q][u].y & 0xffffu), __uint_as_float(xr[q][u].y & 0xffff0000u)};
                    float o[4], lo[4]; unsigned hb[4];
#pragma unroll
                    for (int j = 0; j < 4; ++j) { o[j] = xq[j] * rstd * ta[j] + tb[j]; hb[j] = f2bf(o[j]); lo[j] = o[j] - bf2f(hb[j]); }
                    u32x2 wh; wh.x = hb[0] | (hb[1] << 16); wh.y = hb[2] | (hb[3] << 16); *(LAS u32x2*)(HI + i * HS + c0) = wh;
                    *(unsigned*)(H8 + (size_t)row * D + c0) = pack4f8(__builtin_amdgcn_fmed3f(o[0] * H8S, -448.0f, 448.0f), __builtin_amdgcn_fmed3f(o[1] * H8S, -448.0f, 448.0f), __builtin_amdgcn_fmed3f(o[2] * H8S, -448.0f, 448.0f), __builtin_amdgcn_fmed3f(o[3] * H8S, -448.0f, 448.0f));
                    u32x2 wl; wl.x = pack2(lo[0], lo[1]); wl.y = pack2(lo[2], lo[3]); *(LAS u32x2*)(LO + i * HS + c0) = wl; }
            }
        }
        __syncthreads();
        f32x4 acc[2][4];
#pragma unroll
        for (int mt = 0; mt < 2; ++mt) {
#pragma unroll
            for (int nt = 0; nt < 4; ++nt) acc[mt][nt] = (f32x4){0.f, 0.f, 0.f, 0.f};
#pragma unroll
            for (int ks = 0; ks < 4; ++ks) {
                const bf16x8 ah = *(const LAS bf16x8*)(HI + (mt * 16 + fr) * HS + w * 128 + ks * 32 + fq * 8), al = *(const LAS bf16x8*)(LO + (mt * 16 + fr) * HS + w * 128 + ks * 32 + fq * 8);
#pragma unroll
                for (int nt = 0; nt < 4; ++nt) {
                    acc[mt][nt] = __builtin_amdgcn_mfma_f32_16x16x32_bf16(ah, bh[nt][ks], acc[mt][nt], 0, 0, 0);
                    acc[mt][nt] = __builtin_amdgcn_mfma_f32_16x16x32_bf16(al, bh[nt][ks], acc[mt][nt], 0, 0, 0);
                    acc[mt][nt] = __builtin_amdgcn_mfma_f32_16x16x32_bf16(ah, bl[nt][ks], acc[mt][nt], 0, 0, 0);
                }
            }
        }
        __syncthreads();
#pragma unroll
        for (int mt = 0; mt < 2; ++mt)
#pragma unroll
            for (int nt = 0; nt < 4; ++nt)
#pragma unroll
                for (int r = 0; r < 4; ++r) PART[(w * 32 + mt * 16 + fq * 4 + r) * 64 + nt * 16 + fr] = acc[mt][nt][r];
        __syncthreads();
        for (int o = tid; o < 32 * 64; o += NTHREADS) { float sacc = 0.f;
#pragma unroll
            for (int q = 0; q < 8; ++q) sacc += PART[q * 2048 + o];
            LG[o] = sacc; }
        __syncthreads();
        {
            const int g = lane >> 3;
#pragma unroll 1
            for (int q = 0; q < 4; ++q) {
                const int i = w * 4 + q, row = row0 + i;
                const float sc = sigmoidf_(LG[i * 64 + lane]), c = sc + bias;
                const float m1 = gmax8(c);
                const unsigned long long eqm = __ballot(c == m1);
                const unsigned byte = (unsigned)(eqm >> (g * 8)) & 0xffu;
                const int first = __builtin_ctz(byte | 0x100u);
                const float c2 = ((lane & 7) == first) ? -INFINITY : c;
                const float gs = m1 + gmax8(c2);
                int rg = 0;
#pragma unroll
                for (int g2 = 0; g2 < 8; ++g2) { const float sg = __builtin_bit_cast(float, __builtin_amdgcn_readlane(__builtin_bit_cast(int, gs), g2 * 8)); rg += ((sg > gs) || (sg == gs && g2 < g)) ? 1 : 0; }
                const bool elig = rg < 4;
                unsigned u = __float_as_uint(c); u = (u & 0x80000000u) ? ~u : (u | 0x80000000u); u = (u & ~63u) | (unsigned)(63 - lane);
                const unsigned key = elig ? u : 0u;
                int rk = 0;
#pragma unroll
                for (int j = 0; j < 64; ++j) { const unsigned kj = (unsigned)__builtin_amdgcn_readlane((int)key, j); rk += (kj > key) ? 1 : 0; }
                const bool sel = elig && rk < 8;
                const float wsum = wave_sum(sel ? sc : 0.f, lane);
                if (sel) { ((int*)(wsl + WS_TOPI))[(size_t)row * 8 + rk] = lane; ((float*)(wsl + WS_TOPW))[(size_t)row * 8 + rk] = sc * 2.5f / wsum;
                    __hip_atomic_fetch_add(&HIST[lane], 1u, __ATOMIC_RELAXED, __HIP_MEMORY_SCOPE_WORKGROUP); }
            }
        }
        __syncthreads();
        if (tid < 64) { const unsigned c = HIST[tid]; ((unsigned*)(wsl + WS_TILECNT))[(size_t)tile * 64 + tid] = c;
            if (c && count) atomicAdd((unsigned*)(wsl + WS_CTL + CTL_TOTALS) + ((size_t)l * 2 + (tile >> 9)) * 64 + tid, c); }
        STAGE_MOD2(tile + F.G);
        __syncthreads();
    }
#undef STAGE_MOD2
}

__device__ __forceinline__ void expert_convert_wave(Frame& F, int l, int j) {
    const PP p = F.p; LAS float* T = (LAS float*)(F.lds + F.wave * 16640);
    const int e = j / 192, r = j % 192, kind = r / 64, q = r % 64;
    unsigned char* WGU = F.ws + WS_WGU + (size_t)e * 512 * 1024; unsigned char* WD = F.ws + WS_WD + (size_t)e * 1024 * 256;
    if (kind < 2) {
        const float* src = (e < 64) ? ((kind == 0 ? p->we_gate : p->we_up) + ((size_t)l * NE + e) * 1024 * 256) : ((kind == 0 ? p->ws_gate : p->ws_up) + (size_t)l * 1024 * 256);
        const int kt = q >> 2, ntile = q & 3, n0 = ntile * 64, drow = (n0 >> 7) * 256 + (n0 & 127) + kind * 128;
        tr_tile_wave8(F.lane, T, src + (size_t)kt * 64 * 256 + n0, 256, WGU + (size_t)drow * 1024 + kt * 64, 1024, WG8S);
    } else {
        const float* src = (e < 64) ? (p->we_down + ((size_t)l * NE + e) * 256 * 1024) : (p->ws_down + (size_t)l * 256 * 1024);
        const int kt = q >> 4, ntile = q & 15;
        tr_tile_wave8(F.lane, T, src + (size_t)kt * 64 * 1024 + ntile * 64, 1024, WD + (size_t)ntile * 64 * 256 + kt * 64, 256, WD8S);
    }
}

__device__ __forceinline__ void convert_queue(Frame& F, int l, int qi) {
    volatile LAS int* slot = (volatile LAS int*)(F.lds + MISC_OFF + 64);
    unsigned* ctr = (unsigned*)(F.ws + WS_CTL + CTL_QUEUE) + qi * 64;
#pragma unroll 1
    for (;;) {
        __syncthreads();
        if (F.tid == 0) *slot = (int)atomicAdd(ctr, 1u);
        __syncthreads();
        const int item = *slot;
        if (item >= 65 * 192 / 8) break;
        expert_convert_wave(F, l, item * 8 + F.wave);
    }
}

__device__ __forceinline__ void phase_route(Frame& F, int l) {
    const int tid = F.tid;
    LAS int* PST = (LAS int*)F.lds;
    LAS int* PEN = PST + 128;
    LAS int* CNT = PST + 256;
    LAS unsigned* PART = (LAS unsigned*)(PST + 384);
    LAS unsigned* BASE = PART + 512;
    LAS unsigned* LCNT = BASE + 64;
    const unsigned* totals = (const unsigned*)(F.ws + WS_CTL + CTL_TOTALS) + (size_t)l * 2 * 64;
    if (tid < 128) CNT[tid] = (int)ld_u32_agent(totals + tid);
    __syncthreads();
    if (tid < 2) { int run = 0; for (int e = 0; e < 64; ++e) { const int c = CNT[tid * 64 + e]; PST[tid * 64 + e] = run; run += (c + 255) & ~255; PEN[tid * 64 + e] = run; } }
    __syncthreads();
    if (F.bid == 0 && tid < 128) ((int*)(F.ws + WS_PADEND))[tid] = PEN[tid];
    if (F.bid == 0) for (int t = tid; t < 2 * 576; t += NTHREADS) { const int hf2 = t / 576, rt = t % 576; int e = 0; while (e < 63 && rt * 256 >= PEN[hf2 * 64 + e]) ++e; ((int*)(F.ws + WS_TILEE))[t] = e; }
    const unsigned* tc = (const unsigned*)(F.ws + WS_TILECNT);
    int* rowtok = (int*)(F.ws + WS_ROWTOK); float* roww = (float*)(F.ws + WS_ROWW); int* rowdst = (int*)(F.ws + WS_ROWDST);
    for (int tb = F.bid * 4; tb < 1024; tb += F.G * 4) {
        const int hf = tb >> 9, e = tid & 63, part = tid >> 6; unsigned s = 0;
        int exv[4]; float wvv[4];
        if (tid < 256) {
#pragma unroll
            for (int j = 0; j < 4; ++j) { const int tok = (tb + j) * 32 + (tid >> 3); exv[j] = ((const int*)(F.ws + WS_TOPI))[(size_t)tok * 8 + (tid & 7)]; wvv[j] = ((const float*)(F.ws + WS_TOPW))[(size_t)tok * 8 + (tid & 7)]; }
        }
        for (int t2 = hf * 512 + part; t2 < tb; t2 += 8) s += tc[(size_t)t2 * 64 + e];
        PART[part * 64 + e] = s;
        __syncthreads();
        if (tid < 64) { unsigned b = (unsigned)PST[hf * 64 + tid];
#pragma unroll
            for (int q = 0; q < 8; ++q) b += PART[q * 64 + tid];
            BASE[tid] = b; LCNT[tid] = 0u; }
        __syncthreads();
#pragma unroll
        for (int j = 0; j < 4; ++j) {
            if (tid < 256) { const int i = tid >> 3, k = tid & 7, tok = (tb + j) * 32 + i; const int ex = exv[j];
                const unsigned r = __hip_atomic_fetch_add(&LCNT[ex], 1u, __ATOMIC_RELAXED, __HIP_MEMORY_SCOPE_WORKGROUP); const size_t pos = (size_t)hf * PMAXH + BASE[ex] + r;
                rowtok[pos] = tok; roww[pos] = wvv[j]; rowdst[pos] = (tok - hf * HT) * 9 + k; }
            __syncthreads();
            if (tid < 64) { BASE[tid] += LCNT[tid]; LCNT[tid] = 0u; }
            __syncthreads();
        }
    }
    if (F.bid < 128) { const int hf = F.bid >> 6, e = F.bid & 63; const int s = PST[hf * 64 + e] + CNT[hf * 64 + e], en = PEN[hf * 64 + e];
        for (int pos = s + tid; pos < en; pos += NTHREADS) { rowtok[(size_t)hf * PMAXH + pos] = NTOK; roww[(size_t)hf * PMAXH + pos] = 0.f; rowdst[(size_t)hf * PMAXH + pos] = -1; } }
    __syncthreads();
}

__device__ __forceinline__ int load_padend(Frame& F, int hf) {
    LAS int* pe = (LAS int*)(F.lds + MISC_OFF + 256);
    __syncthreads();
    if (F.tid < 64) pe[F.tid] = (int)ld_u32_agent((const unsigned*)(F.ws + WS_PADEND) + hf * 64 + F.tid);
    { LAS int* te = (LAS int*)(F.lds + TILEE_OFF); for (int t = F.tid; t < 576; t += NTHREADS) te[t] = (int)ld_u32_agent((const unsigned*)(F.ws + WS_TILEE) + hf * 576 + t); }
    __syncthreads();
    return __builtin_amdgcn_readfirstlane(pe[63]) >> 8;
}
constexpr int ROWMETA_OFF = 131072;
__device__ __forceinline__ void run_gu(Frame& F, int hf) {
    const int ntr = load_padend(F, hf);
    LAS int* ltok = (LAS int*)(F.lds + ROWMETA_OFF); LAS float* lw = (LAS float*)(F.lds + ROWMETA_OFF + 8 * 1024);
    { const int* rowtok = (const int*)(F.ws + WS_ROWTOK) + (size_t)hf * PMAXH; const float* roww = (const float*)(F.ws + WS_ROWW) + (size_t)hf * PMAXH;
      for (int i = 0; i < 8; ++i) { const int uu = F.bid + i * F.G; if (uu >= (ntr + 64) * 2) break; const int rt = uu >> 1;
          if (rt < ntr && F.tid < 256) { ltok[i * 256 + F.tid] = rowtok[rt * 256 + F.tid]; lw[i * 256 + F.tid] = roww[rt * 256 + F.tid]; } }
      __syncthreads(); }
    TaskGU t; t.A = (const char*)(F.ws + WS_H8); t.W = (const char*)(F.ws + WS_WGU); t.ltok = ltok; t.lw = lw;
    t.act = F.ws + WS_ACT; t.tilee = (const LAS int*)(F.lds + TILEE_OFF); t.hf = hf; t.ntr = ntr; t.G = F.G; t.c = F.bid;
    pg8::gemm_run(F.lds, t);
}
__device__ __forceinline__ void run_down(Frame& F, int hf) {
    const int ntr = load_padend(F, hf);
    LAS int* ldst = (LAS int*)(F.lds + ROWMETA_OFF);
    { const int* rowdst = (const int*)(F.ws + WS_ROWDST) + (size_t)hf * PMAXH;
      for (int i = 0; i < 16; ++i) { const int uu = F.bid + i * F.G; if (uu >= (ntr + 64) * 4) break; const int rt = uu >> 2;
          if (rt < ntr && F.tid < 256) ldst[i * 256 + F.tid] = rowdst[rt * 256 + F.tid]; }
      __syncthreads(); }
    TaskDown t; t.A = (const char*)(F.ws + WS_ACT); t.W = (const char*)(F.ws + WS_WD); t.ldst = ldst; t.yb = (unsigned char*)(F.ws + WS_YB);
    t.tilee = (const LAS int*)(F.lds + TILEE_OFF); t.hf = hf; t.ntr = ntr; t.G = F.G; t.c = F.bid;
    pg8::gemm_run(F.lds, t);
}
struct CombSet { u32x4 yv[9]; u32x4 x0, x1; };
__device__ __forceinline__ void combine_load(CombSet& S, const unsigned char* YB, const bf16_t* XBp, int hf, int tl, int c0) {
    const int tok = hf * HT + tl;
#pragma unroll
    for (int k = 0; k < 9; ++k) S.yv[k] = *(const u32x4*)(YB + ((size_t)tl * 9 + k) * 1024 + c0);
    S.x0 = *(const u32x4*)(XBp + (size_t)tok * D + c0); S.x1 = *(const u32x4*)(XBp + (size_t)tok * D + c0 + 8);
}
__device__ __forceinline__ void phase_combine(Frame& F, int l, int hf) {
    typedef float f32x2v __attribute__((ext_vector_type(2)));
    const PP p = F.p; const int lane = F.lane;
    const unsigned char* YB = (const unsigned char*)(F.ws + WS_YB); float* X = p->out; bf16_t* XBp = (bf16_t*)(F.ws + WS_XB); bf16_t* H = (bf16_t*)(F.ws + WS_H);
    const float* mod_l = (const float*)(F.ws + WS_MOD) + (size_t)l * 16 * 6144;
    const float* mod_n = (const float*)(F.ws + WS_MOD) + (size_t)1 * 16 * 6144;
    const int c0 = lane * 16;
    f32x4 gg[4];
#pragma unroll
    for (int q = 0; q < 4; ++q) gg[q] = (l == 0) ? *(const f32x4*)(p->norm1_g + (size_t)D + c0 + q * 4) : *(const f32x4*)(p->final_g + c0 + q * 4);
    int tl = F.bid * 8 + F.wave;
    CombSet C;
    if (tl < HT) combine_load(C, YB, XBp, hf, tl, c0);
#pragma unroll 1
    for (; tl < HT; tl += F.G * 8) {
        const int tok = hf * HT + tl, b = tok / SEQ;
        CombSet N = C;
        if (tl + F.G * 8 < HT) combine_load(N, YB, XBp, hf, tl + F.G * 8, c0);
        f32x4 gv[4], sc[4], sh[4];
#pragma unroll
        for (int q = 0; q < 4; ++q) { gv[q] = *(const f32x4*)(mod_l + (size_t)b * 6144 + 5120 + c0 + q * 4);
            if (l == 0) { sc[q] = *(const f32x4*)(mod_n + (size_t)b * 6144 + 1024 + c0 + q * 4); sh[q] = *(const f32x4*)(mod_n + (size_t)b * 6144 + c0 + q * 4); } }
        f32x4 xv[4];
        { float xa[8], xc[8]; unpack8(C.x0, xa); unpack8(C.x1, xc);
          xv[0] = (f32x4){xa[0], xa[1], xa[2], xa[3]}; xv[1] = (f32x4){xa[4], xa[5], xa[6], xa[7]}; xv[2] = (f32x4){xc[0], xc[1], xc[2], xc[3]}; xv[3] = (f32x4){xc[4], xc[5], xc[6], xc[7]}; }
        float s[16];
#pragma unroll
        for (int j = 0; j < 16; ++j) s[j] = 0.f;
#pragma unroll
        for (int k = 0; k < 9; ++k) { const unsigned wd[4] = {C.yv[k].x, C.yv[k].y, C.yv[k].z, C.yv[k].w};
#pragma unroll
            for (int q = 0; q < 4; ++q) { const f32x2v lo = __builtin_amdgcn_cvt_pk_f32_fp8((int)wd[q], false), hi = __builtin_amdgcn_cvt_pk_f32_fp8((int)wd[q], true);
                s[q * 4 + 0] += lo.x; s[q * 4 + 1] += lo.y; s[q * 4 + 2] += hi.x; s[q * 4 + 3] += hi.y; } }
        float xn[16]; float ss = 0.f;
#pragma unroll
        for (int q = 0; q < 4; ++q)
#pragma unroll
            for (int j = 0; j < 4; ++j) { const float v = xv[q][j] + gv[q][j] * (s[q * 4 + j] * 0.015625f); xn[q * 4 + j] = v; ss += v * v; }
        ss = wave_sum(ss, lane); const float rstd = rsqrtf(ss * (1.0f / D) + 1e-6f);
        if (l == 0) {
            float o[16];
            { u32x4 x0, x1; x0.x = pack2(xn[0], xn[1]); x0.y = pack2(xn[2], xn[3]); x0.z = pack2(xn[4], xn[5]); x0.w = pack2(xn[6], xn[7]); x1.x = pack2(xn[8], xn[9]); x1.y = pack2(xn[10], xn[11]); x1.z = pack2(xn[12], xn[13]); x1.w = pack2(xn[14], xn[15]);
              *(u32x4*)(XBp + (size_t)tok * D + c0) = x0; *(u32x4*)(XBp + (size_t)tok * D + c0 + 8) = x1; }
#pragma unroll
            for (int q = 0; q < 4; ++q)
#pragma unroll
                for (int j = 0; j < 4; ++j) o[q * 4 + j] = xn[q * 4 + j] * rstd * gg[q][j] * (1.0f + sc[q][j]) + sh[q][j];
            u32x4 h0, h1; h0.x = pack2(o[0], o[1]); h0.y = pack2(o[2], o[3]); h0.z = pack2(o[4], o[5]); h0.w = pack2(o[6], o[7]); h1.x = pack2(o[8], o[9]); h1.y = pack2(o[10], o[11]); h1.z = pack2(o[12], o[13]); h1.w = pack2(o[14], o[15]);
            *(u32x4*)(H + (size_t)tok * D + c0) = h0; *(u32x4*)(H + (size_t)tok * D + c0 + 8) = h1;
        } else {
#pragma unroll
            for (int q = 0; q < 4; ++q)
                *(f32x4*)(X + (size_t)tok * D + c0 + q * 4) = (f32x4){xn[q * 4] * rstd * gg[q][0], xn[q * 4 + 1] * rstd * gg[q][1], xn[q * 4 + 2] * rstd * gg[q][2], xn[q * 4 + 3] * rstd * gg[q][3]};
        }
        C = N;
    }
}

#define LAUNDER() do { F.tid = opaque_tid(); F.lane = F.tid & 63; F.wave = __builtin_amdgcn_readfirstlane(F.tid >> 6); \
        { PP q_ = (PP)__builtin_amdgcn_kernarg_segment_ptr(); asm volatile("" : "+s"(q_)); F.p = q_; } \
        { GPTR w_ = (GPTR)F.p->ws; asm volatile("" : "+s"(w_)); F.ws = (unsigned char*)w_; } \
        { LAS unsigned char* l_ = (LAS unsigned char*)smem; asm volatile("" : "+s"(l_)); F.lds = l_; } \
        { int b_ = blockIdx.x; asm volatile("" : "+s"(b_)); F.bid = b_; } \
        { unsigned x_ = bar.x; asm volatile("" : "+s"(x_)); bar.x = x_; } } while (0)
#define PHASE(ph, ...) do { if (lo <= (ph) && (ph) < hi) { LAUNDER(); { __VA_ARGS__; } if ((ph) + 1 < hi) xcd_barrier(bar); } } while (0)
#define PHASE_R(ph, s, ...) do { PHASE(ph, __VA_ARGS__); if ((s) == REPEAT_STEP) PHASE(ph, __VA_ARGS__); } while (0)

__global__ void __launch_bounds__(NTHREADS, 2) mega(Params prm_unused) {
    extern __shared__ __attribute__((aligned(16))) unsigned char smem[];
    Frame F;
    F.p = (PP)__builtin_amdgcn_kernarg_segment_ptr();
    F.lds = (LAS unsigned char*)smem; F.ws = F.p->ws;
    F.tid = opaque_tid(); F.lane = F.tid & 63; F.wave = __builtin_amdgcn_readfirstlane(F.tid >> 6); F.G = gridDim.x; F.bid = blockIdx.x;
    volatile LAS unsigned* misc = (volatile LAS unsigned*)(F.lds + MISC_OFF);
    if (F.tid < 4) misc[F.tid] = 0u;
    __syncthreads();
    XcdBarrier bar; bar.bar = (unsigned*)(F.ws + WS_CTL); bar.x = 0; bar.st = misc;
    const int lo = F.p->ph_lo, hi = F.p->ph_hi;
    if (hi - lo > 1) bar = xcd_barrier_post((unsigned*)(F.ws + WS_CTL), misc);
#define MODP ((const float*)(F.ws + WS_MOD))
#define LAYER(l) \
    if ((l) == 0) PHASE_R(1 + 13 * (l) + 0, 0, phase_norm(F, F.p->x, F.p->norm1_g, MODP, 0, 1024)); \
    PHASE_R(1 + 13 * (l) + 1, 1, TaskIn t; t.A = (const char*)(F.ws + WS_H); t.Bt = (const char*)(F.ws + WS_WINT) + (size_t)(l) * INP * 1024 * 2; t.O = (unsigned char*)(F.ws + WS_P); t.G = F.G; t.c = F.bid; pg8::gemm_run(F.lds, t); \
        TaskInTail tt; tt.A = t.A; tt.Bt = t.Bt; tt.O = t.O; tt.G = F.G; tt.c = F.bid; pg8::gemm_run(F.lds, tt)); \
    PHASE_R(1 + 13 * (l) + 2, 2, phase_prep_rwkv(F, (l)); for (int it = F.bid; it < 512; it += F.G) pool_tile(F, (l), it)); \
    PHASE(1 + 13 * (l) + 3, if (F.bid < 96) rwkv_chunk_block(F, F.bid, (l)); else for (int it = F.bid - 96; it < 96; it += F.G - 96) retention_item(F, it); \
        F.tid = opaque_tid(); F.lane = F.tid & 63; F.wave = __builtin_amdgcn_readfirstlane(F.tid >> 6); convert_queue(F, (l), (l))); \
    if (3 == REPEAT_STEP) PHASE(1 + 13 * (l) + 3, if (F.bid < 96) rwkv_chunk_block(F, F.bid, (l)); else for (int it = F.bid - 96; it < 96; it += F.G - 96) retention_item(F, it); \
        F.tid = opaque_tid(); F.lane = F.tid & 63; F.wave = __builtin_amdgcn_readfirstlane(F.tid >> 6); convert_queue(F, (l), 2 + (l))); \
    if (33 == REPEAT_STEP) PHASE(1 + 13 * (l) + 3, convert_queue(F, (l), 2 + (l))); \
    if (31 == REPEAT_STEP) PHASE(1 + 13 * (l) + 3, if (F.bid < 96) rwkv_chunk_block(F, F.bid, (l))); \
    if (32 == REPEAT_STEP) PHASE(1 + 13 * (l) + 3, if (F.bid >= 96) for (int it = F.bid - 96; it < 96; it += F.G - 96) retention_item(F, it)); \
    PHASE(1 + 13 * (l) + 5, TaskOut t; t.A = (const char*)(F.ws + WS_H); t.Bt = (const char*)(F.ws + WS_WOUTT) + (size_t)(l) * 1024 * 1024 * 2; t.xf = (l) == 0 ? F.p->x : nullptr; t.xb = (bf16_t*)(F.ws + WS_XB); t.gate = MODP + (size_t)(l) * 16 * 6144 + 2048; t.G = F.G; t.c = F.bid; pg8::gemm_run(F.lds, t)); \
    PHASE(1 + 13 * (l) + 6, phase_norm2_router(F, (l), true)); \
    if (6 == REPEAT_STEP) PHASE(1 + 13 * (l) + 6, phase_norm2_router(F, (l), false)); \
    PHASE_R(1 + 13 * (l) + 7, 7, phase_route(F, (l))); \
    PHASE_R(1 + 13 * (l) + 8, 8, run_gu(F, 0)); \
    PHASE_R(1 + 13 * (l) + 9, 9, run_down(F, 0)); \
    PHASE(1 + 13 * (l) + 10, phase_combine(F, (l), 0); LAUNDER(); run_gu(F, 1)); \
    PHASE_R(1 + 13 * (l) + 11, 11, run_down(F, 1)); \
    PHASE(1 + 13 * (l) + 12, phase_combine(F, (l), 1));
    PHASE(0, phase_init(F));
    LAYER(0)
    LAYER(1)
}

extern "C" void kernel_launch(void* const* d_in, const int* in_sizes, int n_in, void* d_out, int out_size, void* d_ws, size_t ws_size, hipStream_t stream) {
    static int grid = 0;
    if (grid == 0) {
        if (n_in != 30 || out_size != NTOK * D || ws_size < WS_END) { fprintf(stderr, "kernel_launch: unexpected sizes: n_in %d out %d ws %zu (need %zu)\n", n_in, out_size, ws_size, (size_t)WS_END); grid = -1; return; }
        int dev = 0, cus = 0;
        if (hipGetDevice(&dev) != hipSuccess || hipDeviceGetAttribute(&cus, hipDeviceAttributeMultiprocessorCount, dev) != hipSuccess) { grid = -1; return; }
        if (hipFuncSetAttribute((const void*)mega, hipFuncAttributeMaxDynamicSharedMemorySize, LDS_BYTES) != hipSuccess) { fprintf(stderr, "kernel_launch: hipFuncSetAttribute failed\n"); grid = -1; return; }
        int per_cu = 0; (void)hipOccupancyMaxActiveBlocksPerMultiprocessor(&per_cu, (const void*)mega, NTHREADS, LDS_BYTES); (void)hipGetLastError();
        grid = cus;
        if (per_cu < 1) fprintf(stderr, "kernel_launch: occupancy query says %d blocks per CU\n", per_cu);
    }
    if (grid < 0) return;
    (void)hipMemsetAsync((char*)d_ws + WS_CTL, 0, CTL_BYTES, stream);
    Params p{};
    const float** f = (const float**)&p;
    for (int i = 0; i < 30; ++i) f[i] = (const float*)d_in[i];
    p.out = (float*)d_out; p.ws = (unsigned char*)d_ws;
#if N_LAUNCH_MODE == 0
    p.ph_lo = 0; p.ph_hi = LAST_PHASE + 1;
    hipLaunchKernelGGL(mega, dim3(grid), dim3(NTHREADS), LDS_BYTES, stream, p);
#else
    for (int ph = 0; ph <= LAST_PHASE; ++ph) { p.ph_lo = ph; p.ph_hi = ph + 1; hipLaunchKernelGGL(mega, dim3(grid), dim3(NTHREADS), LDS_BYTES, stream, p); }
#endif
}
```
